# Optimizing an MI355X kernel written in HIP

```python
import math
import jax
import jax.numpy as jnp
from jax import lax
import numpy as np

D_MODEL = 1024
BATCH = 8
SEQ = 4096
DEPTH = 1

GLA_HEADS = 4
GLA_DK = D_MODEL // (2 * GLA_HEADS)
GLA_DV = D_MODEL // GLA_HEADS
GLA_GATE_RANK = 16
GLA_TAU = 16.0
GLA_CHUNK = 64
DIFF_HEADS = 8
DIFF_DH = D_MODEL // (2 * DIFF_HEADS)
ROPE_THETA = 10000.0
Q_BLOCK = 128
N_GROUPS = 4
EXPERTS_PER_GROUP = 8
N_EXPERTS = N_GROUPS * EXPERTS_PER_GROUP
TOP_K_IN_GROUP = 2
EXPERT_FF = 512
MOE_BLOCK = 128
LN_EPS = 1e-5
RMS_EPS = 1e-6
IN_SPLITS = (GLA_HEADS * GLA_DK, GLA_HEADS * GLA_DK, GLA_HEADS * GLA_DV, GLA_HEADS * GLA_DV, GLA_GATE_RANK,
             DIFF_HEADS * 2 * DIFF_DH, DIFF_HEADS * 2 * DIFF_DH, DIFF_HEADS * 2 * DIFF_DH, 2 * D_MODEL)
IN_COLS = sum(IN_SPLITS)

kernel_name = "hybrid_gla_diffattn_hmoe_deepnorm_adaln"


def _split_points():
    pts, acc = [], 0
    for s in IN_SPLITS[:-1]:
        acc += s
        pts.append(acc)
    return pts


def _layer_norm(x):
    xf = x.astype(jnp.float32)
    mu = jnp.mean(xf, -1, keepdims=True)
    var = jnp.mean(jnp.square(xf - mu), -1, keepdims=True)
    return (xf - mu) * lax.rsqrt(var + LN_EPS)


def _rms_norm(x, w):
    xf = x.astype(jnp.float32)
    y = xf * lax.rsqrt(jnp.mean(jnp.square(xf), -1, keepdims=True) + RMS_EPS) * w.astype(jnp.float32)
    return y


def _rope(t, pos):
    half = t.shape[-1] // 2
    inv = ROPE_THETA ** (-jnp.arange(half, dtype=jnp.float32) / half)
    ang = pos.astype(jnp.float32)[:, :, None, None, None] * inv
    cos, sin = jnp.cos(ang), jnp.sin(ang)
    tf = t.astype(jnp.float32)
    t1, t2 = tf[..., :half], tf[..., half:]
    return jnp.concatenate([t1 * cos - t2 * sin, t2 * cos + t1 * sin], -1).astype(t.dtype)


def _gla_chunked(q, k, v, log_g):
    B, H, S, dk = q.shape
    dv = v.shape[-1]
    C = GLA_CHUNK
    N = S // C
    f32 = jnp.float32
    q = q.astype(f32).reshape(B, H, N, C, dk) * (dk ** -0.5)
    k = k.astype(f32).reshape(B, H, N, C, dk)
    v = v.astype(f32).reshape(B, H, N, C, dv)
    b = jnp.cumsum(log_g.astype(f32).reshape(B, H, N, C, dk), axis=3)
    b_last = b[:, :, :, -1:, :]
    q_t = q * jnp.exp(b)
    k_t = k * jnp.exp(-b)
    k_d = k * jnp.exp(b_last - b)
    causal = jnp.tril(jnp.ones((C, C), dtype=bool))
    attn = jnp.where(causal, jnp.einsum('bhnid,bhnjd->bhnij', q_t, k_t), 0.0)
    o_intra = jnp.einsum('bhnij,bhnjv->bhniv', attn, v)
    decay = jnp.exp(b_last[:, :, :, 0, :])

    def step(state, inp):
        qn, kn, vn, dn = inp
        o = jnp.einsum('bhid,bhdv->bhiv', qn, state)
        state = state * dn[..., None] + jnp.einsum('bhjd,bhjv->bhdv', kn, vn)
        return state, o

    xs = (jnp.moveaxis(q_t, 2, 0), jnp.moveaxis(k_d, 2, 0), jnp.moveaxis(v, 2, 0), jnp.moveaxis(decay, 2, 0))
    _, o_inter = lax.scan(step, jnp.zeros((B, H, dk, dv), f32), xs)
    o = o_intra + jnp.moveaxis(o_inter, 0, 2)
    return o.reshape(B, H, S, dv)


def _gla_branch(q_in, k_in, v_in, og_in, glr, w_g2, b_g2, norm_w):
    B, S, _ = q_in.shape
    log_g = jax.nn.log_sigmoid((glr @ w_g2 + b_g2).astype(jnp.float32)) / GLA_TAU

    def heads(t, d):
        return t.reshape(B, S, GLA_HEADS, d).transpose(0, 2, 1, 3)

    o = _gla_chunked(heads(q_in, GLA_DK), heads(k_in, GLA_DK), heads(v_in, GLA_DV), heads(log_g, GLA_DK))
    o = o.transpose(0, 2, 1, 3)
    o = _rms_norm(o, norm_w) * jax.nn.silu(og_in.astype(jnp.float32)).reshape(B, S, GLA_HEADS, GLA_DV)
    return o.reshape(B, S, GLA_HEADS * GLA_DV).astype(q_in.dtype)


def _diff_branch(q_in, k_in, v_in, pos, lq1, lk1, lq2, lk2, norm_w, lam_init):
    B, S, _ = q_in.shape
    H, dh = DIFF_HEADS, DIFF_DH
    nb = S // Q_BLOCK
    q = _rope(q_in.reshape(B, S, H, 2, dh), pos) * (dh ** -0.5)
    k = _rope(k_in.reshape(B, S, H, 2, dh), pos)
    q = jnp.moveaxis(q.transpose(0, 2, 3, 1, 4).reshape(B, H, 2, nb, Q_BLOCK, dh), 3, 0)
    k = k.transpose(0, 2, 3, 1, 4)
    v = v_in.reshape(B, S, H, 2 * dh).transpose(0, 2, 1, 3)
    f32 = jnp.float32
    lam = (jnp.exp(jnp.sum(lq1.astype(f32) * lk1.astype(f32)))
           - jnp.exp(jnp.sum(lq2.astype(f32) * lk2.astype(f32))) + lam_init)
    key_pos = jnp.arange(S)

    def block(args):
        qb, bi = args
        s = jnp.einsum('bhcqd,bhckd->bhcqk', qb, k, preferred_element_type=f32)
        q_pos = bi * Q_BLOCK + jnp.arange(Q_BLOCK)
        s = jnp.where(key_pos[None, :] <= q_pos[:, None], s, -jnp.inf)
        p = jax.nn.softmax(s, axis=-1)
        a = p[:, :, 0] - lam * p[:, :, 1]
        return jnp.einsum('bhqk,bhkd->bhqd', a.astype(v.dtype), v)

    o = lax.map(block, (q, jnp.arange(nb)))
    o = jnp.moveaxis(o, 0, 2).reshape(B, H, S, 2 * dh).transpose(0, 2, 1, 3)
    o = _rms_norm(o, norm_w) * (1.0 - lam_init)
    return o.reshape(B, S, H * 2 * dh).astype(q_in.dtype)


def _hier_moe(u, w_rg, b_rg, w_re, b_re, w_gate, w_up, w_down):
    B, S, D = u.shape
    T = B * S
    xf = u.reshape(T, D)
    f32 = jnp.float32
    p_group = jax.nn.softmax((xf @ w_rg + b_rg).astype(f32), axis=-1)
    w_grp, g_idx = lax.top_k(p_group, 1)
    e_logits = (xf @ w_re + b_re).astype(f32).reshape(T, N_GROUPS, EXPERTS_PER_GROUP)
    e_sel = jnp.take_along_axis(e_logits, g_idx[:, :, None], axis=1)[:, 0]
    v2, i2 = lax.top_k(e_sel, TOP_K_IN_GROUP)
    comb = w_grp * jax.nn.softmax(v2, axis=-1)
    eid = g_idx * EXPERTS_PER_GROUP + i2
    tk = T * TOP_K_IN_GROUP
    flat_e = eid.reshape(tk).astype(jnp.int32)
    flat_t = jnp.repeat(jnp.arange(T, dtype=jnp.int32), TOP_K_IN_GROUP)
    flat_w = comb.reshape(tk).astype(u.dtype)
    order = jnp.argsort(flat_e, stable=True)
    sorted_e = flat_e[order]
    counts = jnp.bincount(flat_e, length=N_EXPERTS)
    start = jnp.cumsum(counts) - counts
    pcounts = ((counts + MOE_BLOCK - 1) // MOE_BLOCK) * MOE_BLOCK
    pend = jnp.cumsum(pcounts)
    pstart = pend - pcounts
    dest = pstart[sorted_e] + (jnp.arange(tk) - start[sorted_e])
    P = ((tk + N_EXPERTS * (MOE_BLOCK - 1) + MOE_BLOCK - 1) // MOE_BLOCK) * MOE_BLOCK
    nblk = P // MOE_BLOCK
    row_token = jnp.zeros((P,), jnp.int32).at[dest].set(flat_t[order])
    row_w = jnp.zeros((P,), u.dtype).at[dest].set(flat_w[order])
    block_expert = jnp.clip(jnp.searchsorted(pend, jnp.arange(nblk) * MOE_BLOCK, side='right'),
                            0, N_EXPERTS - 1).astype(jnp.int32)
    xs = xf[row_token].reshape(nblk, MOE_BLOCK, D)

    def expert_block(args):
        xb, e = args
        h = jax.nn.silu(xb @ w_gate[e]) * (xb @ w_up[e])
        return h @ w_down[e]

    rows = lax.map(expert_block, (xs, block_expert)).reshape(P, D)
    y = jax.ops.segment_sum(rows * row_w[:, None], row_token, num_segments=T)
    return y.reshape(B, S, D)


def setup_inputs(seed: int = 0) -> dict:
    key = jax.random.key(seed)
    ks = jax.random.split(key, 26)
    f32 = jnp.float32
    beta = (8.0 * DEPTH) ** -0.25
    Ldim = DEPTH

    def nrm(k, shape, s):
        return jax.random.normal(k, shape, f32) * s

    return {
        "x": nrm(ks[0], (BATCH, SEQ, D_MODEL), 1.0),
        "c": nrm(ks[1], (BATCH, D_MODEL), 1.0),
        "positions": (jnp.arange(SEQ, dtype=jnp.int32)[None, :]
                      + jax.random.randint(ks[2], (BATCH, 1), 0, SEQ, dtype=jnp.int32)),
        "w_ada": nrm(ks[3], (Ldim, D_MODEL, 6 * D_MODEL), 0.5 * D_MODEL ** -0.5),
        "b_ada": nrm(ks[4], (Ldim, 6 * D_MODEL), 0.01),
        "w_in": nrm(ks[5], (Ldim, D_MODEL, IN_COLS), D_MODEL ** -0.5),
        "w_gla_gate2": nrm(ks[6], (Ldim, GLA_GATE_RANK, GLA_HEADS * GLA_DK), GLA_GATE_RANK ** -0.5),
        "b_gla_gate2": nrm(ks[7], (Ldim, GLA_HEADS * GLA_DK), 0.01),
        "gla_norm_w": 1.0 + nrm(ks[8], (Ldim, GLA_DV), 0.02),
        "diff_lambda_q1": nrm(ks[9], (Ldim, DIFF_DH), 0.1),
        "diff_lambda_k1": nrm(ks[10], (Ldim, DIFF_DH), 0.1),
        "diff_lambda_q2": nrm(ks[11], (Ldim, DIFF_DH), 0.1),
        "diff_lambda_k2": nrm(ks[12], (Ldim, DIFF_DH), 0.1),
        "diff_norm_w": 1.0 + nrm(ks[13], (Ldim, 2 * DIFF_DH), 0.02),
        "w_out": nrm(ks[14], (Ldim, D_MODEL, D_MODEL), beta * D_MODEL ** -0.5),
        "ln1_w": 1.0 + nrm(ks[15], (Ldim, D_MODEL), 0.02),
        "ln1_b": nrm(ks[16], (Ldim, D_MODEL), 0.02),
        "w_router_group": nrm(ks[17], (Ldim, D_MODEL, N_GROUPS), D_MODEL ** -0.5),
        "b_router_group": nrm(ks[18], (Ldim, N_GROUPS), 0.01),
        "w_router_expert": nrm(ks[19], (Ldim, D_MODEL, N_EXPERTS), D_MODEL ** -0.5),
        "b_router_expert": nrm(ks[20], (Ldim, N_EXPERTS), 0.01),
        "w_exp_gate": nrm(ks[21], (Ldim, N_EXPERTS, D_MODEL, EXPERT_FF), D_MODEL ** -0.5),
        "w_exp_up": nrm(ks[22], (Ldim, N_EXPERTS, D_MODEL, EXPERT_FF), D_MODEL ** -0.5),
        "w_exp_down": nrm(ks[23], (Ldim, N_EXPERTS, EXPERT_FF, D_MODEL), beta * EXPERT_FF ** -0.5),
        "ln2_w": 1.0 + nrm(ks[24], (Ldim, D_MODEL), 0.02),
        "ln2_b": nrm(ks[25], (Ldim, D_MODEL), 0.02),
    }


def reference(x, c, positions, w_ada, b_ada, w_in, w_gla_gate2, b_gla_gate2, gla_norm_w,
              diff_lambda_q1, diff_lambda_k1, diff_lambda_q2, diff_lambda_k2, diff_norm_w, w_out,
              ln1_w, ln1_b, w_router_group, b_router_group, w_router_expert, b_router_expert,
              w_exp_gate, w_exp_up, w_exp_down, ln2_w, ln2_b):
    alpha = (2.0 * DEPTH) ** 0.25
    dt = x.dtype
    for l in range(DEPTH):
        lam_init = 0.8 - 0.6 * math.exp(-0.3 * l)
        ada = jax.nn.silu(c) @ w_ada[l] + b_ada[l]
        shift1, scale1, gate1, shift2, scale2, gate2 = jnp.split(ada[:, None, :], 6, axis=-1)
        u = (_layer_norm(x) * (1.0 + scale1) + shift1).astype(dt)
        proj = u @ w_in[l]
        gq, gk, gv, go, gr, dq, dk, dv, mg = jnp.split(proj, _split_points(), axis=-1)
        o_gla = _gla_branch(gq, gk, gv, go, gr, w_gla_gate2[l], b_gla_gate2[l], gla_norm_w[l])
        o_diff = _diff_branch(dq, dk, dv, positions, diff_lambda_q1[l], diff_lambda_k1[l],
                              diff_lambda_q2[l], diff_lambda_k2[l], diff_norm_w[l], lam_init)
        g_a, g_b = jnp.split(jax.nn.sigmoid(mg), 2, axis=-1)
        y = (g_a * o_gla + g_b * o_diff) @ w_out[l]
        x = (_layer_norm(alpha * x + gate1 * y) * ln1_w[l] + ln1_b[l]).astype(dt)
        u2 = (_layer_norm(x) * (1.0 + scale2) + shift2).astype(dt)
        m = _hier_moe(u2, w_router_group[l], b_router_group[l], w_router_expert[l], b_router_expert[l],
                      w_exp_gate[l], w_exp_up[l], w_exp_down[l])
        x = (_layer_norm(alpha * x + gate2 * m) * ln2_w[l] + ln2_b[l]).astype(dt)
    return x
```

```cpp
#include <hip/hip_runtime.h>
#include <hip/hip_bf16.h>
#include <cstdio>
#include <cstdint>
#include <cmath>

#ifndef MK_N_LAUNCHES
#define MK_N_LAUNCHES 15
#endif

namespace pg8 {
#define PG8_LAS __attribute__((address_space(3)))
typedef unsigned short bf16_t;
typedef short bf16x8 __attribute__((ext_vector_type(8)));
typedef float f32x4 __attribute__((ext_vector_type(4)));
typedef float f32x2 __attribute__((ext_vector_type(2)));
typedef unsigned u32x4 __attribute__((ext_vector_type(4)));
typedef unsigned u32x2 __attribute__((ext_vector_type(2)));
constexpr int BM = 256, BK = 64, HALF = 128, HTB = HALF * BK * 2  , STAGE_BYTES = 8 * HTB, NXCD = 8, WGM = 8;

__host__ __device__ __forceinline__ int lds_byte(int r, int c) { const int st = (r >> 4) * 2 + (c >> 5), rr = r & 15, cc = c & 31, ob = rr * 64 + cc * 2; return st * 1024 + (ob ^ (((ob >> 9) & 1) << 5)); }
__host__ __device__ __forceinline__ void stage_rc(int b, int& R, int& C) { const int st = b / 1024, sb = b % 1024, swz = sb ^ (((sb >> 9) & 1) << 5); R = (st >> 1) * 16 + swz / 64; C = (st & 1) * 32 + (swz % 64) / 2; }
__host__ __device__ __forceinline__ int perm32(int rho) { const int n = rho >> 4, i = rho & 15; return 8 * (i >> 2) + 4 * n + (i & 3); }

struct Unit { int pm, pn, e, row0; };

struct DenseProb {
    const char* A; const char* Bt; int lda, K; int nM, nN, nwg, G, c;
    __device__ __forceinline__ void init(const void* A_, int lda_, const void* Bt_, int M, int N, int K_, int G_, int c_) { A = (const char*)A_; Bt = (const char*)Bt_; lda = lda_; K = K_; nM = M / BM; nN = N / BM; nwg = nM * nN; G = G_; c = c_; }
    __device__ __forceinline__ bool next(int i, Unit& u) const {
        const long L = (long)i * G + c; if (L >= nwg) return false;
        int wgid = (int)L; { const int q = nwg / NXCD, r = nwg % NXCD, xcd = wgid % NXCD, off = wgid / NXCD; wgid = (xcd < r ? xcd * (q + 1) : r * (q + 1) + (xcd - r) * q) + off; }
        const int nig = WGM * nN, gid = wgid / nig, fm = gid * WGM, gsz = (nM - fm) < WGM ? (nM - fm) : WGM;
        u.pm = fm + ((wgid % nig) % gsz); u.pn = (wgid % nig) / gsz; u.e = 0; u.row0 = u.pm * BM; return true;
    }
    __device__ __forceinline__ void a_voff(const Unit& u, const int (&R)[2], const int (&C)[2], unsigned (&v)[4]) const {
#pragma unroll
        for (int h = 0; h < 2; ++h)
#pragma unroll
            for (int i = 0; i < 2; ++i) v[h * 2 + i] = (unsigned)((u.row0 + h * HALF + R[i]) * lda + C[i]) * 2u;
    }
    __device__ __forceinline__ size_t b_off(const Unit& u) const { return (size_t)u.pn * BM * K * 2; }
};

__device__ __forceinline__ unsigned cvt_pk_bf16(float lo, float hi) { typedef __bf16 bf16x2_t __attribute__((ext_vector_type(2))); f32x2 v = {lo, hi}; bf16x2_t b = __builtin_convertvector(v, bf16x2_t); return __builtin_bit_cast(unsigned, b); }
__device__ __forceinline__ float bf_lo(unsigned w) { return __uint_as_float(w << 16); }
__device__ __forceinline__ float bf_hi(unsigned w) { return __uint_as_float(w & 0xffff0000u); }
__device__ __forceinline__ float sigmoidf_(float x) { return __builtin_amdgcn_rcpf(1.f + __expf(-x)); }

template <class Epi, class Prob, bool ALIGN_EPI>
__device__ __forceinline__ void gemm_phase(PG8_LAS unsigned char* lds, const Prob& P, const Epi& E) {
    const int tid = threadIdx.x, wid = __builtin_amdgcn_readfirstlane(tid >> 6), lane = tid & 63, wr = wid >> 2, wc = wid & 3, fr = lane & 15, fq = lane >> 4;
    const int K = P.K, nt = K / BK;
    int sR[2], sC[2]; unsigned voffB[2];
#pragma unroll
    for (int i = 0; i < 2; ++i) { int R, C; stage_rc(tid * 16 + i * 8192, R, C); const int Rb = (R & ~31) + perm32(R & 31); sR[i] = R; sC[i] = C; voffB[i] = (unsigned)(Rb * K + C) * 2u; }
    const size_t kstep = (size_t)(BK * 2);
    const size_t hstepB = (size_t)HALF * K * 2;
    const unsigned ldsw = (unsigned)wid * 1024u;
    const int aoff = lds_byte(wr * 64 + fr, fq * 8), boff = lds_byte(wc * 32 + fr, fq * 8);
#define PG8_SA(b, h) (((b) * 2 + (h)) * HTB)
#define PG8_SB(b, h) ((4 + (b) * 2 + (h)) * HTB)
#define PG8_STAGE(bufoff, gbase, voff) do { _Pragma("unroll") for (int _i = 0; _i < 2; ++_i) \
        __builtin_amdgcn_global_load_lds((const unsigned*)((const char*)(gbase) + (voff)[_i]), (PG8_LAS unsigned*)(lds + (bufoff) + ldsw + _i * 8192), 16, 0, 0); } while (0)
#define PG8_STAGE_A(bufoff, kofs, V, h) do { _Pragma("unroll") for (int _i = 0; _i < 2; ++_i) \
        __builtin_amdgcn_global_load_lds((const unsigned*)(P.A + (kofs) + (V)[(h) * 2 + _i]), (PG8_LAS unsigned*)(lds + (bufoff) + ldsw + _i * 8192), 16, 0, 0); } while (0)
#define PG8_LDA(dst, b, h) do { _Pragma("unroll") for (int m = 0; m < 4; ++m) _Pragma("unroll") for (int k = 0; k < 2; ++k) dst[m][k] = *(const PG8_LAS bf16x8*)(lds + PG8_SA(b, h) + aoff + m * 2048 + k * 1024); } while (0)
#define PG8_LDB(dst, b, h) do { _Pragma("unroll") for (int n = 0; n < 2; ++n) _Pragma("unroll") for (int k = 0; k < 2; ++k) dst[n][k] = *(const PG8_LAS bf16x8*)(lds + PG8_SB(b, h) + boff + n * 2048 + k * 1024); } while (0)
#define PG8_MMA(ai, bj, At, Bt) do { __builtin_amdgcn_s_setprio(1); _Pragma("unroll") for (int m = 0; m < 4; ++m) _Pragma("unroll") for (int n = 0; n < 2; ++n) _Pragma("unroll") for (int k = 0; k < 2; ++k) \
        acc[ai][bj][m][n] = __builtin_amdgcn_mfma_f32_16x16x32_bf16(Bt[n][k], At[m][k], acc[ai][bj][m][n], 0, 0, 0); __builtin_amdgcn_s_setprio(0); } while (0)
#define PG8_WAIT_V(n) asm volatile("s_waitcnt vmcnt(" #n ")" ::: "memory")
#define PG8_WAIT_L(n) asm volatile("s_waitcnt lgkmcnt(" #n ")" ::: "memory")
#define PG8_BAR __builtin_amdgcn_s_barrier()
#define PG8_SCHED __builtin_amdgcn_sched_barrier(0)
    Unit cur, nxt; int ui = 0;
    if (!P.next(0, cur)) return;
    f32x4 acc[2][2][4][2];
#pragma unroll
    for (int a = 0; a < 2; ++a)
#pragma unroll
        for (int b = 0; b < 2; ++b)
#pragma unroll
            for (int m = 0; m < 4; ++m)
#pragma unroll
                for (int n = 0; n < 2; ++n) acc[a][b][m][n] = (f32x4){0.f, 0.f, 0.f, 0.f};
    bf16x8 At[4][2], B0[2][2], B1[2][2];
    unsigned vc[4], vn[4];
    P.a_voff(cur, sR, sC, vc);
    const char* cB = P.Bt + P.b_off(cur);
    PG8_STAGE(PG8_SB(0, 0), cB, voffB); PG8_STAGE(PG8_SB(0, 1), cB + hstepB, voffB); PG8_STAGE_A(PG8_SA(0, 0), 0, vc, 0); PG8_STAGE_A(PG8_SA(0, 1), 0, vc, 1);
    if (wr == 1) PG8_BAR;
    PG8_WAIT_V(2); PG8_BAR;
    PG8_STAGE(PG8_SB(1, 0), cB + kstep, voffB); PG8_STAGE_A(PG8_SA(1, 0), kstep, vc, 0); PG8_STAGE(PG8_SB(1, 1), cB + hstepB + kstep, voffB);
    PG8_WAIT_V(6); PG8_BAR;
    for (;;) {
        const bool has_next = P.next(ui + 1, nxt);
        const char* nB = cB;
        if (has_next) { P.a_voff(nxt, sR, sC, vn); nB = P.Bt + P.b_off(nxt); }
        else {
#pragma unroll
            for (int q = 0; q < 4; ++q) vn[q] = vc[q];
        }
        for (int t = 0; t < nt; t += 2) {
            const bool last = (t == nt - 2);
            const size_t ka1 = (size_t)(t + 1) * kstep;
            const size_t ka2 = last ? (size_t)0 : (size_t)(t + 2) * kstep, ka3 = ka2 + kstep;
            const char* b2 = last ? nB : cB + (size_t)(t + 2) * kstep; const char* b3 = b2 + kstep;
            unsigned v2[4];
#pragma unroll
            for (int q = 0; q < 4; ++q) v2[q] = last ? vn[q] : vc[q];
            PG8_LDB(B0, 0, 0); PG8_LDB(B1, 0, 1); PG8_SCHED; PG8_LDA(At, 0, 0); PG8_STAGE_A(PG8_SA(1, 1), ka1, vc, 1);
            PG8_WAIT_V(8); PG8_WAIT_L(0); PG8_BAR; PG8_MMA(0, 0, At, B0); PG8_MMA(0, 1, At, B1); PG8_BAR; PG8_SCHED;
            PG8_LDA(At, 0, 1); PG8_STAGE(PG8_SB(0, 0), b2, voffB); PG8_STAGE(PG8_SB(0, 1), b2 + hstepB, voffB); PG8_STAGE_A(PG8_SA(0, 0), ka2, v2, 0);
            PG8_WAIT_V(8); PG8_WAIT_L(0); PG8_BAR; PG8_MMA(1, 0, At, B0); PG8_MMA(1, 1, At, B1); PG8_BAR; PG8_SCHED;
            PG8_LDB(B0, 1, 0); PG8_LDB(B1, 1, 1); PG8_SCHED; PG8_LDA(At, 1, 0); PG8_STAGE_A(PG8_SA(0, 1), ka2, v2, 1);
            PG8_WAIT_V(8); PG8_WAIT_L(0); PG8_BAR; PG8_MMA(0, 0, At, B0); PG8_MMA(0, 1, At, B1); PG8_BAR; PG8_SCHED;
            PG8_LDA(At, 1, 1); PG8_STAGE(PG8_SB(1, 0), b3, voffB); PG8_STAGE(PG8_SB(1, 1), b3 + hstepB, voffB); PG8_STAGE_A(PG8_SA(1, 0), ka3, v2, 0);
            PG8_WAIT_V(8); PG8_WAIT_L(0); PG8_BAR; PG8_MMA(1, 0, At, B0); PG8_MMA(1, 1, At, B1); PG8_BAR; PG8_SCHED;
        }
        if constexpr (ALIGN_EPI) { if (wr == 0) PG8_BAR; }
        E(acc, cur, wr, wc, fr, fq);
        if (!has_next) break;
#pragma unroll
        for (int a = 0; a < 2; ++a)
#pragma unroll
            for (int b = 0; b < 2; ++b)
#pragma unroll
                for (int m = 0; m < 4; ++m)
#pragma unroll
                    for (int n = 0; n < 2; ++n) acc[a][b][m][n] = (f32x4){0.f, 0.f, 0.f, 0.f};
        cur = nxt; cB = nB; ++ui;
#pragma unroll
        for (int q = 0; q < 4; ++q) vc[q] = vn[q];
        if constexpr (ALIGN_EPI) { if (wr == 1) PG8_BAR; }
    }
    PG8_WAIT_V(0);
    if constexpr (!ALIGN_EPI) { if (wr == 0) PG8_BAR; }
    PG8_BAR;
#undef PG8_SA
#undef PG8_SB
#undef PG8_STAGE
#undef PG8_STAGE_A
#undef PG8_LDA
#undef PG8_LDB
#undef PG8_MMA
#undef PG8_WAIT_V
#undef PG8_WAIT_L
#undef PG8_BAR
#undef PG8_SCHED
}
}
constexpr int BATCH = 8, SEQ = 4096, D = 1024, T = BATCH * SEQ;
constexpr int IN_COLS = 8208;
constexpr int NEXP = 32, FF = 512;
constexpr float LN_EPS = 1e-5f, RMS_EPS = 1e-6f, ALPHA = 1.189207115002721f, LAM_INIT = 0.2f;
constexpr float ATT_C2 = 0.125f * 1.4426950408889634f;
constexpr int ACT_LD = 4352, AC_GQ = 0, AC_GK = 512, AC_GV = 1024, AC_GO = 2048, AC_DV = 3072, AC_GR = 4096;
constexpr int AC_O1 = 0, AC_O2 = 2048, AC_OGLA = 1024, AC_ODIFF = 0, AC_MERGED = 3072;
constexpr int DQK_LD = 2048;
constexpr int N1 = 25 * 256;

namespace pg8 {
struct EpiProj {
    bf16_t* act1; bf16_t* dqk; const int* pos;
    __device__ __forceinline__ void operator()(const f32x4 (&acc)[2][2][4][2], const Unit& u, int wr, int wc, int fr, int fq) const {
        const int pn = u.pn, row0 = u.row0 + wr * 64 + fr, colin = wc * 32 + 8 * fq;
        if (pn < 12 || pn >= 20) {
            const int coltile = pn < 12 ? pn * 256 : (pn < 24 ? AC_DV + (pn - 20) * 256 : AC_GR);
#pragma unroll
            for (int ai = 0; ai < 2; ++ai)
#pragma unroll
                for (int m = 0; m < 4; ++m) { bf16_t* rowp = act1 + (size_t)(row0 + ai * HALF + m * 16) * ACT_LD + coltile + colin;
#pragma unroll
                    for (int bj = 0; bj < 2; ++bj) { const f32x4 v0 = acc[ai][bj][m][0], v1 = acc[ai][bj][m][1];
                        u32x4 w; w.x = cvt_pk_bf16(v0[0], v0[1]); w.y = cvt_pk_bf16(v0[2], v0[3]); w.z = cvt_pk_bf16(v1[0], v1[1]); w.w = cvt_pk_bf16(v1[2], v1[3]);
                        *(u32x4*)(rowp + bj * HALF) = w; } }
        } else {
            const bool isq = pn < 16; const int coltile = isq ? (pn - 12) * 256 : 1024 + (pn - 16) * 256; const float sc = isq ? ATT_C2 : 1.f;
            const int g = 4 * (wc & 1) + fq; float inv[4];
#pragma unroll
            for (int i = 0; i < 4; ++i) inv[i] = exp2f(-(float)(4 * g + i) * (13.287712379549449f / 32.f));
#pragma unroll
            for (int ai = 0; ai < 2; ++ai)
#pragma unroll
                for (int m = 0; m < 4; ++m) { const int r = row0 + ai * HALF + m * 16; const float p = (float)pos[r]; float cs[4], sn[4];
#pragma unroll
                    for (int i = 0; i < 4; ++i) { const float ang = p * inv[i]; float rev = ang * 0.15915494309189535f; rev = rev - floorf(rev); sn[i] = __builtin_amdgcn_sinf(rev); cs[i] = __builtin_amdgcn_cosf(rev); }
                    bf16_t* rowp = dqk + (size_t)r * DQK_LD + coltile + colin;
#pragma unroll
                    for (int bj = 0; bj < 2; ++bj) { const f32x4 v0 = acc[ai][bj][m][0], v1 = acc[ai][bj][m][1]; float o1[4], o2[4];
#pragma unroll
                        for (int i = 0; i < 4; ++i) { o1[i] = (v0[i] * cs[i] - v1[i] * sn[i]) * sc; o2[i] = (v1[i] * cs[i] + v0[i] * sn[i]) * sc; }
                        u32x4 w; w.x = cvt_pk_bf16(o1[0], o1[1]); w.y = cvt_pk_bf16(o1[2], o1[3]); w.z = cvt_pk_bf16(o2[0], o2[1]); w.w = cvt_pk_bf16(o2[2], o2[3]);
                        *(u32x4*)(rowp + bj * HALF) = w; } }
        }
    }
};
struct EpiMerge {
    bf16_t* act1;
    __device__ __forceinline__ void operator()(const f32x4 (&acc)[2][2][4][2], const Unit& u, int wr, int wc, int fr, int fq) const {
        const int row0 = u.row0 + wr * 64 + fr, j0 = u.pn * 128 + wc * 16 + 4 * fq;
#pragma unroll
        for (int ai = 0; ai < 2; ++ai)
#pragma unroll
            for (int m = 0; m < 4; ++m) { bf16_t* rowp = act1 + (size_t)(row0 + ai * HALF + m * 16) * ACT_LD;
#pragma unroll
                for (int bj = 0; bj < 2; ++bj) { const int j = j0 + bj * 64; const f32x4 v0 = acc[ai][bj][m][0], v1 = acc[ai][bj][m][1];
                    const u32x2 og = *(const u32x2*)(rowp + AC_OGLA + j), od = *(const u32x2*)(rowp + AC_ODIFF + j);
                    const float ga0 = sigmoidf_(v0[0]), ga1 = sigmoidf_(v0[1]), ga2 = sigmoidf_(v0[2]), ga3 = sigmoidf_(v0[3]);
                    const float gb0 = sigmoidf_(v1[0]), gb1 = sigmoidf_(v1[1]), gb2 = sigmoidf_(v1[2]), gb3 = sigmoidf_(v1[3]);
                    u32x2 w; w.x = cvt_pk_bf16(ga0 * bf_lo(og.x) + gb0 * bf_lo(od.x), ga1 * bf_hi(og.x) + gb1 * bf_hi(od.x));
                    w.y = cvt_pk_bf16(ga2 * bf_lo(og.y) + gb2 * bf_lo(od.y), ga3 * bf_hi(og.y) + gb3 * bf_hi(od.y));
                    *(u32x2*)(rowp + AC_MERGED + j) = w; } }
    }
};
struct EpiX1 {
    const float* x; const float* ada; float* out;
    __device__ __forceinline__ void operator()(const f32x4 (&acc)[2][2][4][2], const Unit& u, int wr, int wc, int fr, int fq) const {
        const int row0 = u.row0 + wr * 64 + fr, col0 = u.pn * BM + wc * 32 + 8 * fq; const int b = u.row0 / SEQ;
        f32x4 gv[2][2];
#pragma unroll
        for (int bj = 0; bj < 2; ++bj)
#pragma unroll
            for (int n = 0; n < 2; ++n) gv[bj][n] = *(const f32x4*)(ada + (size_t)b * 6 * D + 2 * D + col0 + bj * HALF + 4 * n);
#pragma unroll
        for (int ai = 0; ai < 2; ++ai)
#pragma unroll
            for (int m = 0; m < 4; ++m) { const size_t off = (size_t)(row0 + ai * HALF + m * 16) * D + col0;
#pragma unroll
                for (int bj = 0; bj < 2; ++bj)
#pragma unroll
                    for (int n = 0; n < 2; ++n) { const f32x4 xv = *(const f32x4*)(x + off + bj * HALF + 4 * n); *(f32x4*)(out + off + bj * HALF + 4 * n) = xv * ALPHA + gv[bj][n] * acc[ai][bj][m][n]; } }
    }
};
struct EpiUp {
    bf16_t* hbuf;
    __device__ __forceinline__ void operator()(const f32x4 (&acc)[2][2][4][2], const Unit& u, int wr, int wc, int fr, int fq) const {
        const int row0 = u.row0 + wr * 64 + fr, j0 = u.pn * 128 + wc * 16 + 4 * fq;
#pragma unroll
        for (int ai = 0; ai < 2; ++ai)
#pragma unroll
            for (int m = 0; m < 4; ++m) { bf16_t* rowp = hbuf + (size_t)(row0 + ai * HALF + m * 16) * FF;
#pragma unroll
                for (int bj = 0; bj < 2; ++bj) { const f32x4 v0 = acc[ai][bj][m][0], v1 = acc[ai][bj][m][1];
                    u32x2 w; w.x = cvt_pk_bf16(v0[0] * sigmoidf_(v0[0]) * v1[0], v0[1] * sigmoidf_(v0[1]) * v1[1]); w.y = cvt_pk_bf16(v0[2] * sigmoidf_(v0[2]) * v1[2], v0[3] * sigmoidf_(v0[3]) * v1[3]);
                    *(u32x2*)(rowp + j0 + bj * 64) = w; } }
    }
};
struct EpiDown {
    bf16_t* mout; const int* rowtok; const float* roww;
    __device__ __forceinline__ void operator()(const f32x4 (&acc)[2][2][4][2], const Unit& u, int wr, int wc, int fr, int fq) const {
        const int row0 = u.row0 + wr * 64 + fr, col0 = u.pn * BM + wc * 32 + 8 * fq;
#pragma unroll
        for (int ai = 0; ai < 2; ++ai)
#pragma unroll
            for (int m = 0; m < 4; ++m) { const int pr = row0 + ai * HALF + m * 16; const int rt = rowtok[pr]; const float w = roww[pr];
                if (rt >= 0) { bf16_t* rowp = mout + (size_t)rt * D + col0;
#pragma unroll
                    for (int bj = 0; bj < 2; ++bj) { const f32x4 v0 = acc[ai][bj][m][0] * w, v1 = acc[ai][bj][m][1] * w;
                        u32x4 o; o.x = cvt_pk_bf16(v0[0], v0[1]); o.y = cvt_pk_bf16(v0[2], v0[3]); o.z = cvt_pk_bf16(v1[0], v1[1]); o.w = cvt_pk_bf16(v1[2], v1[3]);
                        *(u32x4*)(rowp + bj * HALF) = o; } } }
    }
};
constexpr int TILE_MAX = 512;
template <bool GATHER> struct MoeProb {
    const char* A; const char* Bt; int lda, K; int G, c; const int* tab; PG8_LAS const int* rows; size_t bstride;
    __device__ __forceinline__ bool next(int i, Unit& u) const {
        const int idx = i * G + c, ntile = tab[0]; if (idx >= ntile * 4) return false;
        const int t = idx >> 2; u.pn = idx & 3; u.e = tab[1 + t]; u.row0 = tab[1 + TILE_MAX + t]; u.pm = i; return true;
    }
    __device__ __forceinline__ void a_voff(const Unit& u, const int (&R)[2], const int (&C)[2], unsigned (&v)[4]) const {
#pragma unroll
        for (int h = 0; h < 2; ++h)
#pragma unroll
            for (int i = 0; i < 2; ++i) { const int row = GATHER ? rows[u.pm * 256 + h * HALF + R[i]] : (u.row0 + h * HALF + R[i]); v[h * 2 + i] = (unsigned)(row * lda + C[i]) * 2u; }
    }
    __device__ __forceinline__ size_t b_off(const Unit& u) const { return (size_t)u.e * bstride + (size_t)u.pn * BM * K * 2; }
};
}
#include <hip/hip_bf16.h>
#include <cmath>
namespace attn_body {
using bf16=__hip_bfloat16;
using bf16x8=__attribute__((ext_vector_type(8)))short;
using s16x4=__attribute__((ext_vector_type(4)))short;
using f32x16=__attribute__((ext_vector_type(16)))float;
using u32x4=__attribute__((ext_vector_type(4)))unsigned;
constexpr int SEQ=4096,D=64,PQ=2048,PK=2048,PV=4352,PO=4352;
constexpr int NW=8,QBLK=32,QB=QBLK*NW,KVBLK=64,NQB=SEQ/QB;
constexpr int ATTN_UNIT_ROWS=QB;
__device__ __forceinline__ int crow(int r,int hi){return (r&3)+8*(r>>2)+4*hi;}
#define SBAR() __builtin_amdgcn_sched_barrier(0)
__device__ __forceinline__ void cmask(f32x16&p0,f32x16&p1,int jb,int qrel,int hi){
  const float NEG=-INFINITY; int kb=64*jb+4*hi;
  #pragma unroll
  for(int r=0;r<16;++r){int kv=kb+(r&3)+8*(r>>2); if(kv>qrel)p0[r]=NEG; if(kv+32>qrel)p1[r]=NEG;}
}

constexpr int NSLOT=3, SLOTB=8192;
constexpr int LDS_K=0, LDS_V=NSLOT*SLOTB, LDS_WS=2*NSLOT*SLOTB, LDS_OST=LDS_WS+NW*64*4, LDS_BYTES=LDS_OST+NW*4096;
constexpr float C2=0.125f*1.4426950408889634f;
__device__ __forceinline__ void glds16(const void*gsrc,unsigned lds_dst){unsigned keep;
  asm volatile("s_mov_b32 %0, m0\n\ts_mov_b32 m0, %2\n\ts_nop 0\n\tglobal_load_lds_dwordx4 %1, off\n\ts_mov_b32 m0, %0":"=&s"(keep):"v"(gsrc),"s"(lds_dst):"memory");}
__device__ __forceinline__ float max3f(float a,float b,float c){float r;asm("v_max3_f32 %0, %1, %2, %3":"=v"(r):"v"(a),"v"(b),"v"(c));return r;}
__device__ __forceinline__ float max2f(float a,float b){float r;asm("v_max_f32_e32 %0, %1, %2":"=v"(r):"v"(a),"v"(b));return r;}
__device__ __forceinline__ float fadd_s(float a,float b){float r;asm("v_add_f32_e32 %0, %1, %2":"=v"(r):"v"(a),"v"(b));return r;}
__device__ __forceinline__ float fsub_s(float a,float b){float r;asm("v_sub_f32_e32 %0, %1, %2":"=v"(r):"v"(a),"v"(b));return r;}
typedef float f32x2_t __attribute__((ext_vector_type(2))); typedef __bf16 bf16x2_t __attribute__((ext_vector_type(2)));
__device__ __forceinline__ unsigned cvtpk_s(float lo,float hi){f32x2_t v={lo,hi};bf16x2_t b=__builtin_convertvector(v,bf16x2_t);return __builtin_bit_cast(unsigned,b);}
#define WAIT_BAR(N) asm volatile("s_waitcnt vmcnt(" #N ") lgkmcnt(0)\n\ts_barrier":::"memory")

__device__ __forceinline__ void qkt(f32x16&p0,f32x16&p1,const char*Kslot,const bf16x8*qr,const f32x16&negm,int r32,int hi){
  const char*kb=Kslot+hi*1024+r32*16;
  #pragma unroll
  for(int d0=0;d0<4;++d0){
    const bf16x8 b0=*reinterpret_cast<const bf16x8*>(kb+d0*2048);
    const bf16x8 b1=*reinterpret_cast<const bf16x8*>(kb+d0*2048+512);
    if(d0==0){p0=__builtin_amdgcn_mfma_f32_32x32x16_bf16(b0,qr[0],negm,0,0,0);p1=__builtin_amdgcn_mfma_f32_32x32x16_bf16(b1,qr[0],negm,0,0,0);}
    else{p0=__builtin_amdgcn_mfma_f32_32x32x16_bf16(b0,qr[d0],p0,0,0,0);p1=__builtin_amdgcn_mfma_f32_32x32x16_bf16(b1,qr[d0],p1,0,0,0);}}
}
typedef __attribute__((address_space(3))) const char* lds_cptr;
typedef short v4i16_t __attribute__((ext_vector_type(4)));
__device__ __forceinline__ void kload8(bf16x8*kf,lds_cptr kp){
  kf[0]=*(const __attribute__((address_space(3))) bf16x8*)(kp);      kf[1]=*(const __attribute__((address_space(3))) bf16x8*)(kp+512);
  kf[2]=*(const __attribute__((address_space(3))) bf16x8*)(kp+2048); kf[3]=*(const __attribute__((address_space(3))) bf16x8*)(kp+2560);
  kf[4]=*(const __attribute__((address_space(3))) bf16x8*)(kp+4096); kf[5]=*(const __attribute__((address_space(3))) bf16x8*)(kp+4608);
  kf[6]=*(const __attribute__((address_space(3))) bf16x8*)(kp+6144); kf[7]=*(const __attribute__((address_space(3))) bf16x8*)(kp+6656);
}
__device__ __forceinline__ void kload2(bf16x8*kf,lds_cptr kp,int j){ kf[2*j]=*(const __attribute__((address_space(3))) bf16x8*)(kp+j*2048); kf[2*j+1]=*(const __attribute__((address_space(3))) bf16x8*)(kp+j*2048+512); }
__device__ __forceinline__ s16x4 vtr(lds_cptr p){ return __builtin_bit_cast(s16x4,__builtin_amdgcn_ds_read_tr16_b64_v4i16((__attribute__((address_space(3))) v4i16_t*)p)); }
__device__ __forceinline__ float rowmax(const f32x16&p0,const f32x16&p1){
  float a=max3f(p0[0],p0[1],p1[0]),b=max3f(p0[2],p0[3],p1[1]);a=max3f(a,p1[2],p1[3]);
  #pragma unroll
  for(int r=4;r<16;r+=4){a=max3f(a,p0[r],p0[r+1]);b=max3f(b,p0[r+2],p0[r+3]);a=max3f(a,p1[r],p1[r+1]);b=max3f(b,p1[r+2],p1[r+3]);}
  const float m=max2f(a,b);
  auto rr=__builtin_amdgcn_permlane32_swap(__float_as_uint(m),__float_as_uint(m),false,false);
  return max2f(__uint_as_float(rr[0]),__uint_as_float(rr[1]));
}
__device__ __forceinline__ void pv(f32x16*o,int vb,bf16x8 pa0,bf16x8 pa1,bf16x8 pa2,bf16x8 pa3){
  #pragma unroll
  for(int d0=0;d0<2;++d0){s16x4 lo[4],hi[4];
    #pragma unroll
    for(int ks=0;ks<4;++ks){
      asm volatile("ds_read_b64_tr_b16 %0,%1 offset:%c2":"=&v"(lo[ks]):"v"(vb),"i"(d0*4096+ks*1024):"memory");
      asm volatile("ds_read_b64_tr_b16 %0,%1 offset:%c2":"=&v"(hi[ks]):"v"(vb),"i"(d0*4096+ks*1024+512):"memory");}
    asm volatile("s_waitcnt lgkmcnt(0)":::"memory");SBAR();
    #define PK(k) (bf16x8){lo[k][0],lo[k][1],lo[k][2],lo[k][3],hi[k][0],hi[k][1],hi[k][2],hi[k][3]}
    o[d0]=__builtin_amdgcn_mfma_f32_32x32x16_bf16(pa0,PK(0),o[d0],0,0,0);
    o[d0]=__builtin_amdgcn_mfma_f32_32x32x16_bf16(pa1,PK(1),o[d0],0,0,0);
    o[d0]=__builtin_amdgcn_mfma_f32_32x32x16_bf16(pa2,PK(2),o[d0],0,0,0);
    o[d0]=__builtin_amdgcn_mfma_f32_32x32x16_bf16(pa3,PK(3),o[d0],0,0,0);
    #undef PK
  }
}

#ifndef ATTN_STORE16
#define ATTN_STORE16(p,v) (*(u32x4*)(p)=(v))
#endif
template<int THRL> __device__ __forceinline__ void attn_unit(int b,int qb,int qcol,int vcol,int ocol,const bf16*QK,const bf16*__restrict__ V,bf16*O,char*shm){
  int tid_=threadIdx.x; asm volatile("":"+v"(tid_));
  const int tid=tid_,lane=tid&63,r32=lane&31,hi=lane>>5; const int wid=__builtin_amdgcn_readfirstlane(tid>>6);
  const long rowbase=(long)b*SEQ; const int q0=qb*QB;
  const bf16*Qw=QK+(rowbase+q0+wid*QBLK)*PQ+qcol;
  const bf16*Kh=QK+rowbase*PK+1024+qcol,*Vh=V+rowbase*PV+vcol;
  const unsigned lds0=(unsigned)(uintptr_t)shm;
  float*wsf=(float*)(shm+LDS_WS)+wid*64;
  const bf16*ksrc=Kh+(long)lane*PK+wid*8;
  const bf16*vsrc=Vh+(long)(16*(wid&3)+(lane>>2))*PV+(wid>>2)*32+(lane&3)*8;
  const unsigned kdst=lds0+LDS_K+wid*1024, vdst=lds0+LDS_V+wid*1024;
  #define DMA_K(t,slot) glds16(ksrc+(long)(t)*KVBLK*PK,(unsigned)__builtin_amdgcn_readfirstlane(kdst+(slot)))
  #define DMA_V(t,slot) glds16(vsrc+(long)(t)*KVBLK*PV,(unsigned)__builtin_amdgcn_readfirstlane(vdst+(slot)))
  const int vb0=(int)(lds0+LDS_V)+((lane>>4)&1)*32+(lane&3)*8+(4*hi+((lane&15)>>2))*64;
  const char*Kbase=shm+LDS_K; bf16x8 kf[8];
  const lds_cptr shm3=(lds_cptr)shm; const lds_cptr kp0=shm3+LDS_K+hi*1024+r32*16; const lds_cptr vp0=shm3+LDS_V+((lane>>4)&1)*32+(lane&3)*8+(4*hi+((lane&15)>>2))*64;
  const int NT=(q0+QB)/KVBLK;
  DMA_K(0,0);DMA_V(0,0);DMA_K(1,SLOTB);
  bf16x8 qr[4];
  #pragma unroll
  for(int d0=0;d0<4;++d0)qr[d0]=*reinterpret_cast<const bf16x8*>(&Qw[(long)r32*PQ+d0*16+hi*8]);
  float mhat=0.f,l_reg=0.f;f32x16 o[2];o[0]=f32x16{};o[1]=f32x16{};f32x16 negm=f32x16{};asm volatile("":"+v"(negm));
  const int qrel=wid*QBLK+r32;
  #define CMASK(P0,P1,t) do{int jb_=(t)-(NT-4); if(jb_>=0)cmask(P0,P1,jb_,qrel,hi);}while(0)
  bool resc=false;
  #define START(P0,P1) do{ const float rm=rowmax(P0,P1); resc=false; \
    { const float dl=rm; mhat=fadd_s(mhat,dl); \
      _Pragma("unroll") for(int r=0;r<16;++r){P0[r]=fsub_s(P0[r],dl);P1[r]=fsub_s(P1[r],dl);} \
      _Pragma("unroll") for(int r=0;r<16;++r)negm[r]=-mhat; asm volatile("":"+v"(negm)); } \
    _Pragma("unroll") for(int r=0;r<16;++r)P0[r]=__builtin_amdgcn_exp2f(P0[r]); }while(0)
  #define RESC() do{ if(resc){ asm volatile("s_waitcnt lgkmcnt(0)":::"memory"); \
      _Pragma("unroll") for(int d_=0;d_<2;++d_) _Pragma("unroll") for(int r=0;r<16;++r)o[d_][r]*=wsf[crow(r,hi)]; } }while(0)
  f32x16 pA0,pA1,pB0,pB1;
  int sl_prev=0,sl_cur=0,sl_next=SLOTB;
  #define ROT() do{sl_prev=sl_cur;sl_cur=sl_next;sl_next=(sl_next==(NSLOT-1)*SLOTB)?0:sl_next+SLOTB;}while(0)
  DMA_K(2,2*SLOTB);
  WAIT_BAR(3);
  qkt(pA0,pA1,Kbase,qr,negm,r32,hi);asm volatile("s_nop 15\n\ts_nop 7":"+v"(pA0),"+v"(pA1));CMASK(pA0,pA1,0);
  START(pA0,pA1);
  _Pragma("unroll") for(int r=0;r<16;++r)pA1[r]=__builtin_amdgcn_exp2f(pA1[r]);
  WAIT_BAR(0);
  DMA_K(3,0);DMA_V(1,SLOTB);
  ROT();
  kload8(kf,kp0+sl_cur);
  WAIT_BAR(2);
  s16x4 vlo[8],vhi[8]; u32x4 pw0,pw1,pw2,pw3;
  #define PKW(P,B) cvtpk_s(P[B],P[B+1])
  #define PAF(k) __builtin_bit_cast(bf16x8,pw##k)
  #define VFR(i) (bf16x8){vlo[i][0],vlo[i][1],vlo[i][2],vlo[i][3],vhi[i][0],vhi[i][1],vhi[i][2],vhi[i][3]}
  #define PIN(x) asm volatile("":"+v"(x))
  #define MX3(a,b,c) __builtin_fmaxf(__builtin_fmaxf((a),(b)),(c))
  #define GAPA(MF,A0,A1,A2,A3,W0,W1,PW) do{ MF; sacc+=A0; sacc+=A1; sacc+=A2; sacc+=A3; PIN(sacc); W0; W1; PIN(PW); SBAR(); }while(0)
  #define EX(v) __builtin_amdgcn_exp2f(v)
  #define GAPB(MF,X,B) do{ MF; X[B]=EX(X[B]); X[B+1]=EX(X[B+1]); X[B+2]=EX(X[B+2]); X[B+3]=EX(X[B+3]); PIN(X); SBAR(); }while(0)
  #define VRD(i) do{ vlo[i]=vtr(vp_+(((i)>>2)*4096+((i)&3)*1024)); vhi[i]=vtr(vp_+(((i)>>2)*4096+((i)&3)*1024+512)); }while(0)
  #define KRD(G,j) do{ if(G){ kload2(kf,kp0+sl_next,j); SBAR(); } }while(0)
  #define STEP(C0,C1,P0,P1,t,GK,GV,GL) do{ SBAR(); \
    const lds_cptr vp_=vp0+sl_prev; \
    VRD(0); SBAR(); float sacc=(P0[0]+P0[1]); \
    GAPA(C0=__builtin_amdgcn_mfma_f32_32x32x16_bf16(kf[0],qr[0],negm,0,0,0), P0[2],P0[3],P0[4],P0[5],     pw0[0]=PKW(P0,0), pw0[1]=PKW(P0,2), pw0); \
    VRD(4); SBAR(); GAPA(C1=__builtin_amdgcn_mfma_f32_32x32x16_bf16(kf[1],qr[0],negm,0,0,0), P0[6],P0[7],P0[8],P0[9],     pw0[2]=PKW(P0,4), pw0[3]=PKW(P0,6), pw0); \
    VRD(1); SBAR(); GAPA(C0=__builtin_amdgcn_mfma_f32_32x32x16_bf16(kf[2],qr[1],C0,0,0,0),   P0[10],P0[11],P0[12],P0[13], pw1[0]=PKW(P0,8), pw1[1]=PKW(P0,10), pw1); \
    VRD(5); SBAR(); GAPA(C1=__builtin_amdgcn_mfma_f32_32x32x16_bf16(kf[3],qr[1],C1,0,0,0),   P0[14],P0[15],P1[0],P1[1],   pw1[2]=PKW(P0,12),pw1[3]=PKW(P0,14), pw1); \
    VRD(2); SBAR(); GAPA(C0=__builtin_amdgcn_mfma_f32_32x32x16_bf16(kf[4],qr[2],C0,0,0,0),   P1[2],P1[3],P1[4],P1[5],     pw2[0]=PKW(P1,0), pw2[1]=PKW(P1,2), pw2); \
    VRD(6); SBAR(); GAPA(C1=__builtin_amdgcn_mfma_f32_32x32x16_bf16(kf[5],qr[2],C1,0,0,0),   P1[6],P1[7],P1[8],P1[9],     pw2[2]=PKW(P1,4), pw2[3]=PKW(P1,6), pw2); \
    VRD(3); SBAR(); GAPA(C0=__builtin_amdgcn_mfma_f32_32x32x16_bf16(kf[6],qr[3],C0,0,0,0),   P1[10],P1[11],P1[12],P1[13], pw3[0]=PKW(P1,8), pw3[1]=PKW(P1,10), pw3); \
    VRD(7); SBAR(); GAPA(C1=__builtin_amdgcn_mfma_f32_32x32x16_bf16(kf[7],qr[3],C1,0,0,0),   P1[14],P1[15],0.f,0.f,       pw3[2]=PKW(P1,12),pw3[3]=PKW(P1,14), pw3); \
    l_reg+=sacc; \
    if(GK){DMA_K((t)+3,sl_cur);} if(GV){DMA_V((t)+1,sl_next);} \
    CMASK(C0,C1,t); \
    { float a=MX3(C0[0],C0[1],C1[0]),b=MX3(C0[2],C0[3],C1[1]); a=MX3(a,C1[2],C1[3]); \
      _Pragma("unroll") for(int r=4;r<16;r+=4){a=MX3(a,C0[r],C0[r+1]);b=MX3(b,C0[r+2],C0[r+3]);a=MX3(a,C1[r],C1[r+1]);b=MX3(b,C1[r+2],C1[r+3]);} \
      float rm=__builtin_fmaxf(a,b); { auto rr=__builtin_amdgcn_permlane32_swap(__float_as_uint(rm),__float_as_uint(rm),false,false); rm=__builtin_fmaxf(__uint_as_float(rr[0]),__uint_as_float(rr[1])); } \
      resc=false; \
      if(__builtin_expect(__any(rm>(float)THRL),0)){ const float dl=__builtin_fmaxf(rm,0.f); mhat+=dl; \
        _Pragma("unroll") for(int r=0;r<16;++r){C0[r]-=dl;C1[r]-=dl;} \
        _Pragma("unroll") for(int r=0;r<16;++r)negm[r]=-mhat; asm volatile("":"+v"(negm)); \
        const float f=__builtin_amdgcn_exp2f(-dl); l_reg*=f; if(hi==0)wsf[r32]=f; resc=true; } } \
    SBAR(); \
    GAPB(o[0]=__builtin_amdgcn_mfma_f32_32x32x16_bf16(PAF(0),VFR(0),o[0],0,0,0), C0,0); \
    GAPB(o[1]=__builtin_amdgcn_mfma_f32_32x32x16_bf16(PAF(0),VFR(4),o[1],0,0,0), C0,4); \
    KRD(GL,0); GAPB(o[0]=__builtin_amdgcn_mfma_f32_32x32x16_bf16(PAF(1),VFR(1),o[0],0,0,0), C0,8); \
    KRD(GL,1); GAPB(o[1]=__builtin_amdgcn_mfma_f32_32x32x16_bf16(PAF(1),VFR(5),o[1],0,0,0), C0,12); \
    KRD(GL,2); GAPB(o[0]=__builtin_amdgcn_mfma_f32_32x32x16_bf16(PAF(2),VFR(2),o[0],0,0,0), C1,0); \
    KRD(GL,3); GAPB(o[1]=__builtin_amdgcn_mfma_f32_32x32x16_bf16(PAF(2),VFR(6),o[1],0,0,0), C1,4); \
    GAPB(o[0]=__builtin_amdgcn_mfma_f32_32x32x16_bf16(PAF(3),VFR(3),o[0],0,0,0), C1,8); \
    GAPB(o[1]=__builtin_amdgcn_mfma_f32_32x32x16_bf16(PAF(3),VFR(7),o[1],0,0,0), C1,12); \
    }while(0)
  int t=1;
  #undef CMASK
  #define CMASK(P0,P1,t) do{}while(0)
  for(;t+5<NT;t+=2){
    STEP(pB0,pB1,pA0,pA1,t,true,true,true);     WAIT_BAR(2); RESC(); ROT();
    STEP(pA0,pA1,pB0,pB1,t+1,true,true,true);   WAIT_BAR(2); RESC(); ROT();
  }
  #undef CMASK
  #define CMASK(P0,P1,t) do{int jb_=(t)-(NT-4); if(jb_>=0)cmask(P0,P1,jb_,qrel,hi);}while(0)
  #define ENDW(tt) do{ if((tt)+3<NT){WAIT_BAR(2);} else if((tt)+2<NT){WAIT_BAR(1);} else {WAIT_BAR(0);} }while(0)
  for(;t+1<NT;t+=2){
    STEP(pB0,pB1,pA0,pA1,t,(t+3<NT),(t+1<NT),(t+1<NT));       ENDW(t);   RESC(); ROT();
    STEP(pA0,pA1,pB0,pB1,t+1,(t+4<NT),(t+2<NT),(t+2<NT));     ENDW(t+1); RESC(); ROT();
  }
  STEP(pB0,pB1,pA0,pA1,NT-1,false,false,false); RESC();
  { float sacc=pB0[0]+pB0[1]; _Pragma("unroll") for(int r=2;r<16;++r)sacc+=pB0[r]; _Pragma("unroll") for(int r=0;r<16;++r)sacc+=pB1[r]; l_reg+=sacc;
    pw0=(u32x4){PKW(pB0,0),PKW(pB0,2),PKW(pB0,4),PKW(pB0,6)};pw1=(u32x4){PKW(pB0,8),PKW(pB0,10),PKW(pB0,12),PKW(pB0,14)};pw2=(u32x4){PKW(pB1,0),PKW(pB1,2),PKW(pB1,4),PKW(pB1,6)};pw3=(u32x4){PKW(pB1,8),PKW(pB1,10),PKW(pB1,12),PKW(pB1,14)};
    SBAR(); pv(o,vb0+sl_cur,PAF(0),PAF(1),PAF(2),PAF(3)); }
  #undef PKW
  #undef PAF
  #undef VFR
  #undef PIN
  #undef MX3
  #undef GAPA
  #undef GAPB
  #undef EX
  #undef VRD
  #undef KRD
  #undef STEP
  #undef ENDW
  {auto rr=__builtin_amdgcn_permlane32_swap(__float_as_uint(l_reg),__float_as_uint(l_reg),false,false);l_reg=__uint_as_float(rr[0])+__uint_as_float(rr[1]);}
  if(hi==0)wsf[32+r32]=l_reg;asm volatile("s_waitcnt lgkmcnt(0)":::"memory");
  float rli[16];
  #pragma unroll
  for(int r=0;r<16;++r)rli[r]=__builtin_amdgcn_rcpf(wsf[32+crow(r,hi)]);
  bf16*Ow=O+(rowbase+q0+wid*QBLK)*PO+ocol;
  { bf16*stg=(bf16*)(shm+LDS_OST)+wid*2048;
    #pragma unroll
    for(int r=0;r<16;++r){const int orow=crow(r,hi);
      #pragma unroll
      for(int d0=0;d0<2;++d0)stg[orow*64+d0*32+r32]=__float2bfloat16(o[d0][r]*rli[r]);}
    asm volatile("s_waitcnt lgkmcnt(0)":::"memory");
    #pragma unroll
    for(int i=0;i<4;++i){const int row=i*8+(lane>>3),ch=lane&7; const u32x4 v=*(const u32x4*)(stg+row*64+ch*8); ATTN_STORE16(Ow+(long)row*PO+ch*8,v);} }
  asm volatile("s_waitcnt lgkmcnt(0)\n\ts_barrier":::"memory");
  #undef DMA_K
  #undef DMA_V
  #undef CMASK
  #undef START
  #undef RESC
  #undef ROT
}
constexpr int ATTN_LDS_BYTES=LDS_BYTES;
struct AttnTensors { const bf16* QK; const bf16* V; bf16* O; };
struct AttnUnit { int bh; int qb; };
struct StaticOrder {
  int vcu, G;
  __device__ __forceinline__ explicit StaticOrder(int grid,int vcu_):vcu(vcu_),G(grid){}
  __device__ __forceinline__ bool next(int i,AttnUnit&u)const{ const int L=i*G+vcu; if(L>=256*NQB)return false; u.bh=L&255; u.qb=NQB-1-(L>>8); return true; }
};
template<class Sched,int THRL=8> __device__ __forceinline__ void attn_phase(char*lds,const AttnTensors&T,const Sched&S,int vcol,int o1col,int o2col){
  AttnUnit u;
  for(int i=0;S.next(i,u);++i){
    const int b=u.bh>>5,vh=u.bh&31,h=vh>>2,c=(vh>>1)&1,vhalf=vh&1;
    attn_unit<THRL>(b,u.qb,h*128+c*64,vcol+h*128+vhalf*64,(c?o2col:o1col)+h*128+vhalf*64,T.QK,T.V,T.O,lds);
  }
}
#undef SBAR
#undef WAIT_BAR
}
constexpr size_t MiB = 1u << 20;
constexpr size_t WS_CTL = 0, CTL_ZERO_BYTES = 1 * MiB;
constexpr size_t WS_ADA = 1 * MiB;
constexpr size_t WS_WRT = 1 * MiB + 256 * 1024;
constexpr size_t WS_CNT = 1 * MiB + 512 * 1024;
constexpr size_t WS_TAB = 1 * MiB + 640 * 1024;
constexpr size_t WS_TOKE = 2 * MiB;
constexpr size_t WS_TOKW = 2 * MiB + 256 * 1024;
constexpr size_t WS_ROWTOK = 2 * MiB + 512 * 1024;
constexpr size_t WS_ROWW = 3 * MiB;
constexpr size_t WS_DT = 3 * MiB + 512 * 1024;
constexpr size_t WS_WIN = 8 * MiB;
constexpr size_t WS_WMG = 21 * MiB;
constexpr size_t WS_WOUT = 25 * MiB;
constexpr size_t WS_WGU = 27 * MiB;
constexpr size_t WS_WD = 91 * MiB;
constexpr size_t WS_U = 123 * MiB;
constexpr size_t WS_ACT = 187 * MiB;
constexpr size_t WS_HST = 459 * MiB;
constexpr size_t WS_END = 491 * MiB;
constexpr size_t WS_HBUF = WS_ACT;
constexpr int PROWS = 73728;
constexpr size_t WS_MOUT = WS_ACT + 72 * MiB;
static_assert(WS_HBUF + (size_t)PROWS * FF * 2 <= WS_MOUT && WS_MOUT + (size_t)T * 2 * D * 2 <= WS_HST && WS_ACT + (size_t)T * ACT_LD * 2 <= WS_HST, "d_ws map");
constexpr int CW_TMO = 0, CW_CODE = 1, CW_BAR = 4096;

constexpr int NWAVES = 8;
constexpr int RING_OFF = 0, RING_BYTES = 131072;
constexpr int LDSCTL_OFF = RING_BYTES, MISC_OFF = LDSCTL_OFF + 320;
constexpr int ROWS_OFF = RING_BYTES + 1024;
constexpr int LDS_BYTES = 147456;
static_assert(ROWS_OFF + 8 * 256 * 4 <= LDS_BYTES, "LDS map");

#define GAS __attribute__((address_space(1)))
#define LAS __attribute__((address_space(3)))
typedef unsigned short bf16;
typedef unsigned v4u __attribute__((ext_vector_type(4)));
typedef float f32x4 __attribute__((ext_vector_type(4)));
typedef short bf16x8 __attribute__((ext_vector_type(8)));
typedef GAS unsigned gu32;
typedef GAS unsigned long long gu64;
#define RLX_AGENT __ATOMIC_RELAXED, __HIP_MEMORY_SCOPE_AGENT
#define LDS_WAIT() asm volatile("s_waitcnt lgkmcnt(0)" ::: "memory")
#define VM_WAIT() asm volatile("s_waitcnt vmcnt(0)" ::: "memory")
__device__ __forceinline__ unsigned long long rt() { return __builtin_amdgcn_s_memrealtime(); }
__device__ __forceinline__ unsigned f2bf(float f) { unsigned u = __builtin_bit_cast(unsigned, f); return (u + 0x7fffu + ((u >> 16) & 1u)) >> 16; }
__device__ __forceinline__ unsigned pk2(float lo, float hi) { return f2bf(lo) | (f2bf(hi) << 16); }

#define XB_TMO      128
#define XB_XCNT(j)  (256  + 64 * (j))
#define XB_XSUB(j)  (1280 + 64 * (j))
#define XB_XGEN(j)  (2304 + 64 * (j))
#define XB_TOP      3328
#define XB_TOPGEN   3392
#define XCD_BAR_WORDS 3456
#define XB_SPIN_CAP (1u << 18)

__device__ __forceinline__ unsigned xb_ld(unsigned* p)              { return __hip_atomic_load(p, __ATOMIC_RELAXED, __HIP_MEMORY_SCOPE_AGENT); }
__device__ __forceinline__ unsigned xb_add(unsigned* p, unsigned v) { return __hip_atomic_fetch_add(p, v, __ATOMIC_RELAXED, __HIP_MEMORY_SCOPE_AGENT); }
__device__ __forceinline__ unsigned xb_xcc_id() { return (unsigned)__builtin_amdgcn_s_getreg((3 << 11) | 20) & 0xFu; }
#define XB_SPIN(cond, bar) do { unsigned _sp = 0; while (cond) { __builtin_amdgcn_s_sleep(1); \
    if ((++_sp & 255u) == 0u) { if (xb_ld(&(bar)[XB_TMO])) break; if (_sp > XB_SPIN_CAP) { atomicAdd(&(bar)[XB_TMO], 1u); break; } } } } while (0)

struct XcdBarrier {
    unsigned* bar; unsigned x;
    volatile LAS unsigned* st;
};

__device__ __forceinline__ XcdBarrier xcd_barrier_post(unsigned* bar, volatile LAS unsigned* st) {
    XcdBarrier b; b.bar = bar; b.x = xb_xcc_id(); b.st = st;
    if (threadIdx.x == 0) (void)xb_add(&bar[XB_XCNT(b.x)], 1u);
    return b;
}
__device__ __forceinline__ void xcd_barrier_complete(unsigned* bar, unsigned x, unsigned& nloc, unsigned& nx) {
    const unsigned G = gridDim.x * gridDim.y * gridDim.z;
    unsigned sum, cnt, mine, sp = 0u;
    for (;;) {
        sum = 0u; cnt = 0u; mine = 0u;
#pragma unroll
        for (unsigned j = 0; j < 16; ++j) { const unsigned c = xb_ld(&bar[XB_XCNT(j)]); sum += c; cnt += (c > 0u) ? 1u : 0u; mine = (j == x) ? c : mine; }
        if (sum == G) break;
        __builtin_amdgcn_s_sleep(1);
        if ((++sp & 255u) == 0u) { if (xb_ld(&bar[XB_TMO])) break; if (sp > XB_SPIN_CAP) { atomicAdd(&bar[XB_TMO], 1u); break; } }
    }
    nloc = mine > 0u ? mine : 1u; nx = cnt > 0u ? cnt : 1u;
}

__device__ __forceinline__ void xcd_barrier(const XcdBarrier& b) {
    asm volatile("s_waitcnt vmcnt(0)" ::: "memory");
    __syncthreads();
    if (threadIdx.x == 0) {
        unsigned* bar = b.bar;
        __builtin_amdgcn_s_waitcnt(0);
        unsigned nloc = b.st[0], nx = b.st[1];
        if (nloc == 0u) { xcd_barrier_complete(bar, b.x, nloc, nx); b.st[0] = nloc; b.st[1] = nx; }
        const unsigned old = xb_add(&bar[XB_XSUB(b.x)], 1u);
        const unsigned gen = old / nloc;
        if (old + 1u == (gen + 1u) * nloc) {
            __builtin_amdgcn_fence(__ATOMIC_RELEASE, "agent");
            asm volatile("s_waitcnt vmcnt(0)" ::: "memory");
            const unsigned og = xb_add(&bar[XB_TOP], 1u);
            const unsigned tg = og / nx;
            if (og + 1u == (tg + 1u) * nx) xb_add(&bar[XB_TOPGEN], 1u);
            else XB_SPIN(xb_ld(&bar[XB_TOPGEN]) == tg, bar);
            __builtin_amdgcn_fence(__ATOMIC_ACQUIRE, "agent");
            xb_add(&bar[XB_XGEN(b.x)], 1u);
            asm volatile("s_waitcnt vmcnt(0)" ::: "memory");
        } else {
            XB_SPIN(xb_ld(&bar[XB_XGEN(b.x)]) == gen, bar);
            __builtin_amdgcn_fence(__ATOMIC_ACQUIRE, "agent");
            asm volatile("s_waitcnt vmcnt(0)" ::: "memory");
        }
    }
    __syncthreads();
}

typedef float f32x16 __attribute__((ext_vector_type(16)));
typedef short s16x4 __attribute__((ext_vector_type(4)));
typedef unsigned v2u __attribute__((ext_vector_type(2)));
using pg8::cvt_pk_bf16; using pg8::bf_lo; using pg8::bf_hi; using pg8::sigmoidf_;
__device__ __forceinline__ float wave_sum(float v) {
#pragma unroll
    for (int o = 1; o < 64; o <<= 1) v += __shfl_xor(v, o);
    return v;
}
__device__ __forceinline__ float dot4(f32x4 a, f32x4 b) { return (a.x * b.x + a.y * b.y) + (a.z * b.z + a.w * b.w); }

struct MapIn { bf16* win; bf16* wmg;
    __device__ __forceinline__ bf16* operator()(int n) const {
        if (n < 3072) return win + (size_t)n * D;
        if (n < 3088) return win + (size_t)(6144 + n - 3072) * D;
        if (n < 5136) { const int c = n - 3088, blk = c >> 6, d = c & 63, g = (d & 31) >> 2, e = (d & 3) + ((d >> 5) << 2); return win + (size_t)(3072 + blk * 64 + 8 * g + e) * D; }
        if (n < 6160) return win + (size_t)(5120 + n - 5136) * D;
        const int c = n - 6160, j = c & 1023, half = c >> 10; return wmg + (size_t)(8 * (j >> 2) + 4 * half + (j & 3)) * D; } };
struct MapPlain { bf16* w; int K;
    __device__ __forceinline__ bf16* operator()(int n) const { return w + (size_t)n * K; } };
struct MapIl { bf16* w; int half;
    __device__ __forceinline__ bf16* operator()(int n) const { return w + (size_t)(8 * (n >> 2) + 4 * half + (n & 3)) * D; } };
template <class MapFn>
__device__ __forceinline__ void p0_transpose_item(const float* W, int K, int N, LAS float* scr, int item, int lane, const MapFn& map) {
    const int nblk = (N + 31) / 32, kb = item / nblk, nb = item % nblk, k0 = 64 * kb, n0 = 32 * nb;
    const int nn = n0 + (lane & 31);
#pragma unroll 8
    for (int i = 0; i < 32; ++i) { const int kk = 2 * i + (lane >> 5); scr[kk * 33 + (lane & 31)] = (nn < N) ? W[(size_t)(k0 + kk) * N + nn] : 0.f; }
    LDS_WAIT(); asm volatile("" ::: "memory");
    const int c = lane & 7;
#pragma unroll
    for (int j = 0; j < 4; ++j) { const int nl = (lane >> 3) + 8 * j; const LAS float* s = scr + (8 * c) * 33 + nl;
        v4u o; o.x = pk2(s[0 * 33], s[1 * 33]); o.y = pk2(s[2 * 33], s[3 * 33]); o.z = pk2(s[4 * 33], s[5 * 33]); o.w = pk2(s[6 * 33], s[7 * 33]);
        if (n0 + nl < N) *(GAS v4u*)(map(n0 + nl) + k0 + 8 * c) = o; }
    LDS_WAIT(); asm volatile("" ::: "memory");
}

struct Ptrs {
    const float *x, *c, *w_ada, *b_ada, *w_in, *wg2, *bg2, *gnw, *lq1, *lk1, *lq2, *lk2, *dnw, *w_out, *ln1w, *ln1b, *wrg, *brg, *wre, *bre, *weg, *weu, *wed, *ln2w, *ln2b;
    const int* pos;
    float* out;
    float *ada, *wrt, *tokw, *roww, *dt, *hst;
    int *cnt, *tab, *toke, *rowtok;
    bf16 *win, *wmg, *wout, *wgu, *wd, *u, *act, *hbuf, *mout, *dqk;
};

__device__ __forceinline__ void p0_prologue(const Ptrs& P, LAS unsigned char* lds, int vcu, int G, int tid, int lane, int wave) {
    if (vcu < 192) {
        LAS float* sc = (LAS float*)(lds + RING_OFF);
        LAS float* red = (LAS float*)(lds + RING_OFF + 32768);
        for (int i = tid; i < 8 * D; i += NWAVES * 64) { const float v = P.c[i]; sc[i] = v / (1.f + __expf(-v)); }
        __syncthreads();
        for (int item = vcu; item < 192; item += G) {
            const int col = item * 32 + (tid & 31), kg = tid >> 5;
            float a[8];
#pragma unroll
            for (int b = 0; b < 8; ++b) a[b] = 0.f;
#pragma unroll 8
            for (int i = 0; i < 64; ++i) { const int k = kg + 16 * i; const float w = P.w_ada[(size_t)k * (6 * D) + col];
#pragma unroll
                for (int b = 0; b < 8; ++b) a[b] += sc[b * D + k] * w; }
#pragma unroll
            for (int b = 0; b < 8; ++b) red[(kg * 8 + b) * 32 + (tid & 31)] = a[b];
            __syncthreads();
            if (tid < 256) { const int b = tid >> 5, cc = tid & 31; float s = 0.f;
#pragma unroll
                for (int q = 0; q < 16; ++q) s += red[(q * 8 + b) * 32 + cc];
                P.ada[(size_t)b * (6 * D) + item * 32 + cc] = s + P.b_ada[item * 32 + cc]; }
            __syncthreads();
        }
    }
    const int gt = vcu * (NWAVES * 64) + tid, NT = G * NWAVES * 64;
    for (int i = gt; i < 36 * D; i += NT) { const int cc = i >> 10, k = i & 1023; P.wrt[i] = cc < 4 ? P.wrg[k * 4 + cc] : P.wre[k * 32 + (cc - 4)]; }
    for (int i = gt; i < 240 * D / 8; i += NT) *(GAS v4u*)(P.win + (size_t)6160 * D + (size_t)i * 8) = (v4u){0u, 0u, 0u, 0u};
    LAS float* scr = (LAS float*)(lds + RING_OFF + wave * 16384);
    const int gw = vcu * NWAVES + wave, NGW = G * NWAVES;
    constexpr int I_IN = 16 * 257, I_OUT = 16 * 32, I_E = 16 * 16, I_D = 8 * 32;
    constexpr int NITEMS = I_IN + I_OUT + NEXP * (2 * I_E + I_D);
    for (int it = gw; it < NITEMS; it += NGW) {
        int r = it;
        if (r < I_IN) { p0_transpose_item(P.w_in, D, IN_COLS, scr, r, lane, MapIn{P.win, P.wmg}); continue; } r -= I_IN;
        if (r < I_OUT) { p0_transpose_item(P.w_out, D, D, scr, r, lane, MapPlain{P.wout, D}); continue; } r -= I_OUT;
        if (r < NEXP * I_E) { const int e = r / I_E; p0_transpose_item(P.weg + (size_t)e * D * FF, D, FF, scr, r % I_E, lane, MapIl{P.wgu + (size_t)e * 1024 * D, 0}); continue; } r -= NEXP * I_E;
        if (r < NEXP * I_E) { const int e = r / I_E; p0_transpose_item(P.weu + (size_t)e * D * FF, D, FF, scr, r % I_E, lane, MapIl{P.wgu + (size_t)e * 1024 * D, 1}); continue; } r -= NEXP * I_E;
        { const int e = r / I_D; p0_transpose_item(P.wed + (size_t)e * FF * D, FF, D, scr, r % I_D, lane, MapPlain{P.wd + (size_t)e * D * FF, FF}); }
    }
}

__device__ __forceinline__ void p1_ln_mod(const Ptrs& P, int gw, int NGW, int lane) {
    for (int m = gw; m < T; m += NGW) {
        const int b = m / SEQ;
        const GAS f32x4* xr = (const GAS f32x4*)(P.x + (size_t)m * D) + lane;
        f32x4 v[4]; float s = 0.f;
#pragma unroll
        for (int j = 0; j < 4; ++j) { v[j] = xr[64 * j]; s += (v[j].x + v[j].y) + (v[j].z + v[j].w); }
        const float mean = wave_sum(s) * (1.f / D); float s2 = 0.f;
#pragma unroll
        for (int j = 0; j < 4; ++j) { v[j] = v[j] - mean; s2 += dot4(v[j], v[j]); }
        const float rstd = 1.f / sqrtf(wave_sum(s2) * (1.f / D) + LN_EPS);
        const f32x4* sh = (const f32x4*)(P.ada + (size_t)b * 6 * D) + lane; const f32x4* sl = (const f32x4*)(P.ada + (size_t)b * 6 * D + D) + lane;
        GAS v2u* o8 = (GAS v2u*)(P.u + (size_t)m * D) + lane;
#pragma unroll
        for (int j = 0; j < 4; ++j) { const f32x4 a = sh[64 * j], c = sl[64 * j]; const f32x4 uu = v[j] * rstd * (c + 1.f) + a;
            v2u w; w.x = cvt_pk_bf16(uu.x, uu.y); w.y = cvt_pk_bf16(uu.z, uu.w); o8[64 * j] = w; }
    }
}

namespace gla {
constexpr int QT_LD = 136, KD_LD = 72, VT_LD = 72, AT_LD = 72, OS_LD = 260;
constexpr int L_QT = 0, L_KT = L_QT + 64 * QT_LD * 2, L_KDT = L_KT + 64 * QT_LD * 2, L_VT = L_KDT + 128 * KD_LD * 2, L_AT = L_VT + 256 * VT_LD * 2, L_GL = L_AT + 64 * AT_LD * 2,
              L_SEG = L_GL + 64 * 16 * 4, L_DEC = L_SEG + 4 * 128 * 4, L_END = L_DEC + 128 * 4, L_OS = 0;
static_assert(L_END <= RING_BYTES && 64 * OS_LD * 4 <= L_AT, "GLA LDS map");
__device__ __forceinline__ int crow(int reg, int h) { return (reg & 3) + 8 * (reg >> 2) + 4 * h; }
#define MFMA32(a, b, c) __builtin_amdgcn_mfma_f32_32x32x16_bf16((a), (b), (c), 0, 0, 0)
#define MFMA16(a, b, c) __builtin_amdgcn_mfma_f32_16x16x32_bf16((a), (b), (c), 0, 0, 0)
template <bool OUT>
__device__ __forceinline__ void gla_unit(LAS unsigned char* lds, const Ptrs& P, int b, int h, int sc) {
    const int tid = threadIdx.x, lane = tid & 63, wid = __builtin_amdgcn_readfirstlane(tid >> 6), r = lane & 31, hh = lane >> 5;
    const int d = tid & 127, seg = tid >> 7;
    LAS bf16* QT = (LAS bf16*)(lds + L_QT); LAS bf16* KT = (LAS bf16*)(lds + L_KT); LAS bf16* KDT = (LAS bf16*)(lds + L_KDT); LAS bf16* VT = (LAS bf16*)(lds + L_VT); LAS bf16* AT = (LAS bf16*)(lds + L_AT);
    LAS float* GL = (LAS float*)(lds + L_GL); LAS float* SEG = (LAS float*)(lds + L_SEG); LAS float* DEC = (LAS float*)(lds + L_DEC); LAS float* OS = (LAS float*)(lds + L_OS);
    bf16* act = P.act;
    float wg[16];
#pragma unroll
    for (int q = 0; q < 16; ++q) wg[q] = P.wg2[q * 512 + h * 128 + d];
    const float bias = P.bg2[h * 128 + d];
    const int bhs = (b * 4 + h) * 8 + sc;
    float* Hp = P.hst + (size_t)bhs * (128 * 256);
    f32x16 S[4];
#pragma unroll
    for (int i = 0; i < 4; ++i)
#pragma unroll
        for (int g = 0; g < 16; ++g) S[i][g] = OUT ? Hp[(32 * i + crow(g, hh)) * 256 + 32 * wid + r] : 0.f;
    float dsum = 0.f;
    for (int n = 0; n < 8; ++n) {
        const size_t row0 = (size_t)b * SEQ + sc * 512 + n * 64;
        if (tid < 128) { const int rw = tid >> 1, hf = tid & 1; const v4u g = *(const GAS v4u*)(act + (row0 + rw) * ACT_LD + AC_GR + hf * 8); LAS float* gl = GL + rw * 16 + hf * 8;
            gl[0] = bf_lo(g.x); gl[1] = bf_hi(g.x); gl[2] = bf_lo(g.y); gl[3] = bf_hi(g.y); gl[4] = bf_lo(g.z); gl[5] = bf_hi(g.z); gl[6] = bf_lo(g.w); gl[7] = bf_hi(g.w); }
        { const int rw = tid >> 3, cb = (tid & 7) * 32; const bf16* vp = act + (row0 + rw) * ACT_LD + AC_GV + h * 256 + cb;
#pragma unroll
            for (int q4 = 0; q4 < 4; ++q4) { const v4u vv = *(const GAS v4u*)(vp + q4 * 8); LAS bf16* dst = VT + (cb + q4 * 8) * VT_LD + rw;
                dst[0 * VT_LD] = (bf16)(vv.x & 0xffffu); dst[1 * VT_LD] = (bf16)(vv.x >> 16); dst[2 * VT_LD] = (bf16)(vv.y & 0xffffu); dst[3 * VT_LD] = (bf16)(vv.y >> 16);
                dst[4 * VT_LD] = (bf16)(vv.z & 0xffffu); dst[5 * VT_LD] = (bf16)(vv.z >> 16); dst[6 * VT_LD] = (bf16)(vv.w & 0xffffu); dst[7 * VT_LD] = (bf16)(vv.w >> 16); } }
        __syncthreads();
        float bc[16]; float run = 0.f;
#pragma unroll
        for (int i = 0; i < 16; ++i) { const LAS float* gl = GL + (seg * 16 + i) * 16; float lg = bias;
#pragma unroll
            for (int q = 0; q < 16; ++q) lg += gl[q] * wg[q];
            const float ls = (fminf(lg, 0.f) - __logf(1.f + __expf(-fabsf(lg)))) * (1.f / 16.f); run += ls; bc[i] = run; }
        SEG[seg * 128 + d] = run;
        __syncthreads();
        float off = 0.f, tot = 0.f;
#pragma unroll
        for (int s = 0; s < 4; ++s) { const float v = SEG[s * 128 + d]; off += (s < seg) ? v : 0.f; tot += v; }
        unsigned kdw[8];
#pragma unroll
        for (int i = 0; i < 16; i += 2) {
            float kd2[2];
#pragma unroll
            for (int e = 0; e < 2; ++e) { const int rowl = seg * 16 + i + e; const float bi = off + bc[i + e];
                const float kraw = __uint_as_float((unsigned)act[(row0 + rowl) * ACT_LD + AC_GK + h * 128 + d] << 16);
                kd2[e] = kraw * __expf(tot - bi);
                if (OUT) { const float qraw = __uint_as_float((unsigned)act[(row0 + rowl) * ACT_LD + AC_GQ + h * 128 + d] << 16);
                    QT[rowl * QT_LD + d] = (bf16)f2bf(qraw * 0.08838834764831845f * __expf(bi)); KT[rowl * QT_LD + d] = (bf16)f2bf(kraw * __expf(-bi)); } }
            kdw[i >> 1] = cvt_pk_bf16(kd2[0], kd2[1]);
        }
        *(LAS v4u*)(KDT + d * KD_LD + seg * 16) = (v4u){kdw[0], kdw[1], kdw[2], kdw[3]};
        *(LAS v4u*)(KDT + d * KD_LD + seg * 16 + 8) = (v4u){kdw[4], kdw[5], kdw[6], kdw[7]};
        if (seg == 0) { DEC[d] = __expf(tot); dsum += tot; }
        __syncthreads();
        f32x16 o[2];
        if (OUT) {
            const int fr = lane & 15, fq = lane >> 4;
#pragma unroll
            for (int tt = 0; tt < 2; ++tt) { const int t = 2 * wid + tt, mi = t >> 2, nj = t & 3; f32x4 a4 = (f32x4){0.f, 0.f, 0.f, 0.f};
                if (nj <= mi) {
#pragma unroll
                    for (int s = 0; s < 4; ++s) { const bf16x8 a = *(const LAS bf16x8*)(QT + (16 * mi + fr) * QT_LD + 32 * s + 8 * fq); const bf16x8 bb = *(const LAS bf16x8*)(KT + (16 * nj + fr) * QT_LD + 32 * s + 8 * fq); a4 = MFMA16(a, bb, a4); } }
#pragma unroll
                for (int g = 0; g < 4; ++g) { const int row = 16 * mi + 4 * fq + g, col = 16 * nj + fr; AT[row * AT_LD + col] = (bf16)f2bf(col <= row ? a4[g] : 0.f); } }
            __syncthreads();
            bf16x8 Sp[4][2];
#pragma unroll
            for (int i = 0; i < 4; ++i)
#pragma unroll
                for (int s = 0; s < 2; ++s) { v4u w; w.x = cvt_pk_bf16(S[i][8 * s + 0], S[i][8 * s + 1]); w.y = cvt_pk_bf16(S[i][8 * s + 2], S[i][8 * s + 3]); w.z = cvt_pk_bf16(S[i][8 * s + 4], S[i][8 * s + 5]); w.w = cvt_pk_bf16(S[i][8 * s + 6], S[i][8 * s + 7]); Sp[i][s] = __builtin_bit_cast(bf16x8, w); }
#pragma unroll
            for (int mt = 0; mt < 2; ++mt) {
#pragma unroll
                for (int g = 0; g < 16; ++g) o[mt][g] = 0.f;
#pragma unroll
                for (int ks = 0; ks < 4; ++ks) if (mt == 1 || ks < 2) { const bf16x8 a = *(const LAS bf16x8*)(AT + (32 * mt + r) * AT_LD + 16 * ks + 8 * hh); const bf16x8 bb = *(const LAS bf16x8*)(VT + (32 * wid + r) * VT_LD + 16 * ks + 8 * hh); o[mt] = MFMA32(a, bb, o[mt]); }
#pragma unroll
                for (int i = 0; i < 4; ++i)
#pragma unroll
                    for (int s = 0; s < 2; ++s) { const s16x4 lo = *(const LAS s16x4*)(QT + (32 * mt + r) * QT_LD + 32 * i + 16 * s + 4 * hh); const s16x4 hi = *(const LAS s16x4*)(QT + (32 * mt + r) * QT_LD + 32 * i + 16 * s + 8 + 4 * hh);
                        const bf16x8 a = __builtin_shufflevector(lo, hi, 0, 1, 2, 3, 4, 5, 6, 7); o[mt] = MFMA32(a, Sp[i][s], o[mt]); }
            }
        }
#pragma unroll
        for (int i = 0; i < 4; ++i) {
#pragma unroll
            for (int g = 0; g < 16; ++g) S[i][g] *= DEC[32 * i + crow(g, hh)];
#pragma unroll
            for (int ks = 0; ks < 4; ++ks) { const bf16x8 a = *(const LAS bf16x8*)(KDT + (32 * i + r) * KD_LD + 16 * ks + 8 * hh); const bf16x8 bb = *(const LAS bf16x8*)(VT + (32 * wid + r) * VT_LD + 16 * ks + 8 * hh); S[i] = MFMA32(a, bb, S[i]); }
        }
        __syncthreads();
        if (OUT) {
#pragma unroll
            for (int mt = 0; mt < 2; ++mt)
#pragma unroll
                for (int g = 0; g < 16; ++g) OS[(32 * mt + crow(g, hh)) * OS_LD + 32 * wid + r] = o[mt][g];
            __syncthreads();
            const int rowl = tid >> 3, part = tid & 7; const LAS float* orow = OS + rowl * OS_LD + part * 32;
            f32x4 ov[8]; float ss = 0.f;
#pragma unroll
            for (int q = 0; q < 8; ++q) { ov[q] = *(const LAS f32x4*)(orow + 4 * q); ss += dot4(ov[q], ov[q]); }
            ss += __shfl_xor(ss, 1); ss += __shfl_xor(ss, 2); ss += __shfl_xor(ss, 4);
            const float rstd = 1.f / sqrtf(ss * (1.f / 256.f) + RMS_EPS);
            bf16* orp = act + (row0 + rowl) * ACT_LD + AC_OGLA + h * 256 + part * 32; const bf16* gop = act + (row0 + rowl) * ACT_LD + AC_GO + h * 256 + part * 32; const float* nw = P.gnw + part * 32;
#pragma unroll
            for (int q4 = 0; q4 < 4; ++q4) { const v4u gg = *(const GAS v4u*)(gop + q4 * 8); const f32x4 w0 = *(const f32x4*)(nw + q4 * 8), w1 = *(const f32x4*)(nw + q4 * 8 + 4); const f32x4 a0 = ov[2 * q4] * rstd * w0, a1 = ov[2 * q4 + 1] * rstd * w1;
                const float g0 = bf_lo(gg.x), g1 = bf_hi(gg.x), g2 = bf_lo(gg.y), g3 = bf_hi(gg.y), g4 = bf_lo(gg.z), g5 = bf_hi(gg.z), g6 = bf_lo(gg.w), g7 = bf_hi(gg.w);
                v4u w; w.x = cvt_pk_bf16(a0.x * g0 * sigmoidf_(g0), a0.y * g1 * sigmoidf_(g1)); w.y = cvt_pk_bf16(a0.z * g2 * sigmoidf_(g2), a0.w * g3 * sigmoidf_(g3));
                w.z = cvt_pk_bf16(a1.x * g4 * sigmoidf_(g4), a1.y * g5 * sigmoidf_(g5)); w.w = cvt_pk_bf16(a1.z * g6 * sigmoidf_(g6), a1.w * g7 * sigmoidf_(g7));
                *(GAS v4u*)(orp + q4 * 8) = w; }
            __syncthreads();
        }
    }
    if (!OUT) {
#pragma unroll
        for (int i = 0; i < 4; ++i)
#pragma unroll
            for (int g = 0; g < 16; ++g) Hp[(32 * i + crow(g, hh)) * 256 + 32 * wid + r] = S[i][g];
        if (seg == 0) P.dt[bhs * 128 + d] = __expf(dsum);
    }
}
__device__ __forceinline__ void gla_scan(const Ptrs& P, int gt, int NT) {
    for (int v = gt; v < 32 * 128 * 64; v += NT) {
        const int bh = v >> 13, rem = v & 8191, dk = rem >> 6, dv4 = rem & 63;
        f32x4 s = (f32x4){0.f, 0.f, 0.f, 0.f};
#pragma unroll
        for (int sc = 0; sc < 8; ++sc) { GAS f32x4* p = (GAS f32x4*)(P.hst + ((size_t)(bh * 8 + sc) * 128 + dk) * 256) + dv4;
            f32x4 hv = (f32x4){0.f, 0.f, 0.f, 0.f}; float dd = 0.f; if (sc < 7) { hv = *p; dd = P.dt[(bh * 8 + sc) * 128 + dk]; }
            *p = s; s = s * dd + hv; }
    }
}
#undef MFMA32
#undef MFMA16
}

__device__ __forceinline__ void p7_combine(const Ptrs& P, int gw, int NGW, int lane) {
    const float s1 = wave_sum(P.lq1[lane] * P.lk1[lane]), s2 = wave_sum(P.lq2[lane] * P.lk2[lane]);
    const float lam = expf(s1) - expf(s2) + LAM_INIT;
    f32x4 nw[4];
#pragma unroll
    for (int q = 0; q < 4; ++q) nw[q] = *(const f32x4*)(P.dnw + ((16 * lane) & 127) + 4 * q) * (1.f - LAM_INIT);
    for (int m = gw; m < T; m += NGW) {
        bf16* rp = P.act + (size_t)m * ACT_LD + 16 * lane;
        const v4u a0 = *(const GAS v4u*)(rp + AC_O1), a1 = *(const GAS v4u*)(rp + AC_O1 + 8), b0 = *(const GAS v4u*)(rp + AC_O2), b1 = *(const GAS v4u*)(rp + AC_O2 + 8);
        float v[16];
        v[0] = bf_lo(a0.x) - lam * bf_lo(b0.x); v[1] = bf_hi(a0.x) - lam * bf_hi(b0.x); v[2] = bf_lo(a0.y) - lam * bf_lo(b0.y); v[3] = bf_hi(a0.y) - lam * bf_hi(b0.y);
        v[4] = bf_lo(a0.z) - lam * bf_lo(b0.z); v[5] = bf_hi(a0.z) - lam * bf_hi(b0.z); v[6] = bf_lo(a0.w) - lam * bf_lo(b0.w); v[7] = bf_hi(a0.w) - lam * bf_hi(b0.w);
        v[8] = bf_lo(a1.x) - lam * bf_lo(b1.x); v[9] = bf_hi(a1.x) - lam * bf_hi(b1.x); v[10] = bf_lo(a1.y) - lam * bf_lo(b1.y); v[11] = bf_hi(a1.y) - lam * bf_hi(b1.y);
        v[12] = bf_lo(a1.z) - lam * bf_lo(b1.z); v[13] = bf_hi(a1.z) - lam * bf_hi(b1.z); v[14] = bf_lo(a1.w) - lam * bf_lo(b1.w); v[15] = bf_hi(a1.w) - lam * bf_hi(b1.w);
        float ss = 0.f;
#pragma unroll
        for (int e = 0; e < 16; ++e) ss += v[e] * v[e];
        ss += __shfl_xor(ss, 1); ss += __shfl_xor(ss, 2); ss += __shfl_xor(ss, 4);
        const float rstd = 1.f / sqrtf(ss * (1.f / 128.f) + RMS_EPS);
        v4u w0, w1;
        w0.x = cvt_pk_bf16(v[0] * rstd * nw[0].x, v[1] * rstd * nw[0].y); w0.y = cvt_pk_bf16(v[2] * rstd * nw[0].z, v[3] * rstd * nw[0].w); w0.z = cvt_pk_bf16(v[4] * rstd * nw[1].x, v[5] * rstd * nw[1].y); w0.w = cvt_pk_bf16(v[6] * rstd * nw[1].z, v[7] * rstd * nw[1].w);
        w1.x = cvt_pk_bf16(v[8] * rstd * nw[2].x, v[9] * rstd * nw[2].y); w1.y = cvt_pk_bf16(v[10] * rstd * nw[2].z, v[11] * rstd * nw[2].w); w1.z = cvt_pk_bf16(v[12] * rstd * nw[3].x, v[13] * rstd * nw[3].y); w1.w = cvt_pk_bf16(v[14] * rstd * nw[3].z, v[15] * rstd * nw[3].w);
        *(GAS v4u*)(rp + AC_ODIFF) = w0; *(GAS v4u*)(rp + AC_ODIFF + 8) = w1;
    }
}

__device__ __forceinline__ void p10_ln_router(const Ptrs& P, LAS unsigned char* lds, int vcu, int gw, int NGW, int tid, int lane) {
    LAS int* hist = (LAS int*)(lds + RING_OFF);
    if (tid < 32) hist[tid] = 0;
    __syncthreads();
    for (int m = gw; m < T; m += NGW) {
        const int b = m / SEQ;
        GAS f32x4* xr = (GAS f32x4*)(P.out + (size_t)m * D) + lane;
        f32x4 v[4]; float s = 0.f;
#pragma unroll
        for (int j = 0; j < 4; ++j) { v[j] = xr[64 * j]; s += (v[j].x + v[j].y) + (v[j].z + v[j].w); }
        float mean = wave_sum(s) * (1.f / D), s2 = 0.f;
#pragma unroll
        for (int j = 0; j < 4; ++j) { v[j] = v[j] - mean; s2 += dot4(v[j], v[j]); }
        float rstd = 1.f / sqrtf(wave_sum(s2) * (1.f / D) + LN_EPS);
        s = 0.f;
#pragma unroll
        for (int j = 0; j < 4; ++j) { const f32x4 w = *((const f32x4*)P.ln1w + lane + 64 * j), bb = *((const f32x4*)P.ln1b + lane + 64 * j); v[j] = v[j] * rstd * w + bb; xr[64 * j] = v[j]; s += (v[j].x + v[j].y) + (v[j].z + v[j].w); }
        mean = wave_sum(s) * (1.f / D); s2 = 0.f;
#pragma unroll
        for (int j = 0; j < 4; ++j) { v[j] = v[j] - mean; s2 += dot4(v[j], v[j]); }
        rstd = 1.f / sqrtf(wave_sum(s2) * (1.f / D) + LN_EPS);
        const f32x4* sh = (const f32x4*)(P.ada + (size_t)b * 6 * D + 3 * D) + lane; const f32x4* sl = (const f32x4*)(P.ada + (size_t)b * 6 * D + 4 * D) + lane;
        GAS v2u* o8 = (GAS v2u*)(P.u + (size_t)m * D) + lane;
#pragma unroll
        for (int j = 0; j < 4; ++j) { const f32x4 a = sh[64 * j], c = sl[64 * j]; v[j] = v[j] * rstd * (c + 1.f) + a;
            v2u w; w.x = cvt_pk_bf16(v[j].x, v[j].y); w.y = cvt_pk_bf16(v[j].z, v[j].w); o8[64 * j] = w; }
        LAS float* lgs = (LAS float*)(lds + RING_OFF + 1024) + (tid >> 6) * 64;
#pragma unroll 2
        for (int c = 0; c < 36; ++c) { const f32x4* wp = (const f32x4*)(P.wrt + (size_t)c * D) + lane; float a = 0.f;
#pragma unroll
            for (int j = 0; j < 4; ++j) a += dot4(v[j], wp[64 * j]);
            a = wave_sum(a); if (lane == 0) lgs[c] = a + (c < 4 ? P.brg[c] : P.bre[c - 4]); }
        LDS_WAIT(); asm volatile("" ::: "memory");
        float lg[4], le[32];
#pragma unroll
        for (int c = 0; c < 4; ++c) lg[c] = lgs[c];
#pragma unroll
        for (int c = 0; c < 32; ++c) le[c] = lgs[4 + c];
        asm volatile("" ::: "memory");
        int g = 0; float gm = lg[0];
#pragma unroll
        for (int c = 1; c < 4; ++c) if (lg[c] > gm) { gm = lg[c]; g = c; }
        float gs = 0.f;
#pragma unroll
        for (int c = 0; c < 4; ++c) gs += expf(lg[c] - gm);
        const float wgrp = 1.f / gs;
        float es[8];
#pragma unroll
        for (int i = 0; i < 8; ++i) es[i] = g == 0 ? le[i] : (g == 1 ? le[8 + i] : (g == 2 ? le[16 + i] : le[24 + i]));
        int i0 = 0; float v0 = es[0];
#pragma unroll
        for (int i = 1; i < 8; ++i) if (es[i] > v0) { v0 = es[i]; i0 = i; }
        int i1 = -1; float v1 = -INFINITY;
#pragma unroll
        for (int i = 0; i < 8; ++i) if (i != i0 && es[i] > v1) { v1 = es[i]; i1 = i; }
        const float p1 = 1.f / (1.f + expf(v0 - v1)), p0 = 1.f - p1;
        if (lane == 0) { const int e0 = g * 8 + i0, e1 = g * 8 + i1;
            P.toke[2 * m] = e0; P.toke[2 * m + 1] = e1; P.tokw[2 * m] = wgrp * p0; P.tokw[2 * m + 1] = wgrp * p1;
            __hip_atomic_fetch_add(hist + e0, 1, __ATOMIC_RELAXED, __HIP_MEMORY_SCOPE_WORKGROUP); __hip_atomic_fetch_add(hist + e1, 1, __ATOMIC_RELAXED, __HIP_MEMORY_SCOPE_WORKGROUP); }
    }
    __syncthreads();
    if (tid < 32) P.cnt[vcu * 32 + tid] = hist[tid];
}

__device__ __forceinline__ void p11_dispatch(const Ptrs& P, LAS unsigned char* lds, int vcu, int G, int gw, int NGW, int tid, int lane) {
    LAS int* tot = (LAS int*)(lds + RING_OFF); LAS int* base = tot + 32; LAS int* cur = tot + 64; LAS int* pst = tot + 96;
    if (tid < 32) { int total = 0, mine = 0;
        for (int w = 0; w < G; ++w) { const int c = P.cnt[w * 32 + tid]; mine += (w < vcu) ? c : 0; total += c; }
        tot[tid] = total; base[tid] = mine; cur[tid] = 0; }
    __syncthreads();
    if (tid == 0) { int p = 0, nt = 0;
        for (int e = 0; e < 32; ++e) { pst[e] = p; const int nte = (tot[e] + 255) >> 8;
            for (int k = 0; k < nte; ++k) { if (vcu == 0) { P.tab[1 + nt] = e; P.tab[1 + pg8::TILE_MAX + nt] = p + 256 * k; } ++nt; }
            p += nte * 256; }
        pst[32] = p; if (vcu == 0) P.tab[0] = nt; }
    __syncthreads();
    for (int m = gw; m < T; m += NGW) {
        if (lane < 2) { const int e = P.toke[2 * m + lane]; const int pos = pst[e] + base[e] + __hip_atomic_fetch_add(cur + e, 1, __ATOMIC_RELAXED, __HIP_MEMORY_SCOPE_WORKGROUP);
            P.rowtok[pos] = 2 * m + lane; P.roww[pos] = P.tokw[2 * m + lane]; }
    }
    if (vcu < 32) { const int e = vcu, lim = pst[e + 1] - pst[e];
        for (int r = tot[e] + tid; r < lim; r += NWAVES * 64) { P.rowtok[pst[e] + r] = -1; P.roww[pst[e] + r] = 0.f; } }
}

__device__ __forceinline__ void p14_final(const Ptrs& P, int gw, int NGW, int lane) {
    for (int m = gw; m < T; m += NGW) {
        const int b = m / SEQ;
        GAS f32x4* xr = (GAS f32x4*)(P.out + (size_t)m * D) + lane;
        const GAS v2u* m0 = (const GAS v2u*)(P.mout + (size_t)(2 * m) * D) + lane; const GAS v2u* m1 = (const GAS v2u*)(P.mout + (size_t)(2 * m + 1) * D) + lane;
        const f32x4* g2 = (const f32x4*)(P.ada + (size_t)b * 6 * D + 5 * D) + lane;
        f32x4 v[4]; float s = 0.f;
#pragma unroll
        for (int j = 0; j < 4; ++j) { const v2u a = m0[64 * j], c = m1[64 * j]; const f32x4 mm = (f32x4){bf_lo(a.x) + bf_lo(c.x), bf_hi(a.x) + bf_hi(c.x), bf_lo(a.y) + bf_lo(c.y), bf_hi(a.y) + bf_hi(c.y)};
            v[j] = xr[64 * j] * ALPHA + g2[64 * j] * mm; s += (v[j].x + v[j].y) + (v[j].z + v[j].w); }
        const float mean = wave_sum(s) * (1.f / D); float s2 = 0.f;
#pragma unroll
        for (int j = 0; j < 4; ++j) { v[j] = v[j] - mean; s2 += dot4(v[j], v[j]); }
        const float rstd = 1.f / sqrtf(wave_sum(s2) * (1.f / D) + LN_EPS);
#pragma unroll
        for (int j = 0; j < 4; ++j) { const f32x4 w = *((const f32x4*)P.ln2w + lane + 64 * j), bb = *((const f32x4*)P.ln2b + lane + 64 * j); xr[64 * j] = v[j] * rstd * w + bb; }
    }
}

constexpr int NPH = 15;
constexpr int N_LAUNCHES = MK_N_LAUNCHES;
static_assert(N_LAUNCHES == 1 || N_LAUNCHES == NPH, "MK_N_LAUNCHES is 1 or 15");
struct Args { const void* in[26]; float* out; unsigned char* ws; int ph_lo, ph_hi; };
__global__ void __launch_bounds__(NWAVES * 64, 2) fwd_kernel(Args args) {
    extern __shared__ __attribute__((aligned(16))) unsigned char lds_raw[];
    LAS unsigned char* lds = (LAS unsigned char*)lds_raw;
    volatile LAS unsigned* MISC = (volatile LAS unsigned*)(lds + MISC_OFF);
    const int tid = threadIdx.x, lane = tid & 63, wave = __builtin_amdgcn_readfirstlane(tid >> 6);
    const int G = gridDim.x; const int bx = blockIdx.x; const int vcu = (G % 8 == 0) ? (bx % 8) * (G / 8) + bx / 8 : bx;
    const int gw = vcu * NWAVES + wave, NGW = G * NWAVES;
    unsigned char* ws = args.ws;
    gu32* ctl = (gu32*)(ws + WS_CTL);
    Ptrs P;
    P.x = (const float*)args.in[0]; P.c = (const float*)args.in[1]; P.pos = (const int*)args.in[2]; P.w_ada = (const float*)args.in[3]; P.b_ada = (const float*)args.in[4]; P.w_in = (const float*)args.in[5];
    P.wg2 = (const float*)args.in[6]; P.bg2 = (const float*)args.in[7]; P.gnw = (const float*)args.in[8]; P.lq1 = (const float*)args.in[9]; P.lk1 = (const float*)args.in[10]; P.lq2 = (const float*)args.in[11]; P.lk2 = (const float*)args.in[12];
    P.dnw = (const float*)args.in[13]; P.w_out = (const float*)args.in[14]; P.ln1w = (const float*)args.in[15]; P.ln1b = (const float*)args.in[16]; P.wrg = (const float*)args.in[17]; P.brg = (const float*)args.in[18];
    P.wre = (const float*)args.in[19]; P.bre = (const float*)args.in[20]; P.weg = (const float*)args.in[21]; P.weu = (const float*)args.in[22]; P.wed = (const float*)args.in[23]; P.ln2w = (const float*)args.in[24]; P.ln2b = (const float*)args.in[25];
    P.out = args.out;
    P.ada = (float*)(ws + WS_ADA); P.wrt = (float*)(ws + WS_WRT); P.tokw = (float*)(ws + WS_TOKW); P.roww = (float*)(ws + WS_ROWW); P.dt = (float*)(ws + WS_DT); P.hst = (float*)(ws + WS_HST);
    P.cnt = (int*)(ws + WS_CNT); P.tab = (int*)(ws + WS_TAB); P.toke = (int*)(ws + WS_TOKE); P.rowtok = (int*)(ws + WS_ROWTOK);
    P.win = (bf16*)(ws + WS_WIN); P.wmg = (bf16*)(ws + WS_WMG); P.wout = (bf16*)(ws + WS_WOUT); P.wgu = (bf16*)(ws + WS_WGU); P.wd = (bf16*)(ws + WS_WD); P.u = (bf16*)(ws + WS_U); P.act = (bf16*)(ws + WS_ACT);
    P.hbuf = (bf16*)(ws + WS_HBUF); P.mout = (bf16*)(ws + WS_MOUT); P.dqk = (bf16*)args.out;
    for (int u = tid; u < (LDS_BYTES - LDSCTL_OFF) / 4; u += NWAVES * 64) ((LAS unsigned*)(lds + LDSCTL_OFF))[u] = 0u;
    __syncthreads();
    XcdBarrier bar; bar.bar = (unsigned*)(ctl + CW_BAR); bar.x = 0; bar.st = nullptr;
    if (N_LAUNCHES == 1) bar = xcd_barrier_post((unsigned*)(ctl + CW_BAR), MISC + 8);
#define GRID_BAR() do { if (N_LAUNCHES == 1) xcd_barrier(bar); } while (0)
    const int lo = args.ph_lo, hi = args.ph_hi;
#ifndef PHASE_MASK
#define PHASE_MASK 0x7fff
#endif
#define IN(k) ((((PHASE_MASK) >> (k)) & 1) && lo <= (k) && (k) < hi)
#define SEAM(k) do { if (IN(k) && IN((k) + 1)) GRID_BAR(); } while (0)

    if (IN(0)) { p0_prologue(P, lds, vcu, G, tid, lane, wave); __syncthreads(); }
    SEAM(0);
    if (IN(1)) { p1_ln_mod(P, gw, NGW, lane); }
    SEAM(1);
    if (IN(2)) {
        pg8::DenseProb Q; Q.init(P.u, D, P.win, T, N1, D, G, bx);
        pg8::EpiProj E{P.act, P.dqk, P.pos};
        pg8::gemm_phase<pg8::EpiProj, pg8::DenseProb, true>(lds + RING_OFF, Q, E);
    }
    SEAM(2);
    if (IN(3)) { for (int u = vcu; u < 256; u += G) { const int b = u >> 5, h = (u >> 3) & 3, sc = u & 7; if (sc < 7) gla::gla_unit<false>(lds + RING_OFF, P, b, h, sc); } }
    SEAM(3);
    if (IN(4)) { gla::gla_scan(P, vcu * (NWAVES * 64) + tid, G * NWAVES * 64); }
    SEAM(4);
    if (IN(5)) { for (int u = vcu; u < 256; u += G) { const int b = u >> 5, h = (u >> 3) & 3, sc = u & 7; gla::gla_unit<true>(lds + RING_OFF, P, b, h, sc); } }
    SEAM(5);
    if (IN(6)) {
        const attn_body::AttnTensors AT{(const attn_body::bf16*)P.dqk, (const attn_body::bf16*)P.act, (attn_body::bf16*)P.act};
        const attn_body::StaticOrder S(G, vcu);
        attn_body::attn_phase<attn_body::StaticOrder>((char*)lds_raw + RING_OFF, AT, S, AC_DV, AC_O1, AC_O2);
    }
    SEAM(6);
    if (IN(7)) { p7_combine(P, gw, NGW, lane); }
    SEAM(7);
    if (IN(8)) {
        pg8::DenseProb Q; Q.init(P.u, D, P.wmg, T, 2048, D, G, bx);
        pg8::EpiMerge E{P.act};
        pg8::gemm_phase<pg8::EpiMerge, pg8::DenseProb, true>(lds + RING_OFF, Q, E);
    }
    SEAM(8);
    if (IN(9)) {
        pg8::DenseProb Q; Q.init(P.act + AC_MERGED, ACT_LD, P.wout, T, D, D, G, bx);
        pg8::EpiX1 E{P.x, P.ada, P.out};
        pg8::gemm_phase<pg8::EpiX1, pg8::DenseProb, true>(lds + RING_OFF, Q, E);
    }
    SEAM(9);
    if (IN(10)) { p10_ln_router(P, lds, vcu, gw, NGW, tid, lane); __syncthreads(); }
    SEAM(10);
    if (IN(11)) { p11_dispatch(P, lds, vcu, G, gw, NGW, tid, lane); __syncthreads(); }
    SEAM(11);
    if (IN(12)) {
        LAS int* rows = (LAS int*)(lds + ROWS_OFF);
        pg8::MoeProb<true> Q; Q.A = (const char*)P.u; Q.Bt = (const char*)P.wgu; Q.lda = D; Q.K = D; Q.G = G; Q.c = vcu; Q.tab = P.tab; Q.rows = rows; Q.bstride = (size_t)1024 * D * 2;
        { pg8::Unit un; for (int i = 0; i < 8 && Q.next(i, un); ++i) if (tid < 256) { const int rt = P.rowtok[un.row0 + tid]; rows[i * 256 + tid] = rt < 0 ? 0 : (rt >> 1); } }
        __syncthreads();
        pg8::EpiUp E{P.hbuf};
        pg8::gemm_phase<pg8::EpiUp, pg8::MoeProb<true>, true>(lds + RING_OFF, Q, E);
    }
    SEAM(12);
    if (IN(13)) {
        pg8::MoeProb<false> Q; Q.A = (const char*)P.hbuf; Q.Bt = (const char*)P.wd; Q.lda = FF; Q.K = FF; Q.G = G; Q.c = vcu; Q.tab = P.tab; Q.rows = nullptr; Q.bstride = (size_t)D * FF * 2;
        pg8::EpiDown E{P.mout, P.rowtok, P.roww};
        pg8::gemm_phase<pg8::EpiDown, pg8::MoeProb<false>, true>(lds + RING_OFF, Q, E);
    }
    SEAM(13);
    if (IN(14)) { p14_final(P, gw, NGW, lane); }
#undef IN
#undef SEAM
#undef GRID_BAR
}

extern "C" void kernel_launch(void* const* d_in, const int* in_sizes, int n_in, void* d_out, int out_size, void* d_ws, size_t ws_size, hipStream_t stream) {
    static int grid = 0;
    if (grid == 0) {
        if (n_in != 26 || in_sizes[0] != T * D || out_size != T * D || ws_size < WS_END) { fprintf(stderr, "kernel_launch: unexpected shapes (n_in %d, in0 %d, out %d, ws %zu < %zu); nothing launched\n", n_in, n_in > 0 ? in_sizes[0] : -1, out_size, ws_size, (size_t)WS_END); grid = -1; return; }
        int dev = 0, cus = 0, per_cu = 0;
        if (hipGetDevice(&dev) != hipSuccess || hipDeviceGetAttribute(&cus, hipDeviceAttributeMultiprocessorCount, dev) != hipSuccess) { fprintf(stderr, "kernel_launch: device query failed\n"); grid = -1; return; }
        if (hipFuncSetAttribute((const void*)fwd_kernel, hipFuncAttributeMaxDynamicSharedMemorySize, LDS_BYTES) != hipSuccess) { fprintf(stderr, "kernel_launch: hipFuncSetAttribute failed\n"); grid = -1; return; }
        if (hipOccupancyMaxActiveBlocksPerMultiprocessor(&per_cu, (const void*)fwd_kernel, NWAVES * 64, LDS_BYTES) != hipSuccess || per_cu < 1)
            fprintf(stderr, "kernel_launch: note: occupancy query reports %d workgroups per CU\n", per_cu);
        (void)hipGetLastError();
        grid = cus;
    }
    if (grid < 0) return;
    if (hipMemsetAsync((char*)d_ws + WS_CTL, 0, CTL_ZERO_BYTES, stream) != hipSuccess) { fprintf(stderr, "kernel_launch: hipMemsetAsync failed\n"); return; }
    Args a{};
    for (int i = 0; i < 26; ++i) a.in[i] = d_in[i];
    a.out = (float*)d_out; a.ws = (unsigned char*)d_ws;
    for (int li = 0; li < N_LAUNCHES; ++li) {
        a.ph_lo = (N_LAUNCHES == 1) ? 0 : li; a.ph_hi = (N_LAUNCHES == 1) ? NPH : li + 1;
        hipLaunchKernelGGL(fwd_kernel, dim3(grid), dim3(NWAVES * 64), LDS_BYTES, stream, a);
        const hipError_t le = hipPeekAtLastError();
        if (le != hipSuccess) { fprintf(stderr, "kernel_launch: launch %d failed: %s\n", li, hipGetErrorName(le)); break; }
    }
}
```

```cpp
#include <hip/hip_runtime.h>
#include <hip/hip_bf16.h>
#include <cstdio>
#include <cstdint>
#include <cmath>

#ifndef MK_N_LAUNCHES
#define MK_N_LAUNCHES 1
#endif

namespace pg8 {
#define PG8_LAS __attribute__((address_space(3)))
typedef unsigned short bf16_t;
typedef short bf16x8 __attribute__((ext_vector_type(8)));
typedef float f32x4 __attribute__((ext_vector_type(4)));
typedef float f32x2 __attribute__((ext_vector_type(2)));
typedef unsigned u32x4 __attribute__((ext_vector_type(4)));
typedef unsigned u32x2 __attribute__((ext_vector_type(2)));
constexpr int BM = 256, BK = 64, HALF = 128, HTB = HALF * BK * 2  , STAGE_BYTES = 8 * HTB, NXCD = 8, WGM = 8;

__host__ __device__ __forceinline__ int lds_byte(int r, int c) { const int st = (r >> 4) * 2 + (c >> 5), rr = r & 15, cc = c & 31, ob = rr * 64 + cc * 2; return st * 1024 + (ob ^ (((ob >> 9) & 1) << 5)); }
__host__ __device__ __forceinline__ void stage_rc(int b, int& R, int& C) { const int st = b / 1024, sb = b % 1024, swz = sb ^ (((sb >> 9) & 1) << 5); R = (st >> 1) * 16 + swz / 64; C = (st & 1) * 32 + (swz % 64) / 2; }
__host__ __device__ __forceinline__ int perm32(int rho) { const int n = rho >> 4, i = rho & 15; return 8 * (i >> 2) + 4 * n + (i & 3); }

struct Unit { int pm, pn, e, row0; };

struct DenseProb {
    const char* A; const char* Bt; int lda, K; int nM, nN, nwg, G, c;
    __device__ __forceinline__ void init(const void* A_, int lda_, const void* Bt_, int M, int N, int K_, int G_, int c_) { A = (const char*)A_; Bt = (const char*)Bt_; lda = lda_; K = K_; nM = M / BM; nN = N / BM; nwg = nM * nN; G = G_; c = c_; }
    __device__ __forceinline__ bool next(int i, Unit& u) const {
        const long L = (long)i * G + c; if (L >= nwg) return false;
        int wgid = (int)L; { const int q = nwg / NXCD, r = nwg % NXCD, xcd = wgid % NXCD, off = wgid / NXCD; wgid = (xcd < r ? xcd * (q + 1) : r * (q + 1) + (xcd - r) * q) + off; }
        const int nig = WGM * nN, gid = wgid / nig, fm = gid * WGM, gsz = (nM - fm) < WGM ? (nM - fm) : WGM;
        u.pm = fm + ((wgid % nig) % gsz); u.pn = (wgid % nig) / gsz; u.e = 0; u.row0 = u.pm * BM; return true;
    }
    __device__ __forceinline__ void a_voff(const Unit& u, const int (&R)[2], const int (&C)[2], unsigned (&v)[4]) const {
#pragma unroll
        for (int h = 0; h < 2; ++h)
#pragma unroll
            for (int i = 0; i < 2; ++i) v[h * 2 + i] = (unsigned)((u.row0 + h * HALF + R[i]) * lda + C[i]) * 2u;
    }
    __device__ __forceinline__ size_t b_off(const Unit& u) const { return (size_t)u.pn * BM * K * 2; }
};

__device__ __forceinline__ unsigned cvt_pk_bf16(float lo, float hi) { typedef __bf16 bf16x2_t __attribute__((ext_vector_type(2))); f32x2 v = {lo, hi}; bf16x2_t b = __builtin_convertvector(v, bf16x2_t); return __builtin_bit_cast(unsigned, b); }
__device__ __forceinline__ float bf_lo(unsigned w) { return __uint_as_float(w << 16); }
__device__ __forceinline__ float bf_hi(unsigned w) { return __uint_as_float(w & 0xffff0000u); }
__device__ __forceinline__ float sigmoidf_(float x) { return __builtin_amdgcn_rcpf(1.f + __builtin_amdgcn_exp2f(x * -1.4426950408889634f)); }

__device__ __forceinline__ unsigned xr8(unsigned v) { return (unsigned)__builtin_amdgcn_update_dpp(0, (int)v, 0x128, 0xf, 0xf, false); }
__device__ __forceinline__ void store_pair16(bf16_t* pA, size_t row8, const u32x4 c0, const u32x4 c1, bool lo) {
    u32x4 dA, dB;
#pragma unroll
    for (int e = 0; e < 4; ++e) { const unsigned rcv = xr8(lo ? c1[e] : c0[e]); dA[e] = lo ? c0[e] : rcv; dB[e] = lo ? rcv : c1[e]; }
    *(u32x4*)pA = dA; *(u32x4*)(pA + row8) = dB;
}

template <class Epi, class Prob, bool ALIGN_EPI, bool C64 = false>
__device__ __forceinline__ void gemm_phase(PG8_LAS unsigned char* lds, const Prob& P, const Epi& E) {
    const int tid = threadIdx.x, wid = __builtin_amdgcn_readfirstlane(tid >> 6), lane = tid & 63, wr = wid >> 2, wc = wid & 3, fr = lane & 15, fq = lane >> 4;
    const int K = P.K, nt = K / BK;
    int sR[2], sC[2]; unsigned voffB[2];
#pragma unroll
    for (int i = 0; i < 2; ++i) { int R, C; stage_rc(tid * 16 + i * 8192, R, C); const int Rb = C64 ? (R >> 5) * 64 + perm32(R & 31) : (R & ~31) + perm32(R & 31); sR[i] = R; sC[i] = C; voffB[i] = (unsigned)(Rb * K + C) * 2u; }
    const size_t kstep = (size_t)(BK * 2);
    const size_t hstepB = (size_t)(C64 ? 32 : HALF) * K * 2;
    const unsigned ldsw = (unsigned)wid * 1024u;
    const int aoff = lds_byte(wr * 64 + fr, fq * 8), boff = lds_byte(wc * 32 + fr, fq * 8);
#define PG8_SA(b, h) (((b) * 2 + (h)) * HTB)
#define PG8_SB(b, h) ((4 + (b) * 2 + (h)) * HTB)
#define PG8_STAGE(bufoff, gbase, voff) do { _Pragma("unroll") for (int _i = 0; _i < 2; ++_i) \
        __builtin_amdgcn_global_load_lds((const unsigned*)((const char*)(gbase) + (voff)[_i]), (PG8_LAS unsigned*)(lds + (bufoff) + ldsw + _i * 8192), 16, 0, 0); } while (0)
#define PG8_STAGE_A(bufoff, kofs, V, h) do { _Pragma("unroll") for (int _i = 0; _i < 2; ++_i) \
        __builtin_amdgcn_global_load_lds((const unsigned*)(P.A + (kofs) + (V)[(h) * 2 + _i]), (PG8_LAS unsigned*)(lds + (bufoff) + ldsw + _i * 8192), 16, 0, 0); } while (0)
#define PG8_LDA(dst, b, h) do { _Pragma("unroll") for (int m = 0; m < 4; ++m) _Pragma("unroll") for (int k = 0; k < 2; ++k) dst[m][k] = *(const PG8_LAS bf16x8*)(lds + PG8_SA(b, h) + aoff + m * 2048 + k * 1024); } while (0)
#define PG8_LDB(dst, b, h) do { _Pragma("unroll") for (int n = 0; n < 2; ++n) _Pragma("unroll") for (int k = 0; k < 2; ++k) dst[n][k] = *(const PG8_LAS bf16x8*)(lds + PG8_SB(b, h) + boff + n * 2048 + k * 1024); } while (0)
#define PG8_MMA(ai, bj, At, Bt) do { __builtin_amdgcn_s_setprio(1); _Pragma("unroll") for (int m = 0; m < 4; ++m) _Pragma("unroll") for (int n = 0; n < 2; ++n) _Pragma("unroll") for (int k = 0; k < 2; ++k) \
        acc[ai][bj][m][n] = __builtin_amdgcn_mfma_f32_16x16x32_bf16(Bt[n][k], At[m][k], acc[ai][bj][m][n], 0, 0, 0); __builtin_amdgcn_s_setprio(0); } while (0)
#define PG8_WAIT_V(n) asm volatile("s_waitcnt vmcnt(" #n ")" ::: "memory")
#define PG8_WAIT_L(n) asm volatile("s_waitcnt lgkmcnt(" #n ")" ::: "memory")
#define PG8_BAR __builtin_amdgcn_s_barrier()
#define PG8_SCHED __builtin_amdgcn_sched_barrier(0)
    Unit cur, nxt; int ui = 0;
    if (!P.next(0, cur)) return;
    f32x4 acc[2][2][4][2];
#pragma unroll
    for (int a = 0; a < 2; ++a)
#pragma unroll
        for (int b = 0; b < 2; ++b)
#pragma unroll
            for (int m = 0; m < 4; ++m)
#pragma unroll
                for (int n = 0; n < 2; ++n) acc[a][b][m][n] = (f32x4){0.f, 0.f, 0.f, 0.f};
    bf16x8 At[4][2], B0[2][2], B1[2][2];
    unsigned vc[4], vn[4];
    P.a_voff(cur, sR, sC, vc);
    const char* cB = P.Bt + P.b_off(cur);
    PG8_STAGE(PG8_SB(0, 0), cB, voffB); PG8_STAGE(PG8_SB(0, 1), cB + hstepB, voffB); PG8_STAGE_A(PG8_SA(0, 0), 0, vc, 0); PG8_STAGE_A(PG8_SA(0, 1), 0, vc, 1);
    if (wr == 1) PG8_BAR;
    PG8_WAIT_V(2); PG8_BAR;
    PG8_STAGE(PG8_SB(1, 0), cB + kstep, voffB); PG8_STAGE_A(PG8_SA(1, 0), kstep, vc, 0); PG8_STAGE(PG8_SB(1, 1), cB + hstepB + kstep, voffB);
    PG8_WAIT_V(6); PG8_BAR;
    for (;;) {
        const bool has_next = P.next(ui + 1, nxt);
        const char* nB = cB;
        if (has_next) { P.a_voff(nxt, sR, sC, vn); nB = P.Bt + P.b_off(nxt); }
        else {
#pragma unroll
            for (int q = 0; q < 4; ++q) vn[q] = vc[q];
        }
        for (int t = 0; t < nt; t += 2) {
            const bool last = (t == nt - 2);
            const size_t ka1 = (size_t)(t + 1) * kstep;
            const size_t ka2 = last ? (size_t)0 : (size_t)(t + 2) * kstep, ka3 = ka2 + kstep;
            const char* b2 = last ? nB : cB + (size_t)(t + 2) * kstep; const char* b3 = b2 + kstep;
            unsigned v2[4];
#pragma unroll
            for (int q = 0; q < 4; ++q) v2[q] = last ? vn[q] : vc[q];
            PG8_LDB(B0, 0, 0); PG8_LDB(B1, 0, 1); PG8_SCHED; PG8_LDA(At, 0, 0); PG8_STAGE_A(PG8_SA(1, 1), ka1, vc, 1);
            PG8_WAIT_V(8); PG8_WAIT_L(0); PG8_BAR; PG8_MMA(0, 0, At, B0); PG8_MMA(0, 1, At, B1); PG8_BAR; PG8_SCHED;
            PG8_LDA(At, 0, 1); PG8_STAGE(PG8_SB(0, 0), b2, voffB); PG8_STAGE(PG8_SB(0, 1), b2 + hstepB, voffB); PG8_STAGE_A(PG8_SA(0, 0), ka2, v2, 0);
            PG8_WAIT_V(8); PG8_WAIT_L(0); PG8_BAR; PG8_MMA(1, 0, At, B0); PG8_MMA(1, 1, At, B1); PG8_BAR; PG8_SCHED;
            PG8_LDB(B0, 1, 0); PG8_LDB(B1, 1, 1); PG8_SCHED; PG8_LDA(At, 1, 0); PG8_STAGE_A(PG8_SA(0, 1), ka2, v2, 1);
            PG8_WAIT_V(8); PG8_WAIT_L(0); PG8_BAR; PG8_MMA(0, 0, At, B0); PG8_MMA(0, 1, At, B1); PG8_BAR; PG8_SCHED;
            PG8_LDA(At, 1, 1); PG8_STAGE(PG8_SB(1, 0), b3, voffB); PG8_STAGE(PG8_SB(1, 1), b3 + hstepB, voffB); PG8_STAGE_A(PG8_SA(1, 0), ka3, v2, 0);
            PG8_WAIT_V(8); PG8_WAIT_L(0); PG8_BAR; PG8_MMA(1, 0, At, B0); PG8_MMA(1, 1, At, B1); PG8_BAR; PG8_SCHED;
        }
        if constexpr (ALIGN_EPI) { if (wr == 0) PG8_BAR; }
        E(acc, cur, wr, wc, fr, fq);
        if (!has_next) break;
#pragma unroll
        for (int a = 0; a < 2; ++a)
#pragma unroll
            for (int b = 0; b < 2; ++b)
#pragma unroll
                for (int m = 0; m < 4; ++m)
#pragma unroll
                    for (int n = 0; n < 2; ++n) acc[a][b][m][n] = (f32x4){0.f, 0.f, 0.f, 0.f};
        cur = nxt; cB = nB; ++ui;
#pragma unroll
        for (int q = 0; q < 4; ++q) vc[q] = vn[q];
        if constexpr (ALIGN_EPI) { if (wr == 1) PG8_BAR; }
    }
    PG8_WAIT_V(0);
    if constexpr (!ALIGN_EPI) { if (wr == 0) PG8_BAR; }
    PG8_BAR;
#undef PG8_SA
#undef PG8_SB
#undef PG8_STAGE
#undef PG8_STAGE_A
#undef PG8_LDA
#undef PG8_LDB
#undef PG8_MMA
#undef PG8_WAIT_V
#undef PG8_WAIT_L
#undef PG8_BAR
#undef PG8_SCHED
}
}
constexpr int BATCH = 8, SEQ = 4096, D = 1024, T = BATCH * SEQ;
constexpr int IN_COLS = 8208;
constexpr int NEXP = 32, FF = 512;
constexpr float LN_EPS = 1e-5f, RMS_EPS = 1e-6f, ALPHA = 1.189207115002721f, LAM_INIT = 0.2f;
constexpr float ATT_C2 = 0.125f * 1.4426950408889634f;
constexpr int ACT_LD = 4352, AC_GQ = 0, AC_GK = 512, AC_GV = 1024, AC_GO = 2048, AC_DV = 3072, AC_GR = 4096;
constexpr int AC_O1 = 0, AC_O2 = 2048, AC_OGLA = 1024, AC_ODIFF = 0, AC_MERGED = 3072, AC_Y = 2048;
constexpr int DQK_LD = 2048;
constexpr int N1 = 32 * 256;

namespace pg8 {
struct EpiProj {
    bf16_t* act1; bf16_t* dqk; const int* pos; unsigned char* gates;
    __device__ __forceinline__ static unsigned q8(const f32x4 v) {
        const unsigned b0 = (unsigned)__builtin_rintf(sigmoidf_(v[0]) * 255.f), b1 = (unsigned)__builtin_rintf(sigmoidf_(v[1]) * 255.f), b2 = (unsigned)__builtin_rintf(sigmoidf_(v[2]) * 255.f), b3 = (unsigned)__builtin_rintf(sigmoidf_(v[3]) * 255.f);
        return b0 | (b1 << 8) | (b2 << 16) | (b3 << 24); }
    __device__ __forceinline__ void operator()(const f32x4 (&acc)[2][2][4][2], const Unit& u, int wr, int wc, int fr, int fq) const {
        const int pn = u.pn, row0 = u.row0 + wr * 64 + fr, rA = u.row0 + wr * 64 + (fr & 7), colx = wc * 64 + (fr >> 3) * 32 + 8 * fq; const bool lo = fr < 8;
        if (pn >= 24) {
            unsigned char* gbase = gates + (wc >= 2 ? 1024 : 0) + (pn - 24) * 128 + (wc & 1) * 64 + (fr >> 3) * 32 + 8 * fq;
#pragma unroll
            for (int ai = 0; ai < 2; ++ai)
#pragma unroll
                for (int m = 0; m < 4; ++m) { unsigned char* gp = gbase + (size_t)(rA + ai * HALF + m * 16) * 2048;
                    const u32x2 c0 = (u32x2){q8(acc[ai][0][m][0]), q8(acc[ai][0][m][1])}, c1 = (u32x2){q8(acc[ai][1][m][0]), q8(acc[ai][1][m][1])}; u32x2 dA, dB;
#pragma unroll
                    for (int e = 0; e < 2; ++e) { const unsigned rcv = xr8(lo ? c1[e] : c0[e]); dA[e] = lo ? c0[e] : rcv; dB[e] = lo ? rcv : c1[e]; }
                    *(u32x2*)gp = dA; *(u32x2*)(gp + 8 * 2048) = dB; }
        } else if (pn < 12 || pn >= 20) {
            const int coltile = pn < 12 ? pn * 256 : AC_DV + (pn - 20) * 256;
#pragma unroll
            for (int ai = 0; ai < 2; ++ai)
#pragma unroll
                for (int m = 0; m < 4; ++m) { u32x4 c[2];
#pragma unroll
                    for (int bj = 0; bj < 2; ++bj) { const f32x4 v0 = acc[ai][bj][m][0], v1 = acc[ai][bj][m][1];
                        c[bj].x = cvt_pk_bf16(v0[0], v0[1]); c[bj].y = cvt_pk_bf16(v0[2], v0[3]); c[bj].z = cvt_pk_bf16(v1[0], v1[1]); c[bj].w = cvt_pk_bf16(v1[2], v1[3]); }
                    store_pair16(act1 + (size_t)(rA + ai * HALF + m * 16) * ACT_LD + coltile + colx, (size_t)8 * ACT_LD, c[0], c[1], lo); }
        } else {
            const bool isq = pn < 16; const int coltile = isq ? (pn - 12) * 256 : 1024 + (pn - 16) * 256; const float sc = isq ? ATT_C2 : 1.f;
            float inv[2][4];
#pragma unroll
            for (int bj = 0; bj < 2; ++bj)
#pragma unroll
                for (int i = 0; i < 4; ++i) inv[bj][i] = exp2f(-(float)(4 * (4 * bj + fq) + i) * (13.287712379549449f / 32.f));
            int pp[2][4];
#pragma unroll
            for (int ai = 0; ai < 2; ++ai)
#pragma unroll
                for (int m = 0; m < 4; ++m) pp[ai][m] = pos[row0 + ai * HALF + m * 16];
#pragma unroll
            for (int ai = 0; ai < 2; ++ai)
#pragma unroll
                for (int m = 0; m < 4; ++m) { const float p = (float)pp[ai][m]; u32x4 c[2];
#pragma unroll
                    for (int bj = 0; bj < 2; ++bj) { const f32x4 v0 = acc[ai][bj][m][0], v1 = acc[ai][bj][m][1]; float o1[4], o2[4];
#pragma unroll
                        for (int i = 0; i < 4; ++i) { const float ang = p * inv[bj][i]; float rev = ang * 0.15915494309189535f; rev = rev - floorf(rev); const float sn = __builtin_amdgcn_sinf(rev), cs = __builtin_amdgcn_cosf(rev);
                            o1[i] = (v0[i] * cs - v1[i] * sn) * sc; o2[i] = (v1[i] * cs + v0[i] * sn) * sc; }
                        c[bj].x = cvt_pk_bf16(o1[0], o1[1]); c[bj].y = cvt_pk_bf16(o1[2], o1[3]); c[bj].z = cvt_pk_bf16(o2[0], o2[1]); c[bj].w = cvt_pk_bf16(o2[2], o2[3]); }
                    store_pair16(dqk + (size_t)(rA + ai * HALF + m * 16) * DQK_LD + coltile + colx, (size_t)8 * DQK_LD, c[0], c[1], lo); }
        }
    }
};
struct EpiMerge {
    bf16_t* act1;
    __device__ __forceinline__ void operator()(const f32x4 (&acc)[2][2][4][2], const Unit& u, int wr, int wc, int fr, int fq) const {
        const int row0 = u.row0 + wr * 64 + fr, j0 = u.pn * 128 + wc * 32 + 8 * fq;
#pragma unroll
        for (int ai = 0; ai < 2; ++ai) { u32x4 ogs[4], ods[4];
#pragma unroll
            for (int m = 0; m < 4; ++m) { const bf16_t* rowp = act1 + (size_t)(row0 + ai * HALF + m * 16) * ACT_LD; ogs[m] = *(const u32x4*)(rowp + AC_OGLA + j0); ods[m] = *(const u32x4*)(rowp + AC_ODIFF + j0); }
#pragma unroll
            for (int m = 0; m < 4; ++m) { bf16_t* rowp = act1 + (size_t)(row0 + ai * HALF + m * 16) * ACT_LD; u32x4 w;
#pragma unroll
                for (int n = 0; n < 2; ++n) { const f32x4 va = acc[ai][0][m][n], vb = acc[ai][1][m][n]; const unsigned g0 = ogs[m][2 * n], g1 = ogs[m][2 * n + 1], d0 = ods[m][2 * n], d1 = ods[m][2 * n + 1];
                    w[2 * n] = cvt_pk_bf16(sigmoidf_(va[0]) * bf_lo(g0) + sigmoidf_(vb[0]) * bf_lo(d0), sigmoidf_(va[1]) * bf_hi(g0) + sigmoidf_(vb[1]) * bf_hi(d0));
                    w[2 * n + 1] = cvt_pk_bf16(sigmoidf_(va[2]) * bf_lo(g1) + sigmoidf_(vb[2]) * bf_lo(d1), sigmoidf_(va[3]) * bf_hi(g1) + sigmoidf_(vb[3]) * bf_hi(d1)); }
                *(u32x4*)(rowp + AC_MERGED + j0) = w; } }
    }
};
struct EpiY {
    bf16_t* act1;
    __device__ __forceinline__ void operator()(const f32x4 (&acc)[2][2][4][2], const Unit& u, int wr, int wc, int fr, int fq) const {
        const int rA = u.row0 + wr * 64 + (fr & 7), col = u.pn * BM + wc * 64 + (fr >> 3) * 32 + 8 * fq; const bool lo = fr < 8;
#pragma unroll
        for (int ai = 0; ai < 2; ++ai)
#pragma unroll
            for (int m = 0; m < 4; ++m) { u32x4 c[2];
#pragma unroll
                for (int bj = 0; bj < 2; ++bj) { const f32x4 v0 = acc[ai][bj][m][0], v1 = acc[ai][bj][m][1];
                    c[bj].x = cvt_pk_bf16(v0[0], v0[1]); c[bj].y = cvt_pk_bf16(v0[2], v0[3]); c[bj].z = cvt_pk_bf16(v1[0], v1[1]); c[bj].w = cvt_pk_bf16(v1[2], v1[3]); }
                store_pair16(act1 + (size_t)(rA + ai * HALF + m * 16) * ACT_LD + AC_Y + col, (size_t)8 * ACT_LD, c[0], c[1], lo); }
    }
};
struct EpiUp {
    bf16_t* hbuf;
    __device__ __forceinline__ void operator()(const f32x4 (&acc)[2][2][4][2], const Unit& u, int wr, int wc, int fr, int fq) const {
        const int row0 = u.row0 + wr * 64 + fr, j0 = u.pn * 128 + wc * 32 + 8 * fq;
#pragma unroll
        for (int ai = 0; ai < 2; ++ai)
#pragma unroll
            for (int m = 0; m < 4; ++m) { bf16_t* rowp = hbuf + (size_t)(row0 + ai * HALF + m * 16) * FF; u32x4 w;
#pragma unroll
                for (int n = 0; n < 2; ++n) { const f32x4 g = acc[ai][0][m][n], v = acc[ai][1][m][n];
                    w[2 * n] = cvt_pk_bf16(g[0] * sigmoidf_(g[0]) * v[0], g[1] * sigmoidf_(g[1]) * v[1]); w[2 * n + 1] = cvt_pk_bf16(g[2] * sigmoidf_(g[2]) * v[2], g[3] * sigmoidf_(g[3]) * v[3]); }
                *(u32x4*)(rowp + j0) = w; }
    }
};
struct EpiDown {
    bf16_t* mout; const int* rowtok; const float* roww;
    __device__ __forceinline__ void operator()(const f32x4 (&acc)[2][2][4][2], const Unit& u, int wr, int wc, int fr, int fq) const {
        const int row0 = u.row0 + wr * 64 + fr, col0 = u.pn * BM + wc * 32 + 8 * fq;
        int rts[2][4]; float ws[2][4];
#pragma unroll
        for (int ai = 0; ai < 2; ++ai)
#pragma unroll
            for (int m = 0; m < 4; ++m) { const int pr = row0 + ai * HALF + m * 16; rts[ai][m] = rowtok[pr]; ws[ai][m] = roww[pr]; }
#pragma unroll
        for (int ai = 0; ai < 2; ++ai)
#pragma unroll
            for (int m = 0; m < 4; ++m) { const int rt = rts[ai][m]; const float w = ws[ai][m];
                if (rt >= 0) { bf16_t* rowp = mout + (size_t)rt * D + col0;
#pragma unroll
                    for (int bj = 0; bj < 2; ++bj) { const f32x4 v0 = acc[ai][bj][m][0] * w, v1 = acc[ai][bj][m][1] * w;
                        u32x4 o; o.x = cvt_pk_bf16(v0[0], v0[1]); o.y = cvt_pk_bf16(v0[2], v0[3]); o.z = cvt_pk_bf16(v1[0], v1[1]); o.w = cvt_pk_bf16(v1[2], v1[3]);
                        *(u32x4*)(rowp + bj * HALF) = o; } } }
    }
};
constexpr int TILE_MAX = 512;
template <bool GATHER> struct MoeProb {
    const char* A; const char* Bt; int lda, K; int G, c; PG8_LAS const int* tab; PG8_LAS const int* rows; size_t bstride;
    __device__ __forceinline__ bool next(int i, Unit& u) const {
        const int idx = i * G + c, ntile = tab[0]; if (idx >= ntile * 4) return false;
        const int t = idx >> 2; u.pn = idx & 3; u.e = tab[1 + t]; u.row0 = tab[1 + TILE_MAX + t]; u.pm = i; return true;
    }
    __device__ __forceinline__ void a_voff(const Unit& u, const int (&R)[2], const int (&C)[2], unsigned (&v)[4]) const {
#pragma unroll
        for (int h = 0; h < 2; ++h)
#pragma unroll
            for (int i = 0; i < 2; ++i) { const int row = GATHER ? rows[u.pm * 256 + h * HALF + R[i]] : (u.row0 + h * HALF + R[i]); v[h * 2 + i] = (unsigned)(row * lda + C[i]) * 2u; }
    }
    __device__ __forceinline__ size_t b_off(const Unit& u) const { return (size_t)u.e * bstride + (size_t)u.pn * BM * K * 2; }
};
}
#include <hip/hip_bf16.h>
#include <cmath>
namespace attn_body {
using bf16=__hip_bfloat16;
using bf16x8=__attribute__((ext_vector_type(8)))short;
using s16x4=__attribute__((ext_vector_type(4)))short;
using f32x16=__attribute__((ext_vector_type(16)))float;
using u32x4=__attribute__((ext_vector_type(4)))unsigned;
constexpr int SEQ=4096,D=64,PQ=2048,PK=2048,PV=4352,PO=4352;
constexpr int NW=8,QBLK=32,QB=QBLK*NW,KVBLK=64,NQB=SEQ/QB;
constexpr int ATTN_UNIT_ROWS=QB;
__device__ __forceinline__ int crow(int r,int hi){return (r&3)+8*(r>>2)+4*hi;}
#define SBAR() __builtin_amdgcn_sched_barrier(0)
__device__ __forceinline__ void cmask(f32x16&p0,f32x16&p1,int jb,int qrel,int hi){
  const float NEG=-INFINITY; int kb=64*jb+4*hi;
  #pragma unroll
  for(int r=0;r<16;++r){int kv=kb+(r&3)+8*(r>>2); if(kv>qrel)p0[r]=NEG; if(kv+32>qrel)p1[r]=NEG;}
}

constexpr int NSLOT=3, SLOTB=8192;
constexpr int LDS_K=0, LDS_V=NSLOT*SLOTB, LDS_WS=3*NSLOT*SLOTB, LDS_OST=LDS_WS+NW*64*4, LDS_BYTES=LDS_OST+NW*4096;
constexpr float C2=0.125f*1.4426950408889634f;
__device__ __forceinline__ void glds16(const void*gsrc,unsigned lds_dst){unsigned keep;
  asm volatile("s_mov_b32 %0, m0\n\ts_mov_b32 m0, %2\n\ts_nop 0\n\tglobal_load_lds_dwordx4 %1, off\n\ts_mov_b32 m0, %0":"=&s"(keep):"v"(gsrc),"s"(lds_dst):"memory");}
__device__ __forceinline__ float max3f(float a,float b,float c){float r;asm("v_max3_f32 %0, %1, %2, %3":"=v"(r):"v"(a),"v"(b),"v"(c));return r;}
__device__ __forceinline__ float max2f(float a,float b){float r;asm("v_max_f32_e32 %0, %1, %2":"=v"(r):"v"(a),"v"(b));return r;}
__device__ __forceinline__ float fadd_s(float a,float b){float r;asm("v_add_f32_e32 %0, %1, %2":"=v"(r):"v"(a),"v"(b));return r;}
__device__ __forceinline__ float fsub_s(float a,float b){float r;asm("v_sub_f32_e32 %0, %1, %2":"=v"(r):"v"(a),"v"(b));return r;}
typedef float f32x2_t __attribute__((ext_vector_type(2))); typedef __bf16 bf16x2_t __attribute__((ext_vector_type(2)));
__device__ __forceinline__ unsigned cvtpk_s(float lo,float hi){f32x2_t v={lo,hi};bf16x2_t b=__builtin_convertvector(v,bf16x2_t);return __builtin_bit_cast(unsigned,b);}
#define WAIT_BAR(N) asm volatile("s_waitcnt vmcnt(" #N ") lgkmcnt(0)\n\ts_barrier":::"memory")

__device__ __forceinline__ void qkt(f32x16&p0,f32x16&p1,const char*Kslot,const bf16x8*qr,int r32,int hi){ const f32x16 negm=f32x16{};
  const char*kb=Kslot+hi*1024+r32*16;
  #pragma unroll
  for(int d0=0;d0<4;++d0){
    const bf16x8 b0=*reinterpret_cast<const bf16x8*>(kb+d0*2048);
    const bf16x8 b1=*reinterpret_cast<const bf16x8*>(kb+d0*2048+512);
    if(d0==0){p0=__builtin_amdgcn_mfma_f32_32x32x16_bf16(b0,qr[0],negm,0,0,0);p1=__builtin_amdgcn_mfma_f32_32x32x16_bf16(b1,qr[0],negm,0,0,0);}
    else{p0=__builtin_amdgcn_mfma_f32_32x32x16_bf16(b0,qr[d0],p0,0,0,0);p1=__builtin_amdgcn_mfma_f32_32x32x16_bf16(b1,qr[d0],p1,0,0,0);}}
}
typedef __attribute__((address_space(3))) const char* lds_cptr;
typedef short v4i16_t __attribute__((ext_vector_type(4)));
__device__ __forceinline__ void kload8(bf16x8*kf,lds_cptr kp){
  kf[0]=*(const __attribute__((address_space(3))) bf16x8*)(kp);      kf[1]=*(const __attribute__((address_space(3))) bf16x8*)(kp+512);
  kf[2]=*(const __attribute__((address_space(3))) bf16x8*)(kp+2048); kf[3]=*(const __attribute__((address_space(3))) bf16x8*)(kp+2560);
  kf[4]=*(const __attribute__((address_space(3))) bf16x8*)(kp+4096); kf[5]=*(const __attribute__((address_space(3))) bf16x8*)(kp+4608);
  kf[6]=*(const __attribute__((address_space(3))) bf16x8*)(kp+6144); kf[7]=*(const __attribute__((address_space(3))) bf16x8*)(kp+6656);
}
__device__ __forceinline__ void kload2(bf16x8*kf,lds_cptr kp,int j){ kf[2*j]=*(const __attribute__((address_space(3))) bf16x8*)(kp+j*2048); kf[2*j+1]=*(const __attribute__((address_space(3))) bf16x8*)(kp+j*2048+512); }
__device__ __forceinline__ s16x4 vtr(lds_cptr p){ return __builtin_bit_cast(s16x4,__builtin_amdgcn_ds_read_tr16_b64_v4i16((__attribute__((address_space(3))) v4i16_t*)p)); }
__device__ __forceinline__ float rowmax(const f32x16&p0,const f32x16&p1){
  float a=max3f(p0[0],p0[1],p1[0]),b=max3f(p0[2],p0[3],p1[1]);a=max3f(a,p1[2],p1[3]);
  #pragma unroll
  for(int r=4;r<16;r+=4){a=max3f(a,p0[r],p0[r+1]);b=max3f(b,p0[r+2],p0[r+3]);a=max3f(a,p1[r],p1[r+1]);b=max3f(b,p1[r+2],p1[r+3]);}
  const float m=max2f(a,b);
  auto rr=__builtin_amdgcn_permlane32_swap(__float_as_uint(m),__float_as_uint(m),false,false);
  return max2f(__uint_as_float(rr[0]),__uint_as_float(rr[1]));
}
__device__ __forceinline__ void pv(f32x16*o,int vb,bf16x8 pa0,bf16x8 pa1,bf16x8 pa2,bf16x8 pa3){
  #pragma unroll
  for(int d0=0;d0<4;++d0){s16x4 lo[4],hi[4];
    #pragma unroll
    for(int ks=0;ks<4;++ks){
      asm volatile("ds_read_b64_tr_b16 %0,%1 offset:%c2":"=&v"(lo[ks]):"v"(vb),"i"(d0*4096+ks*1024):"memory");
      asm volatile("ds_read_b64_tr_b16 %0,%1 offset:%c2":"=&v"(hi[ks]):"v"(vb),"i"(d0*4096+ks*1024+512):"memory");}
    asm volatile("s_waitcnt lgkmcnt(0)":::"memory");SBAR();
    #define PK(k) (bf16x8){lo[k][0],lo[k][1],lo[k][2],lo[k][3],hi[k][0],hi[k][1],hi[k][2],hi[k][3]}
    o[d0]=__builtin_amdgcn_mfma_f32_32x32x16_bf16(pa0,PK(0),o[d0],0,0,0);
    o[d0]=__builtin_amdgcn_mfma_f32_32x32x16_bf16(pa1,PK(1),o[d0],0,0,0);
    o[d0]=__builtin_amdgcn_mfma_f32_32x32x16_bf16(pa2,PK(2),o[d0],0,0,0);
    o[d0]=__builtin_amdgcn_mfma_f32_32x32x16_bf16(pa3,PK(3),o[d0],0,0,0);
    #undef PK
  }
}

#ifndef ATTN_STORE16
#define ATTN_STORE16(p,v) (*(u32x4*)(p)=(v))
#endif
template<int THRL,int CM> __device__ __forceinline__ void attn_unit(int b,int qb,int qcol,int vcol,int ocol,int mcol,int gcol,const bf16*QK,const bf16*__restrict__ V,bf16*O,const unsigned char*gates,char*shm,float lam,const float*nwp){
  int tid_=threadIdx.x; asm volatile("":"+v"(tid_));
  const int tid=tid_,lane=tid&63,r32=lane&31,hi=lane>>5; const int wid=__builtin_amdgcn_readfirstlane(tid>>6);
  const long rowbase=(long)b*SEQ; const int q0=qb*QB;
  const bf16*Qw=QK+(rowbase+q0+wid*QBLK)*PQ+qcol;
  const bf16*Kh=QK+rowbase*PK+1024+qcol,*Vh=V+rowbase*PV+vcol;
  const unsigned lds0=(unsigned)(uintptr_t)shm;
  float*wsf=(float*)(shm+LDS_WS)+wid*64;
  const bf16*ksrc=Kh+(long)lane*PK+wid*8;
  const bf16*vsrc=Vh+(long)(16*(wid&3)+(lane>>2))*PV+(wid>>2)*32+(lane&3)*8;
  const unsigned kdst=lds0+LDS_K+wid*1024, vdst=lds0+LDS_V+wid*1024;
  #define DMA_K(t,slot) glds16(ksrc+(long)(t)*KVBLK*PK,(unsigned)__builtin_amdgcn_readfirstlane(kdst+(slot)))
  #define DMA_V(t,slot) do{ glds16(vsrc+(long)(t)*KVBLK*PV,(unsigned)__builtin_amdgcn_readfirstlane(vdst+2*(slot))); glds16(vsrc+(long)(t)*KVBLK*PV+64,(unsigned)__builtin_amdgcn_readfirstlane(vdst+2*(slot)+8192)); }while(0)
  const int vb0=(int)(lds0+LDS_V)+((lane>>4)&1)*32+(lane&3)*8+(4*hi+((lane&15)>>2))*64;
  const char*Kbase=shm+LDS_K; bf16x8 kf[8];
  const lds_cptr shm3=(lds_cptr)shm; const lds_cptr kp0=shm3+LDS_K+hi*1024+r32*16; const lds_cptr vp0=shm3+LDS_V+((lane>>4)&1)*32+(lane&3)*8+(4*hi+((lane&15)>>2))*64;
  const int NT=(q0+QB)/KVBLK;
  DMA_K(0,0);DMA_V(0,0);DMA_K(1,SLOTB);
  bf16x8 qr[4];
  #pragma unroll
  for(int d0=0;d0<4;++d0)qr[d0]=*reinterpret_cast<const bf16x8*>(&Qw[(long)r32*PQ+d0*16+hi*8]);
  float mhat=0.f,l_reg=0.f;f32x16 o[4];o[0]=f32x16{};o[1]=f32x16{};o[2]=f32x16{};o[3]=f32x16{};
  const int qrel=wid*QBLK+r32;
  #define CMASK(P0,P1,t) do{int jb_=(t)-(NT-4); if(jb_>=0)cmask(P0,P1,jb_,qrel,hi);}while(0)
  bool resc=false;
  #define START(P0,P1) do{ const float rm=rowmax(P0,P1); resc=false; mhat=rm; \
    _Pragma("unroll") for(int r=0;r<16;++r)P0[r]=__builtin_amdgcn_exp2f(fsub_s(P0[r],mhat)); }while(0)
  #define RESC() do{ if(resc){ asm volatile("s_waitcnt lgkmcnt(0)":::"memory"); \
      _Pragma("unroll") for(int d_=0;d_<4;++d_) _Pragma("unroll") for(int r=0;r<16;++r)o[d_][r]*=wsf[crow(r,hi)]; } }while(0)
  f32x16 pA0,pA1,pB0,pB1;
  int sl_prev=0,sl_cur=0,sl_next=SLOTB;
  #define ROT() do{sl_prev=sl_cur;sl_cur=sl_next;sl_next=(sl_next==(NSLOT-1)*SLOTB)?0:sl_next+SLOTB;}while(0)
  DMA_K(2,2*SLOTB);
  WAIT_BAR(3);
  qkt(pA0,pA1,Kbase,qr,r32,hi);asm volatile("s_nop 15\n\ts_nop 7":"+v"(pA0),"+v"(pA1));CMASK(pA0,pA1,0);
  START(pA0,pA1);
  _Pragma("unroll") for(int r=0;r<16;++r)pA1[r]=__builtin_amdgcn_exp2f(fsub_s(pA1[r],mhat));
  WAIT_BAR(0);
  DMA_K(3,0);DMA_V(1,SLOTB);
  ROT();
  kload8(kf,kp0+sl_cur);
  WAIT_BAR(3);
  s16x4 vlo[8],vhi[8]; u32x4 pw0,pw1,pw2,pw3; const f32x16 zc=f32x16{};
  #define PKW(P,B) cvtpk_s(P[B],P[B+1])
  #define PAF(k) __builtin_bit_cast(bf16x8,pw##k)
  #define VFR(i) (bf16x8){vlo[i][0],vlo[i][1],vlo[i][2],vlo[i][3],vhi[i][0],vhi[i][1],vhi[i][2],vhi[i][3]}
  #define PIN(x) asm volatile("":"+v"(x))
  #define MX3(a,b,c) __builtin_fmaxf(__builtin_fmaxf((a),(b)),(c))
  #define GAPA(MF,A0,A1,A2,A3,W0,W1,PW) do{ MF; sacc+=A0; sacc+=A1; sacc+=A2; sacc+=A3; PIN(sacc); W0; W1; PIN(PW); SBAR(); }while(0)
  #define EX(v) __builtin_amdgcn_exp2f((v)-mhat)
  #define GAPB(MF,X,B) do{ MF; X[B]=EX(X[B]); X[B+1]=EX(X[B+1]); PIN(X); SBAR(); }while(0)
  #define VRD(i) do{ vlo[(i)&7]=vtr(vp_+(((i)>>2)*4096+((i)&3)*1024)); vhi[(i)&7]=vtr(vp_+(((i)>>2)*4096+((i)&3)*1024+512)); SBAR(); }while(0)
  #define KRD(G,j) do{ if(G){ kload2(kf,kp0+sl_next,j); SBAR(); } }while(0)
  #define STEP(C0,C1,P0,P1,t,GK,GV,GL) do{ SBAR(); \
    const lds_cptr vp_=vp0+2*sl_prev; \
    VRD(0); float sacc=(P0[0]+P0[1]); \
    GAPA(C0=__builtin_amdgcn_mfma_f32_32x32x16_bf16(kf[0],qr[0],zc,0,0,0), P0[2],P0[3],P0[4],P0[5],     pw0[0]=PKW(P0,0), pw0[1]=PKW(P0,2), pw0); \
    VRD(4); GAPA(C1=__builtin_amdgcn_mfma_f32_32x32x16_bf16(kf[1],qr[0],zc,0,0,0), P0[6],P0[7],P0[8],P0[9],     pw0[2]=PKW(P0,4), pw0[3]=PKW(P0,6), pw0); \
    VRD(1); GAPA(C0=__builtin_amdgcn_mfma_f32_32x32x16_bf16(kf[2],qr[1],C0,0,0,0),   P0[10],P0[11],P0[12],P0[13], pw1[0]=PKW(P0,8), pw1[1]=PKW(P0,10), pw1); \
    VRD(5); GAPA(C1=__builtin_amdgcn_mfma_f32_32x32x16_bf16(kf[3],qr[1],C1,0,0,0),   P0[14],P0[15],P1[0],P1[1],   pw1[2]=PKW(P0,12),pw1[3]=PKW(P0,14), pw1); \
    VRD(2); GAPA(C0=__builtin_amdgcn_mfma_f32_32x32x16_bf16(kf[4],qr[2],C0,0,0,0),   P1[2],P1[3],P1[4],P1[5],     pw2[0]=PKW(P1,0), pw2[1]=PKW(P1,2), pw2); \
    VRD(6); GAPA(C1=__builtin_amdgcn_mfma_f32_32x32x16_bf16(kf[5],qr[2],C1,0,0,0),   P1[6],P1[7],P1[8],P1[9],     pw2[2]=PKW(P1,4), pw2[3]=PKW(P1,6), pw2); \
    VRD(3); GAPA(C0=__builtin_amdgcn_mfma_f32_32x32x16_bf16(kf[6],qr[3],C0,0,0,0),   P1[10],P1[11],P1[12],P1[13], pw3[0]=PKW(P1,8), pw3[1]=PKW(P1,10), pw3); \
    VRD(7); GAPA(C1=__builtin_amdgcn_mfma_f32_32x32x16_bf16(kf[7],qr[3],C1,0,0,0),   P1[14],P1[15],0.f,0.f,       pw3[2]=PKW(P1,12),pw3[3]=PKW(P1,14), pw3); \
    l_reg+=sacc; \
    if(GK){DMA_K((t)+3,sl_cur);} if(GV){DMA_V((t)+1,sl_next);} \
    CMASK(C0,C1,t); \
    { float a=MX3(C0[0],C0[1],C1[0]),b=MX3(C0[2],C0[3],C1[1]); a=MX3(a,C1[2],C1[3]); \
      _Pragma("unroll") for(int r=4;r<16;r+=4){a=MX3(a,C0[r],C0[r+1]);b=MX3(b,C0[r+2],C0[r+3]);a=MX3(a,C1[r],C1[r+1]);b=MX3(b,C1[r+2],C1[r+3]);} \
      float rm=__builtin_fmaxf(a,b); { auto rr=__builtin_amdgcn_permlane32_swap(__float_as_uint(rm),__float_as_uint(rm),false,false); rm=__builtin_fmaxf(__uint_as_float(rr[0]),__uint_as_float(rr[1])); } \
      resc=false; rm-=mhat; \
      if(__builtin_expect(__any(rm>(float)THRL),0)){ const float dl=__builtin_fmaxf(rm,0.f); mhat+=dl; \
        const float f=__builtin_amdgcn_exp2f(-dl); l_reg*=f; if(hi==0)wsf[r32]=f; resc=true; } } \
    SBAR(); \
    GAPB(o[0]=__builtin_amdgcn_mfma_f32_32x32x16_bf16(PAF(0),VFR(0),o[0],0,0,0), C0,0);  VRD(8); \
    GAPB(o[1]=__builtin_amdgcn_mfma_f32_32x32x16_bf16(PAF(0),VFR(4),o[1],0,0,0), C0,2);  VRD(12); \
    GAPB(o[0]=__builtin_amdgcn_mfma_f32_32x32x16_bf16(PAF(1),VFR(1),o[0],0,0,0), C0,4);  VRD(9); \
    GAPB(o[1]=__builtin_amdgcn_mfma_f32_32x32x16_bf16(PAF(1),VFR(5),o[1],0,0,0), C0,6);  VRD(13); \
    GAPB(o[0]=__builtin_amdgcn_mfma_f32_32x32x16_bf16(PAF(2),VFR(2),o[0],0,0,0), C0,8);  VRD(10); \
    GAPB(o[1]=__builtin_amdgcn_mfma_f32_32x32x16_bf16(PAF(2),VFR(6),o[1],0,0,0), C0,10); VRD(14); \
    GAPB(o[0]=__builtin_amdgcn_mfma_f32_32x32x16_bf16(PAF(3),VFR(3),o[0],0,0,0), C0,12); VRD(11); \
    GAPB(o[1]=__builtin_amdgcn_mfma_f32_32x32x16_bf16(PAF(3),VFR(7),o[1],0,0,0), C0,14); VRD(15); \
    GAPB(o[2]=__builtin_amdgcn_mfma_f32_32x32x16_bf16(PAF(0),VFR(0),o[2],0,0,0), C1,0); \
    GAPB(o[3]=__builtin_amdgcn_mfma_f32_32x32x16_bf16(PAF(0),VFR(4),o[3],0,0,0), C1,2); \
    KRD(GL,0); GAPB(o[2]=__builtin_amdgcn_mfma_f32_32x32x16_bf16(PAF(1),VFR(1),o[2],0,0,0), C1,4); \
    KRD(GL,1); GAPB(o[3]=__builtin_amdgcn_mfma_f32_32x32x16_bf16(PAF(1),VFR(5),o[3],0,0,0), C1,6); \
    KRD(GL,2); GAPB(o[2]=__builtin_amdgcn_mfma_f32_32x32x16_bf16(PAF(2),VFR(2),o[2],0,0,0), C1,8); \
    KRD(GL,3); GAPB(o[3]=__builtin_amdgcn_mfma_f32_32x32x16_bf16(PAF(2),VFR(6),o[3],0,0,0), C1,10); \
    GAPB(o[2]=__builtin_amdgcn_mfma_f32_32x32x16_bf16(PAF(3),VFR(3),o[2],0,0,0), C1,12); \
    GAPB(o[3]=__builtin_amdgcn_mfma_f32_32x32x16_bf16(PAF(3),VFR(7),o[3],0,0,0), C1,14); \
    }while(0)
  int t=1;
  #undef CMASK
  #define CMASK(P0,P1,t) do{}while(0)
  for(;t+5<NT;t+=2){
    STEP(pB0,pB1,pA0,pA1,t,true,true,true);     WAIT_BAR(3); RESC(); ROT();
    STEP(pA0,pA1,pB0,pB1,t+1,true,true,true);   WAIT_BAR(3); RESC(); ROT();
  }
  #undef CMASK
  #define CMASK(P0,P1,t) do{int jb_=(t)-(NT-4); if(jb_>=0)cmask(P0,P1,jb_,qrel,hi);}while(0)
  #define ENDW(tt) do{ if((tt)+3<NT){WAIT_BAR(3);} else if((tt)+2<NT){WAIT_BAR(2);} else {WAIT_BAR(0);} }while(0)
  for(;t+1<NT;t+=2){
    STEP(pB0,pB1,pA0,pA1,t,(t+3<NT),(t+1<NT),(t+1<NT));       ENDW(t);   RESC(); ROT();
    STEP(pA0,pA1,pB0,pB1,t+1,(t+4<NT),(t+2<NT),(t+2<NT));     ENDW(t+1); RESC(); ROT();
  }
  STEP(pB0,pB1,pA0,pA1,NT-1,false,false,false); RESC();
  { float sacc=pB0[0]+pB0[1]; _Pragma("unroll") for(int r=2;r<16;++r)sacc+=pB0[r]; _Pragma("unroll") for(int r=0;r<16;++r)sacc+=pB1[r]; l_reg+=sacc;
    pw0=(u32x4){PKW(pB0,0),PKW(pB0,2),PKW(pB0,4),PKW(pB0,6)};pw1=(u32x4){PKW(pB0,8),PKW(pB0,10),PKW(pB0,12),PKW(pB0,14)};pw2=(u32x4){PKW(pB1,0),PKW(pB1,2),PKW(pB1,4),PKW(pB1,6)};pw3=(u32x4){PKW(pB1,8),PKW(pB1,10),PKW(pB1,12),PKW(pB1,14)};
    SBAR(); pv(o,vb0+2*sl_cur,PAF(0),PAF(1),PAF(2),PAF(3)); }
  #undef PKW
  #undef PAF
  #undef VFR
  #undef PIN
  #undef MX3
  #undef GAPA
  #undef GAPB
  #undef EX
  #undef VRD
  #undef KRD
  #undef STEP
  #undef ENDW
  {auto rr=__builtin_amdgcn_permlane32_swap(__float_as_uint(l_reg),__float_as_uint(l_reg),false,false);l_reg=__uint_as_float(rr[0])+__uint_as_float(rr[1]);}
  if(hi==0)wsf[32+r32]=l_reg;asm volatile("s_waitcnt lgkmcnt(0)":::"memory");
  float rli[16];
  #pragma unroll
  for(int r=0;r<16;++r)rli[r]=__builtin_amdgcn_rcpf(wsf[32+crow(r,hi)]);
  bf16*Ow=O+(rowbase+q0+wid*QBLK)*PO+ocol;
  { bf16*stg=(bf16*)(shm+LDS_OST)+wid*2048;
    float vv[2][4][8];
    u32x4 w1s[2][4];
    if constexpr(CM==1){ const bf16*p0=Ow+(long)(lane>>3)*PO+(lane&7)*8;
      asm volatile("global_load_dwordx4 %0, %8, off sc0 sc1\n\tglobal_load_dwordx4 %1, %9, off sc0 sc1\n\tglobal_load_dwordx4 %2, %10, off sc0 sc1\n\tglobal_load_dwordx4 %3, %11, off sc0 sc1\n\t"
                   "global_load_dwordx4 %4, %12, off sc0 sc1\n\tglobal_load_dwordx4 %5, %13, off sc0 sc1\n\tglobal_load_dwordx4 %6, %14, off sc0 sc1\n\tglobal_load_dwordx4 %7, %15, off sc0 sc1\n\ts_waitcnt vmcnt(0)"
                   :"=&v"(w1s[0][0]),"=&v"(w1s[0][1]),"=&v"(w1s[0][2]),"=&v"(w1s[0][3]),"=&v"(w1s[1][0]),"=&v"(w1s[1][1]),"=&v"(w1s[1][2]),"=&v"(w1s[1][3])
                   :"v"(p0),"v"(p0+8L*PO),"v"(p0+16L*PO),"v"(p0+24L*PO),"v"(p0+64),"v"(p0+8L*PO+64),"v"(p0+16L*PO+64),"v"(p0+24L*PO+64):"memory"); }
    #pragma unroll
    for(int hf=0;hf<2;++hf){
      #pragma unroll
      for(int r=0;r<16;++r){const int orow=crow(r,hi);
        #pragma unroll
        for(int d0=0;d0<2;++d0)stg[orow*64+d0*32+r32]=__float2bfloat16(o[2*hf+d0][r]*rli[r]);}
      asm volatile("s_waitcnt lgkmcnt(0)":::"memory");
      #pragma unroll
      for(int i=0;i<4;++i){const int row=i*8+(lane>>3),ch=lane&7; const u32x4 v=*(const u32x4*)(stg+row*64+ch*8);
        if constexpr(CM==0){ ATTN_STORE16(Ow+(long)row*PO+hf*64+ch*8,v); }
        else { const u32x4 w1=w1s[hf][i];
          #pragma unroll
          for(int e=0;e<4;++e){ vv[hf][i][2*e]=__uint_as_float(w1[e]<<16)-lam*__uint_as_float(v[e]<<16); vv[hf][i][2*e+1]=__uint_as_float(w1[e]&0xffff0000u)-lam*__uint_as_float(v[e]&0xffff0000u); } } }
      asm volatile("s_waitcnt lgkmcnt(0)":::"memory"); }
    if constexpr(CM==1){
      bf16*Mw=O+(rowbase+q0+wid*QBLK)*PO+mcol; const unsigned char*Gw=gates+(rowbase+q0+wid*QBLK)*2048+gcol;
      u32x4 mg[2][4]; unsigned gbw[2][4][2];
      #pragma unroll
      for(int hf=0;hf<2;++hf)
        #pragma unroll
        for(int i=0;i<4;++i){ const int row=i*8+(lane>>3),ch=lane&7; mg[hf][i]=*(const u32x4*)(Mw+(long)row*PO+hf*64+ch*8);
          const unsigned long long g8=*(const unsigned long long*)(Gw+(long)row*2048+hf*64+ch*8); gbw[hf][i][0]=(unsigned)g8; gbw[hf][i][1]=(unsigned)(g8>>32); }
      float nw[2][8];
      #pragma unroll
      for(int hf=0;hf<2;++hf)
        #pragma unroll
        for(int e=0;e<8;++e)nw[hf][e]=nwp[hf*64+(lane&7)*8+e];
      #pragma unroll
      for(int i=0;i<4;++i){ float ss=0.f;
        #pragma unroll
        for(int hf=0;hf<2;++hf)
          #pragma unroll
          for(int e=0;e<8;++e)ss+=vv[hf][i][e]*vv[hf][i][e];
        ss+=__shfl_xor(ss,1); ss+=__shfl_xor(ss,2); ss+=__shfl_xor(ss,4);
        const float rstd=1.f/sqrtf(ss*(1.f/128.f)+1e-6f); const int row=i*8+(lane>>3),ch=lane&7;
        #pragma unroll
        for(int hf=0;hf<2;++hf){ u32x4 w;
          #pragma unroll
          for(int e=0;e<4;++e){ const unsigned gw_=gbw[hf][i][e>>1]; const float g0=(float)((gw_>>(16*(e&1)))&0xffu)*(1.f/255.f),g1=(float)((gw_>>(16*(e&1)+8))&0xffu)*(1.f/255.f);
            const unsigned m_=mg[hf][i][e];
            w[e]=cvtpk_s(__uint_as_float(m_<<16)+g0*(vv[hf][i][2*e]*rstd*nw[hf][2*e]),__uint_as_float(m_&0xffff0000u)+g1*(vv[hf][i][2*e+1]*rstd*nw[hf][2*e+1])); }
          ATTN_STORE16(Mw+(long)row*PO+hf*64+ch*8,w); } } } }
  asm volatile("s_waitcnt lgkmcnt(0)\n\ts_barrier":::"memory");
  #undef DMA_K
  #undef DMA_V
  #undef CMASK
  #undef START
  #undef RESC
  #undef ROT
}
constexpr int ATTN_LDS_BYTES=LDS_BYTES;
struct AttnTensors { const bf16* QK; const bf16* V; bf16* O; };
struct AttnUnit { int bh; int qb; };
struct StaticOrder {
  int vcu, G;
  __device__ __forceinline__ explicit StaticOrder(int grid,int vcu_):vcu(vcu_),G(grid){}
  __device__ __forceinline__ bool next(int i,AttnUnit&u)const{ const int L=i*G+vcu; if(L>=64*NQB)return false; const int v=L&255,j=L>>8,sx=v&3; u.bh=v>>2; u.qb=(j==0)?15-sx:(j==1)?8+sx:(j==2)?7-sx:sx; return true; }
};
template<class Sched,int THRL=8> __device__ __forceinline__ void attn_phase(char*lds,const AttnTensors&T,const Sched&S,int vcol,int ocol,int mcol,const unsigned char*gates,float lam,const float*nwp){
  AttnUnit u;
  for(int i=0;S.next(i,u);++i){
    const int b=u.bh>>3,h=u.bh&7;
    attn_unit<THRL,0>(b,u.qb,h*128,vcol+h*128,ocol+h*128,mcol+h*128,1024+h*128,T.QK,T.V,T.O,gates,lds,lam,nwp);
    attn_unit<THRL,1>(b,u.qb,h*128+64,vcol+h*128,ocol+h*128,mcol+h*128,1024+h*128,T.QK,T.V,T.O,gates,lds,lam,nwp);
  }
}
#undef SBAR
#undef WAIT_BAR
}
constexpr size_t MiB = 1u << 20;
constexpr size_t WS_CTL = 0, CTL_ZERO_BYTES = 64 * 1024;
constexpr size_t WS_ADA = 1 * MiB;
constexpr size_t WS_WRT = 1 * MiB + 256 * 1024;
constexpr size_t WS_CNT = 1 * MiB + 512 * 1024;
constexpr size_t WS_TAB = 1 * MiB + 640 * 1024;
constexpr size_t WS_TOKE = 2 * MiB;
constexpr size_t WS_TOKW = 2 * MiB + 256 * 1024;
constexpr size_t WS_ROWTOK = 2 * MiB + 512 * 1024;
constexpr size_t WS_ROWW = 3 * MiB;
constexpr size_t WS_DT = 3 * MiB + 512 * 1024;
constexpr size_t WS_WIN = 8 * MiB;
constexpr size_t WS_WMG = 20 * MiB;
constexpr size_t WS_WOUT = 25 * MiB;
constexpr size_t WS_WGU = 27 * MiB;
constexpr size_t WS_WD = 91 * MiB;
constexpr size_t WS_U = 123 * MiB;
constexpr size_t WS_ACT = 187 * MiB;
constexpr size_t WS_HST = 459 * MiB;
constexpr size_t WS_END = 491 * MiB;
constexpr size_t WS_GATES = WS_WGU;
constexpr size_t WS_HBUF = WS_ACT;
constexpr int PROWS = 73728;
constexpr size_t WS_MOUT = WS_ACT + 72 * MiB;
static_assert(WS_HBUF + (size_t)PROWS * FF * 2 <= WS_MOUT && WS_MOUT + (size_t)T * 2 * D * 2 <= WS_HST && WS_ACT + (size_t)T * ACT_LD * 2 <= WS_HST, "d_ws map");
constexpr int CW_TMO = 0, CW_CODE = 1, CW_BAR = 4096;
static_assert((CW_BAR + 3456) * 4 <= (int)CTL_ZERO_BYTES, "barrier words inside the memset region");

constexpr int NWAVES = 8;
constexpr int RING_OFF = 0, RING_BYTES = 131072;
constexpr int LDSCTL_OFF = RING_BYTES, MISC_OFF = LDSCTL_OFF + 320;
constexpr int ROWS_OFF = RING_BYTES + 1024;
constexpr int TAB_OFF = ROWS_OFF + 8 * 256 * 4;
constexpr int LDS_BYTES = 147456;
static_assert(TAB_OFF + (1 + 2 * 512) * 4 <= LDS_BYTES, "LDS map");

#define GAS __attribute__((address_space(1)))
#define LAS __attribute__((address_space(3)))
typedef unsigned short bf16;
typedef unsigned v4u __attribute__((ext_vector_type(4)));
typedef float f32x4 __attribute__((ext_vector_type(4)));
typedef short bf16x8 __attribute__((ext_vector_type(8)));
typedef GAS unsigned gu32;
typedef GAS unsigned long long gu64;
#define RLX_AGENT __ATOMIC_RELAXED, __HIP_MEMORY_SCOPE_AGENT
#define LDS_WAIT() asm volatile("s_waitcnt lgkmcnt(0)" ::: "memory")
#define VM_WAIT() asm volatile("s_waitcnt vmcnt(0)" ::: "memory")
__device__ __forceinline__ unsigned long long rt() { return __builtin_amdgcn_s_memrealtime(); }
__device__ __forceinline__ unsigned f2bf(float f) { unsigned u = __builtin_bit_cast(unsigned, f); return (u + 0x7fffu + ((u >> 16) & 1u)) >> 16; }
__device__ __forceinline__ unsigned pk2(float lo, float hi) { return f2bf(lo) | (f2bf(hi) << 16); }

#define XB_TMO      128
#define XB_XCNT(j)  (256  + 64 * (j))
#define XB_XSUB(j)  (1280 + 64 * (j))
#define XB_XGEN(j)  (2304 + 64 * (j))
#define XB_TOP      3328
#define XB_TOPGEN   3392
#define XCD_BAR_WORDS 3456
#define XB_SPIN_CAP (1u << 18)

__device__ __forceinline__ unsigned xb_ld(unsigned* p)              { return __hip_atomic_load(p, __ATOMIC_RELAXED, __HIP_MEMORY_SCOPE_AGENT); }
__device__ __forceinline__ unsigned xb_add(unsigned* p, unsigned v) { return __hip_atomic_fetch_add(p, v, __ATOMIC_RELAXED, __HIP_MEMORY_SCOPE_AGENT); }
__device__ __forceinline__ unsigned xb_xcc_id() { return (unsigned)__builtin_amdgcn_s_getreg((3 << 11) | 20) & 0xFu; }
#define XB_SPIN(cond, bar) do { unsigned _sp = 0; while (cond) { __builtin_amdgcn_s_sleep(1); \
    if ((++_sp & 255u) == 0u) { if (xb_ld(&(bar)[XB_TMO])) break; if (_sp > XB_SPIN_CAP) { atomicAdd(&(bar)[XB_TMO], 1u); break; } } } } while (0)

struct XcdBarrier {
    unsigned* bar; unsigned x;
    volatile LAS unsigned* st;
};

__device__ __forceinline__ XcdBarrier xcd_barrier_post(unsigned* bar, volatile LAS unsigned* st) {
    XcdBarrier b; b.bar = bar; b.x = xb_xcc_id(); b.st = st;
    if (threadIdx.x == 0) (void)xb_add(&bar[XB_XCNT(b.x)], 1u);
    return b;
}
__device__ __forceinline__ void xcd_barrier_complete(unsigned* bar, unsigned x, unsigned& nloc, unsigned& nx) {
    const unsigned G = gridDim.x * gridDim.y * gridDim.z;
    unsigned sum, cnt, mine, sp = 0u;
    for (;;) {
        sum = 0u; cnt = 0u; mine = 0u;
#pragma unroll
        for (unsigned j = 0; j < 16; ++j) { const unsigned c = xb_ld(&bar[XB_XCNT(j)]); sum += c; cnt += (c > 0u) ? 1u : 0u; mine = (j == x) ? c : mine; }
        if (sum == G) break;
        __builtin_amdgcn_s_sleep(1);
        if ((++sp & 255u) == 0u) { if (xb_ld(&bar[XB_TMO])) break; if (sp > XB_SPIN_CAP) { atomicAdd(&bar[XB_TMO], 1u); break; } }
    }
    nloc = mine > 0u ? mine : 1u; nx = cnt > 0u ? cnt : 1u;
}

__device__ __forceinline__ void xcd_barrier(const XcdBarrier& b) {
    asm volatile("s_waitcnt vmcnt(0)" ::: "memory");
    __syncthreads();
    if (threadIdx.x == 0) {
        unsigned* bar = b.bar;
        __builtin_amdgcn_s_waitcnt(0);
        unsigned nloc = b.st[0], nx = b.st[1];
        if (nloc == 0u) { xcd_barrier_complete(bar, b.x, nloc, nx); b.st[0] = nloc; b.st[1] = nx; }
        const unsigned old = xb_add(&bar[XB_XSUB(b.x)], 1u);
        const unsigned gen = old / nloc;
        if (old + 1u == (gen + 1u) * nloc) {
            __builtin_amdgcn_fence(__ATOMIC_RELEASE, "agent");
            asm volatile("s_waitcnt vmcnt(0)" ::: "memory");
            const unsigned og = xb_add(&bar[XB_TOP], 1u);
            const unsigned tg = og / nx;
            if (og + 1u == (tg + 1u) * nx) xb_add(&bar[XB_TOPGEN], 1u);
            else XB_SPIN(xb_ld(&bar[XB_TOPGEN]) == tg, bar);
            __builtin_amdgcn_fence(__ATOMIC_ACQUIRE, "agent");
            xb_add(&bar[XB_XGEN(b.x)], 1u);
            asm volatile("s_waitcnt vmcnt(0)" ::: "memory");
        } else {
            XB_SPIN(xb_ld(&bar[XB_XGEN(b.x)]) == gen, bar);
            __builtin_amdgcn_fence(__ATOMIC_ACQUIRE, "agent");
            asm volatile("s_waitcnt vmcnt(0)" ::: "memory");
        }
    }
    __syncthreads();
}

typedef float f32x16 __attribute__((ext_vector_type(16)));
typedef short s16x4 __attribute__((ext_vector_type(4)));
typedef unsigned v2u __attribute__((ext_vector_type(2)));
using pg8::cvt_pk_bf16; using pg8::bf_lo; using pg8::bf_hi; using pg8::sigmoidf_; using pg8::f32x2;
#define WS_DPP(v_, ctrl_) (v_ + __builtin_bit_cast(float, __builtin_amdgcn_update_dpp(0, __builtin_bit_cast(int, v_), (ctrl_), 0xf, 0xf, false)))
__device__ __forceinline__ float wave_sum(float v) {
    v = WS_DPP(v, 0xB1);
    v = WS_DPP(v, 0x4E);
    v = WS_DPP(v, 0x141);
    v = WS_DPP(v, 0x140);
    { auto rr = __builtin_amdgcn_permlane16_swap(__float_as_uint(v), __float_as_uint(v), false, false); v = __uint_as_float(rr[0]) + __uint_as_float(rr[1]); }
    { auto rr = __builtin_amdgcn_permlane32_swap(__float_as_uint(v), __float_as_uint(v), false, false); v = __uint_as_float(rr[0]) + __uint_as_float(rr[1]); }
    return v;
}
#define LBAR() do { asm volatile("s_waitcnt lgkmcnt(0)" ::: "memory"); __builtin_amdgcn_s_barrier(); asm volatile("" ::: "memory"); } while (0)
__device__ __forceinline__ float dot4(f32x4 a, f32x4 b) { return (a.x * b.x + a.y * b.y) + (a.z * b.z + a.w * b.w); }

struct MapIn { bf16* win; bf16* wmg;
    __device__ __forceinline__ bf16* operator()(int n) const {
        if (n < 3072) return win + (size_t)n * D;
        if (n < 3088) return nullptr;
        if (n < 5136) { const int c = n - 3088, blk = c >> 6, d = c & 63, g = (d & 31) >> 2, e = (d & 3) + ((d >> 5) << 2); return win + (size_t)(3072 + blk * 64 + 8 * g + e) * D; }
        if (n < 6160) return win + (size_t)(5120 + n - 5136) * D;
        const int c = n - 6160, j = c & 1023, half = c >> 10; return wmg + (size_t)(256 * (j >> 7) + 128 * half + (j & 127)) * D; } };
struct MapPlain { bf16* w; int K;
    __device__ __forceinline__ bf16* operator()(int n) const { return w + (size_t)n * K; } };
struct MapIl { bf16* w; int half;
    __device__ __forceinline__ bf16* operator()(int n) const { return w + (size_t)(256 * (n >> 7) + 128 * half + (n & 127)) * D; } };
struct TItem { const float* W; int K, N, it, kind, e; };
__device__ __forceinline__ void titem_load(const TItem& t, int lane, float (&r)[32]) {
    const int nblk = (t.N + 31) / 32, kb = t.it / nblk, nb = t.it % nblk, k0 = 64 * kb; int nn = 32 * nb + (lane & 31); nn = nn < t.N ? nn : t.N - 1;
    const float* p = t.W + (size_t)(k0 + (lane >> 5)) * t.N + nn;
#pragma unroll
    for (int i = 0; i < 32; ++i) r[i] = p[(size_t)(2 * i) * t.N];
}
template <class MapFn>
__device__ __forceinline__ void titem_store_map(const TItem& t, const float (&r)[32], LAS float* scr, int lane, const MapFn& map) {
    const int nblk = (t.N + 31) / 32, kb = t.it / nblk, nb = t.it % nblk, k0 = 64 * kb, n0 = 32 * nb;
#pragma unroll
    for (int i = 0; i < 32; ++i) scr[(2 * i + (lane >> 5)) * 33 + (lane & 31)] = r[i];
    LDS_WAIT(); asm volatile("" ::: "memory");
    const int c = lane & 7;
#pragma unroll
    for (int j = 0; j < 4; ++j) { const int nl = (lane >> 3) + 8 * j; const LAS float* s = scr + (8 * c) * 33 + nl;
        v4u o; o.x = cvt_pk_bf16(s[0 * 33], s[1 * 33]); o.y = cvt_pk_bf16(s[2 * 33], s[3 * 33]); o.z = cvt_pk_bf16(s[4 * 33], s[5 * 33]); o.w = cvt_pk_bf16(s[6 * 33], s[7 * 33]);
        if (n0 + nl < t.N) { bf16* dst = map(n0 + nl); if (dst) *(GAS v4u*)(dst + k0 + 8 * c) = o; } }
    LDS_WAIT(); asm volatile("" ::: "memory");
}

struct Ptrs {
    const float *x, *c, *w_ada, *b_ada, *w_in, *wg2, *bg2, *gnw, *lq1, *lk1, *lq2, *lk2, *dnw, *w_out, *ln1w, *ln1b, *wrg, *brg, *wre, *bre, *weg, *weu, *wed, *ln2w, *ln2b;
    const int* pos;
    float* out;
    float *ada, *wrt, *tokw, *roww, *dt, *hst;
    int *cnt, *tab, *toke, *rowtok;
    bf16 *win, *wmg, *wout, *wgu, *wd, *u, *act, *hbuf, *mout, *dqk;
    unsigned* dbg;
    unsigned char* gates;
};

constexpr int TI_IN = 16 * 257, TI_OUT = 16 * 32, TI_E = 16 * 16, TI_D = 8 * 32;
constexpr int TI_DENSE = TI_IN + TI_OUT, TI_ALL = TI_DENSE + NEXP * (2 * TI_E + TI_D);
__device__ __forceinline__ void transpose_items(const Ptrs& P, LAS unsigned char* lds, int gw, int NGW, int lane, int wave, int lo, int hi) {
    LAS float* scr = (LAS float*)(lds + RING_OFF + wave * 16384);
#define P0_DECODE(t_, idx_) do { int r_ = (idx_); \
        if (r_ < TI_IN) { t_ = TItem{P.w_in, D, IN_COLS, r_, 0, 0}; } else { r_ -= TI_IN; \
        if (r_ < TI_OUT) { t_ = TItem{P.w_out, D, D, r_, 1, 0}; } else { r_ -= TI_OUT; \
        if (r_ < NEXP * TI_E) { t_ = TItem{P.weg + (size_t)(r_ / TI_E) * D * FF, D, FF, r_ % TI_E, 2, r_ / TI_E}; } else { r_ -= NEXP * TI_E; \
        if (r_ < NEXP * TI_E) { t_ = TItem{P.weu + (size_t)(r_ / TI_E) * D * FF, D, FF, r_ % TI_E, 3, r_ / TI_E}; } else { r_ -= NEXP * TI_E; \
        t_ = TItem{P.wed + (size_t)(r_ / TI_D) * FF * D, FF, D, r_ % TI_D, 4, r_ / TI_D}; } } } } } while (0)
#define P0_STORE(t_, r_) do { \
        if (t_.kind == 0) titem_store_map(t_, r_, scr, lane, MapIn{P.win, P.wmg}); \
        else if (t_.kind == 1) titem_store_map(t_, r_, scr, lane, MapPlain{P.wout, D}); \
        else if (t_.kind == 2) titem_store_map(t_, r_, scr, lane, MapIl{P.wgu + (size_t)t_.e * 1024 * D, 0}); \
        else if (t_.kind == 3) titem_store_map(t_, r_, scr, lane, MapIl{P.wgu + (size_t)t_.e * 1024 * D, 1}); \
        else titem_store_map(t_, r_, scr, lane, MapPlain{P.wd + (size_t)t_.e * D * FF, FF}); } while (0)
    int it = lo + gw; TItem ta{}, tb{}; float ra[32], rb[32];
    if (it < hi) { P0_DECODE(ta, it); titem_load(ta, lane, ra); }
    while (it < hi) {
        const int it2 = it + NGW; if (it2 < hi) { P0_DECODE(tb, it2); titem_load(tb, lane, rb); }
        P0_STORE(ta, ra);
        it = it2; if (it >= hi) break;
        const int it3 = it + NGW; if (it3 < hi) { P0_DECODE(ta, it3); titem_load(ta, lane, ra); }
        P0_STORE(tb, rb);
        it = it3;
    }
#undef P0_DECODE
#undef P0_STORE
}

__device__ __forceinline__ void p0_prologue(const Ptrs& P, LAS unsigned char* lds, int vcu, int G, int tid, int lane, int wave) {
#ifndef P0PROBE
#define P0PROBE 0
#endif
    unsigned long long p0t = 0ull; if (P0PROBE && blockIdx.x == 0 && tid == 0) p0t = __builtin_amdgcn_s_memrealtime();
    if (vcu < 192) {
        LAS float* sc = (LAS float*)(lds + RING_OFF);
        LAS float* red = (LAS float*)(lds + RING_OFF + 32768);
        for (int i = tid; i < 8 * D; i += NWAVES * 64) { const float v = P.c[i]; sc[i] = v / (1.f + __expf(-v)); }
        __syncthreads();
        for (int item = vcu; item < 192; item += G) {
            const int col = item * 32 + (tid & 31), kg = tid >> 5;
            float a[8];
#pragma unroll
            for (int b = 0; b < 8; ++b) a[b] = 0.f;
#pragma unroll 16
            for (int i = 0; i < 64; ++i) { const int k = kg + 16 * i; const float w = P.w_ada[(size_t)k * (6 * D) + col];
#pragma unroll
                for (int b = 0; b < 8; ++b) a[b] += sc[b * D + k] * w; }
#pragma unroll
            for (int b = 0; b < 8; ++b) red[(kg * 8 + b) * 32 + (tid & 31)] = a[b];
            __syncthreads();
            if (tid < 256) { const int b = tid >> 5, cc = tid & 31; float s = 0.f;
#pragma unroll
                for (int q = 0; q < 16; ++q) s += red[(q * 8 + b) * 32 + cc];
                P.ada[(size_t)b * (6 * D) + item * 32 + cc] = s + P.b_ada[item * 32 + cc]; }
            __syncthreads();
        }
    }
    if (P0PROBE && blockIdx.x == 0 && tid == 0) __hip_atomic_store(P.dbg, (unsigned)(__builtin_amdgcn_s_memrealtime() - p0t), RLX_AGENT);
    const int gt = vcu * (NWAVES * 64) + tid, NT = G * NWAVES * 64;
    for (int i = gt; i < 36 * D; i += NT) { const int cc = i >> 10, k = i & 1023; P.wrt[i] = cc < 4 ? P.wrg[k * 4 + cc] : P.wre[k * 32 + (cc - 4)]; }
    transpose_items(P, lds, vcu * NWAVES + wave, G * NWAVES, lane, wave, 0, TI_DENSE);
}

namespace p1n { constexpr int U_LD = 1032, WAVE_BYTES = 4 * U_LD * 2, L_BF = 8 * WAVE_BYTES; static_assert(L_BF + 32 * 64 * 16 <= RING_BYTES, "P1 LDS map"); }
__device__ __forceinline__ void p1_ln_mod(const Ptrs& P, LAS unsigned char* lds, int gw, int NGW, int lane, int wave) {
    LAS bf16* UW = (LAS bf16*)(lds + RING_OFF + wave * p1n::WAVE_BYTES);
    const int fr = lane & 15, fq = lane >> 4;
    LAS v4u* BF = (LAS v4u*)(lds + RING_OFF + p1n::L_BF);
#pragma unroll
    for (int ss = 0; ss < 4; ++ss) { const int s = wave * 4 + ss, k0 = 32 * s + 8 * fq; unsigned hw[4];
#pragma unroll
        for (int j = 0; j < 8; j += 2) hw[j >> 1] = cvt_pk_bf16(P.w_in[(size_t)(k0 + j) * IN_COLS + 3072 + fr], P.w_in[(size_t)(k0 + j + 1) * IN_COLS + 3072 + fr]);
        BF[s * 64 + lane] = (v4u){hw[0], hw[1], hw[2], hw[3]}; }
    __syncthreads();
    for (int blk = gw; blk < T / 16; blk += NGW) {
        const int m0 = blk * 16, b = m0 / SEQ;
        f32x4 sh[4], sl[4];
#pragma unroll
        for (int j = 0; j < 4; ++j) { sh[j] = *((const f32x4*)(P.ada + (size_t)b * 6 * D) + lane + 64 * j); sl[j] = *((const f32x4*)(P.ada + (size_t)b * 6 * D + D) + lane + 64 * j) + 1.f; }
        f32x4 pre[4][4];
#pragma unroll
        for (int rr = 0; rr < 4; ++rr)
#pragma unroll
            for (int j = 0; j < 4; ++j) pre[rr][j] = *((const GAS f32x4*)(P.x + (size_t)(m0 + rr) * D) + lane + 64 * j);
#pragma unroll 1
        for (int g4 = 0; g4 < 4; ++g4) {
#pragma unroll
            for (int rr = 0; rr < 4; ++rr) {
                const int m = m0 + 4 * g4 + rr;
                f32x4 v[4]; float s = 0.f;
#pragma unroll
                for (int j = 0; j < 4; ++j) { v[j] = pre[rr][j]; s += (v[j].x + v[j].y) + (v[j].z + v[j].w); }
                if (g4 < 3) {
#pragma unroll
                    for (int j = 0; j < 4; ++j) pre[rr][j] = *((const GAS f32x4*)(P.x + (size_t)(m + 4) * D) + lane + 64 * j); }
                const float mean = wave_sum(s) * (1.f / D); float s2 = 0.f;
#pragma unroll
                for (int j = 0; j < 4; ++j) { v[j] = v[j] - mean; s2 += dot4(v[j], v[j]); }
                const float rstd = 1.f / sqrtf(wave_sum(s2) * (1.f / D) + LN_EPS);
                GAS v2u* o8 = (GAS v2u*)(P.u + (size_t)m * D) + lane;
#pragma unroll
                for (int j = 0; j < 4; ++j) { const f32x4 uu = v[j] * rstd * sl[j] + sh[j];
                    v2u w; w.x = cvt_pk_bf16(uu.x, uu.y); w.y = cvt_pk_bf16(uu.z, uu.w); o8[64 * j] = w; *(LAS v2u*)(UW + rr * p1n::U_LD + 4 * lane + 256 * j) = w; }
            }
            asm volatile("s_waitcnt lgkmcnt(0)" ::: "memory");
            f32x4 acc = (f32x4){0.f, 0.f, 0.f, 0.f};
#pragma unroll
            for (int s = 0; s < 32; ++s) { const bf16x8 a = *(const LAS bf16x8*)(UW + (fr & 3) * p1n::U_LD + 32 * s + 8 * fq); const bf16x8 bb = __builtin_bit_cast(bf16x8, BF[s * 64 + lane]); acc = __builtin_amdgcn_mfma_f32_16x16x32_bf16(a, bb, acc, 0, 0, 0); }
            if (fq == 0) {
#pragma unroll
                for (int g = 0; g < 4; ++g) P.act[(size_t)(m0 + 4 * g4 + g) * ACT_LD + AC_GR + fr] = (bf16)f2bf(acc[g]); }
            asm volatile("s_waitcnt lgkmcnt(0)" ::: "memory");
        }
    }
}

namespace gla {
constexpr int QT_LD = 136, KD_LD = 72, AT_LD = 72, OS_LD = 264;
constexpr int L_QT = 0, L_KT = L_QT + 64 * QT_LD * 2, L_KDT = L_KT + 64 * QT_LD * 2, L_VB = L_KDT + 128 * KD_LD * 2, L_AT = L_VB + 32768, L_KRAW = L_AT + 64 * AT_LD * 2, L_QRAW = L_KRAW + 16384, L_ENDC = L_QRAW + 16384, L_OS = 0;
constexpr int A_KDT = 0, A_VB = A_KDT + 128 * KD_LD * 2, A_KRAW = A_VB + 2 * 32768, A_END = A_KRAW + 2 * 16384;
constexpr int X_GL = ROWS_OFF, X_NW = X_GL + 2 * 2048, X_DEC = X_NW + 1024, X_END = X_DEC + 512;
static_assert(L_ENDC <= RING_BYTES && A_END <= RING_BYTES && 64 * OS_LD * 2 <= L_KDT && X_END <= LDS_BYTES, "GLA LDS map");
__device__ __forceinline__ int crow(int reg, int h) { return (reg & 3) + 8 * (reg >> 2) + 4 * h; }
__device__ __forceinline__ float fexp(float x) { return __builtin_amdgcn_exp2f(x * 1.4426950408889634f); }
__device__ __forceinline__ float flog(float x) { return __builtin_amdgcn_logf(x) * 0.6931471805599453f; }
__device__ __forceinline__ unsigned bf1(float x) { return cvt_pk_bf16(x, x) & 0xffffu; }
__device__ __forceinline__ unsigned vswz(unsigned row) { return ((row & 3) << 2) | ((row >> 2) & 3); }
__device__ __forceinline__ unsigned voff_b(unsigned row, unsigned ch) { return 256u * row + 16u * (ch ^ vswz(row)); }
__device__ __forceinline__ unsigned vtr_addr(unsigned lane, unsigned c, unsigned ks, unsigned t) {
    const unsigned h = lane >> 5, blk = (lane >> 4) & 1, q = (lane & 15) >> 2, p = lane & 3;
    return voff_b(16 * ks + 8 * h + 4 * t + q, 4 * c + 2 * blk + (p >> 1)) + 8 * (p & 1);
}
typedef short v4i16_t __attribute__((ext_vector_type(4)));
__device__ __forceinline__ void glds16(const void* gsrc, unsigned lds_dst) { unsigned keep;
    asm volatile("s_mov_b32 %0, m0\n\ts_mov_b32 m0, %2\n\ts_nop 0\n\tglobal_load_lds_dwordx4 %1, off\n\ts_mov_b32 m0, %0" : "=&s"(keep) : "v"(gsrc), "s"(lds_dst) : "memory"); }
#define GLA_LDSA(p_) ((unsigned)__builtin_amdgcn_readfirstlane((int)(unsigned)(size_t)(p_)))
#define MFMA32(a, b, c) __builtin_amdgcn_mfma_f32_32x32x16_bf16((a), (b), (c), 0, 0, 0)
#define MFMA16(a, b, c) __builtin_amdgcn_mfma_f32_16x16x32_bf16((a), (b), (c), 0, 0, 0)
template <bool OUT>
__device__ __forceinline__ void gla_unit(LAS unsigned char* lds, const Ptrs& P, int b, int h, int sc) {
    const int tid = threadIdx.x, lane0 = tid & 63, wid = __builtin_amdgcn_readfirstlane(tid >> 6);
#define GLA_LANE_VARS int lanev_ = lane0; asm volatile("" : "+v"(lanev_)); const int lane = lanev_, r = lane & 31, hh = lane >> 5, fr = lane & 15, fq = lane >> 4, col = 16 * wid + fr; (void)r; (void)hh; (void)fr; (void)fq; (void)col
    LAS bf16* QT = (LAS bf16*)(lds + L_QT); LAS bf16* KT = (LAS bf16*)(lds + L_KT); LAS bf16* KDT = (LAS bf16*)(lds + (OUT ? L_KDT : A_KDT)); LAS bf16* AT = (LAS bf16*)(lds + L_AT); LAS bf16* OS = (LAS bf16*)(lds + L_OS);
    LAS unsigned char* VB0 = lds + (OUT ? L_VB : A_VB); LAS unsigned char* KRAW0 = lds + (OUT ? L_KRAW : A_KRAW); LAS unsigned char* QRAW = lds + L_QRAW;
    LAS unsigned char* GLRAW0 = lds - RING_OFF + X_GL; LAS float* NW = (LAS float*)(lds - RING_OFF + X_NW); LAS float* DEC = (LAS float*)(lds - RING_OFF + X_DEC);
    bf16* act = P.act;
    float bias; bf16x8 bh, bl;
    { GLA_LANE_VARS;
        bias = P.bg2[h * 128 + col];
        unsigned hw[4], lw[4];
#pragma unroll
        for (int j = 0; j < 8; j += 2) { const float m_ = fq < 2 ? 1.f : 0.f; const float w0 = P.wg2[(8 * (fq & 1) + j) * 512 + h * 128 + col] * m_, w1 = P.wg2[(8 * (fq & 1) + j + 1) * 512 + h * 128 + col] * m_;
            const unsigned hp = cvt_pk_bf16(w0, w1); hw[j >> 1] = hp; lw[j >> 1] = cvt_pk_bf16(w0 - bf_lo(hp), w1 - bf_hi(hp)); }
        bh = __builtin_bit_cast(bf16x8, (v4u){hw[0], hw[1], hw[2], hw[3]}); bl = __builtin_bit_cast(bf16x8, (v4u){lw[0], lw[1], lw[2], lw[3]}); }
    if (OUT && tid < 256) NW[tid] = P.gnw[tid];
    const int bhs = (b * 4 + h) * 8 + sc;
    float* Hp = P.hst + (size_t)bhs * (128 * 256);
    float dsum = 0.f;
    v4u pgo[4]; v2u pga[4];
    const size_t rowu = (size_t)b * SEQ + sc * 512;
    unsigned okq[2], ov_[4], og_ = 0u, ogo_ = 0u, oga_ = 0u;
    { GLA_LANE_VARS;
#pragma unroll
        for (int pp_ = 0; pp_ < 2; ++pp_) okq[pp_] = (unsigned)((4 * (wid + 8 * pp_) + (lane >> 4)) * ACT_LD + h * 128 + (lane & 15) * 8) * 2u;
#pragma unroll
        for (int pp_ = 0; pp_ < 4; ++pp_) { const int q_ = wid + 8 * pp_, t_ = q_ >> 3; const unsigned rin_ = 4 * (q_ & 7) + (lane >> 4), chin_ = (lane & 15) ^ vswz(rin_);
            ov_[pp_] = (unsigned)((32 * (t_ >> 1) + rin_) * ACT_LD + AC_GV + h * 256 + (16 * (t_ & 1) + chin_) * 8) * 2u; }
        og_ = (unsigned)((32 * wid + (lane >> 1)) * ACT_LD + AC_GR + (lane & 1) * 8) * 2u;
        ogo_ = (unsigned)((8 * wid + (lane >> 3)) * ACT_LD + AC_GO + h * 256 + (lane & 7) * 8) * 2u;
        oga_ = (unsigned)((8 * wid + (lane >> 3)) * 2048 + h * 256 + (lane & 7) * 8); }
#define GLA_CBASE(n_) ((const char*)act + (rowu + (size_t)(n_) * 64) * (ACT_LD * 2))
#define GLA_DMA_KQ(n_, dst_, ac_) do { const char* cb_ = GLA_CBASE(n_) + (ac_) * 2; \
        _Pragma("unroll") for (int pp_ = 0; pp_ < 2; ++pp_) glds16(cb_ + okq[pp_], GLA_LDSA((dst_) + (wid + 8 * pp_) * 1024)); } while (0)
#define GLA_DMA_V(n_, dst_) do { const char* cb_ = GLA_CBASE(n_); \
        _Pragma("unroll") for (int pp_ = 0; pp_ < 4; ++pp_) glds16(cb_ + ov_[pp_], GLA_LDSA((dst_) + (wid + 8 * pp_) * 1024)); } while (0)
#define GLA_DMA_G(n_, dst_) do { if (wid < 2) glds16(GLA_CBASE(n_) + og_, GLA_LDSA((dst_) + wid * 1024)); } while (0)
    f32x16 S[4];
    { GLA_LANE_VARS;
        GLA_DMA_KQ(0, KRAW0, AC_GK); if (OUT) GLA_DMA_KQ(0, QRAW, AC_GQ); GLA_DMA_G(0, GLRAW0); GLA_DMA_V(0, VB0);
#pragma unroll
        for (int i = 0; i < 4; ++i) { const float* hp = Hp + (size_t)(32 * i + 4 * hh) * 256 + 32 * wid + r;
#pragma unroll
            for (int g = 0; g < 16; ++g) S[i][g] = OUT ? hp[((g & 3) + 8 * (g >> 2)) * 256] : 0.f;
            asm volatile("" ::: "memory"); } }
    asm volatile("s_waitcnt vmcnt(0)" ::: "memory");
    LBAR();
#ifndef GPROBE_K
#define GPROBE_K -1
#endif
    unsigned long long gacc = 0ull, gt0 = 0ull; const bool gstamp = OUT && GPROBE_K >= 0 && blockIdx.x == 0 && tid == 0;
#define GST(k_) do { if (gstamp) { const unsigned long long t_ = __builtin_amdgcn_s_memrealtime(); if ((k_) == GPROBE_K) gt0 = t_; if ((k_) == GPROBE_K + 1) gacc += t_ - gt0; } } while (0)
    for (int n = 0; n < 8; ++n) {
        GLA_LANE_VARS;
        GST(0);
        size_t row0 = rowu + n * 64; asm volatile("" : "+s"(row0));
        const int bsel = OUT ? 0 : (n & 1);
        LAS unsigned char* KB = KRAW0 + bsel * 16384; LAS unsigned char* GB = GLRAW0 + bsel * 2048; LAS unsigned char* VB = VB0 + bsel * 32768;
        if (!OUT && n + 1 < 8) { GLA_DMA_KQ(n + 1, KRAW0 + (bsel ^ 1) * 16384, AC_GK); GLA_DMA_G(n + 1, GLRAW0 + (bsel ^ 1) * 2048); GLA_DMA_V(n + 1, VB0 + (bsel ^ 1) * 32768); }
        bf16x8 bv[4];
#pragma unroll
        for (int ks = 0; ks < 4; ++ks) { LAS unsigned char* tb = VB + ((ks >> 1) * 2 + (wid >> 2)) * 8192;
            const v4i16_t lo = __builtin_amdgcn_ds_read_tr16_b64_v4i16((LAS v4i16_t*)(tb + vtr_addr(lane, wid & 3, ks & 1, 0))), hi = __builtin_amdgcn_ds_read_tr16_b64_v4i16((LAS v4i16_t*)(tb + vtr_addr(lane, wid & 3, ks & 1, 1)));
            bv[ks] = __builtin_shufflevector(lo, hi, 0, 1, 2, 3, 4, 5, 6, 7); }
        f32x4 lg[4];
#pragma unroll
        for (int mi = 0; mi < 4; ++mi) { const bf16x8 a = *(const LAS bf16x8*)(GB + (16 * mi + fr) * 32 + (fq & 1) * 16);
            lg[mi] = MFMA16(a, bh, ((f32x4){bias, bias, bias, bias})); lg[mi] = MFMA16(a, bl, lg[mi]); }
        float bq[4][4]; float run = 0.f;
#pragma unroll
        for (int mi = 0; mi < 4; ++mi) { float c = 0.f;
#pragma unroll
            for (int g = 0; g < 4; ++g) { const float l = lg[mi][g]; c += (fminf(l, 0.f) - flog(1.f + fexp(-fabsf(l)))) * (1.f / 16.f); bq[mi][g] = c; }
            const float p1 = __shfl_xor(c, 16), pp = c + p1, p2 = __shfl_xor(pp, 32);
            const float base = run + ((fq & 1) ? p1 : 0.f) + ((fq & 2) ? p2 : 0.f);
#pragma unroll
            for (int g = 0; g < 4; ++g) bq[mi][g] += base;
            run += pp + p2; }
        const float tot = run, etot = fexp(tot);
#pragma unroll
        for (int mi = 0; mi < 4; ++mi) { float kd[4];
#pragma unroll
            for (int g = 0; g < 4; ++g) { const int row = 16 * mi + 4 * fq + g; const float bi = bq[mi][g];
                const float kraw = __uint_as_float((unsigned)(*(const LAS bf16*)(KB + (row * 128 + col) * 2)) << 16);
                const float kt = kraw * fexp(-bi);
                kd[g] = kt * etot;
                if (OUT) { const float qraw = __uint_as_float((unsigned)(*(const LAS bf16*)(QRAW + (row * 128 + col) * 2)) << 16);
                    QT[row * QT_LD + col] = (bf16)bf1(qraw * 0.08838834764831845f * fexp(bi)); KT[row * QT_LD + col] = (bf16)bf1(kt); } }
            *(LAS v2u*)(KDT + col * KD_LD + 16 * mi + 4 * fq) = (v2u){cvt_pk_bf16(kd[0], kd[1]), cvt_pk_bf16(kd[2], kd[3])}; }
        if (fq == 0) DEC[col] = etot;
        dsum += tot;
        LBAR();
        GST(1);
        f32x16 o[2];
        if (OUT) {
#pragma unroll
            for (int tt = 0; tt < 2; ++tt) { const int t = 2 * wid + tt, mi = t >> 2, nj = t & 3; f32x4 a4 = (f32x4){0.f, 0.f, 0.f, 0.f};
                if (nj <= mi) {
#pragma unroll
                    for (int s = 0; s < 4; ++s) { const bf16x8 a = *(const LAS bf16x8*)(QT + (16 * mi + fr) * QT_LD + 32 * s + 8 * fq); const bf16x8 bb = *(const LAS bf16x8*)(KT + (16 * nj + fr) * QT_LD + 32 * s + 8 * fq); a4 = MFMA16(a, bb, a4); } }
#pragma unroll
                for (int g = 0; g < 4; ++g) { const int row = 16 * mi + 4 * fq + g, cc = 16 * nj + fr; AT[row * AT_LD + cc] = (bf16)bf1(cc <= row ? a4[g] : 0.f); } }
            LBAR();
            GST(2);
            const bool more = n + 1 < 8;
            if (more) GLA_DMA_KQ(n + 1, KRAW0, AC_GK);
#pragma unroll
            for (int mt = 0; mt < 2; ++mt) {
#pragma unroll
                for (int g = 0; g < 16; ++g) o[mt][g] = 0.f;
#pragma unroll
                for (int ks = 0; ks < 4; ++ks) if (mt == 1 || ks < 2) { const bf16x8 a = *(const LAS bf16x8*)(AT + (32 * mt + r) * AT_LD + 16 * ks + 8 * hh); o[mt] = MFMA32(a, bv[ks], o[mt]); }
            }
            if (more) { GLA_DMA_KQ(n + 1, QRAW, AC_GQ); GLA_DMA_G(n + 1, GLRAW0); }
#pragma unroll
            for (int i = 0; i < 4; ++i) {
                bf16x8 sp[2];
#pragma unroll
                for (int s = 0; s < 2; ++s) { v4u w; w.x = cvt_pk_bf16(S[i][8 * s + 0], S[i][8 * s + 1]); w.y = cvt_pk_bf16(S[i][8 * s + 2], S[i][8 * s + 3]); w.z = cvt_pk_bf16(S[i][8 * s + 4], S[i][8 * s + 5]); w.w = cvt_pk_bf16(S[i][8 * s + 6], S[i][8 * s + 7]); sp[s] = __builtin_bit_cast(bf16x8, w); }
#pragma unroll
                for (int mt = 0; mt < 2; ++mt)
#pragma unroll
                    for (int s = 0; s < 2; ++s) { const s16x4 lo = *(const LAS s16x4*)(QT + (32 * mt + r) * QT_LD + 32 * i + 16 * s + 4 * hh); const s16x4 hi = *(const LAS s16x4*)(QT + (32 * mt + r) * QT_LD + 32 * i + 16 * s + 8 + 4 * hh);
                        const bf16x8 a = __builtin_shufflevector(lo, hi, 0, 1, 2, 3, 4, 5, 6, 7); o[mt] = MFMA32(a, sp[s], o[mt]); }
                if (i == 1 && more) GLA_DMA_V(n + 1, VB0);
            }
            { const char* gop = GLA_CBASE(n) + ogo_;
#pragma unroll
                for (int q4 = 0; q4 < 4; ++q4) pgo[q4] = *(const GAS v4u*)(gop + q4 * 128);
                const unsigned char* gap = P.gates + (rowu + (size_t)n * 64) * 2048 + oga_;
#pragma unroll
                for (int q4 = 0; q4 < 4; ++q4) pga[q4] = *(const GAS v2u*)(gap + q4 * 64); }
        }
#pragma unroll
        for (int i = 0; i < 4; ++i) {
#pragma unroll
            for (int g = 0; g < 16; ++g) S[i][g] *= DEC[32 * i + crow(g, hh)];
#pragma unroll
            for (int ks = 0; ks < 4; ++ks) { const bf16x8 a = *(const LAS bf16x8*)(KDT + (32 * i + r) * KD_LD + 16 * ks + 8 * hh); S[i] = MFMA32(a, bv[ks], S[i]); }
        }
        if (!OUT) { asm volatile("s_waitcnt vmcnt(0)" ::: "memory"); LBAR(); }
        if (OUT) {
            LBAR();
            GST(3);
#pragma unroll
            for (int mt = 0; mt < 2; ++mt)
#pragma unroll
                for (int g = 0; g < 16; ++g) OS[(32 * mt + crow(g, hh)) * OS_LD + 32 * wid + r] = (bf16)bf1(o[mt][g]);
            LBAR();
            GST(4);
            asm volatile("s_waitcnt vmcnt(0)" ::: "memory");
            const int rowl = 8 * wid + (lane >> 3), part = lane & 7; const LAS bf16* orow = OS + rowl * OS_LD + part * 8;
            f32x4 ov[8]; float ss = 0.f;
#pragma unroll
            for (int q4 = 0; q4 < 4; ++q4) { const v4u w = *(const LAS v4u*)(orow + 64 * q4); ov[2 * q4] = (f32x4){bf_lo(w.x), bf_hi(w.x), bf_lo(w.y), bf_hi(w.y)}; ov[2 * q4 + 1] = (f32x4){bf_lo(w.z), bf_hi(w.z), bf_lo(w.w), bf_hi(w.w)};
                ss += dot4(ov[2 * q4], ov[2 * q4]) + dot4(ov[2 * q4 + 1], ov[2 * q4 + 1]); }
            ss += __shfl_xor(ss, 1); ss += __shfl_xor(ss, 2); ss += __shfl_xor(ss, 4);
            const float rstd = 1.f / sqrtf(ss * (1.f / 256.f) + RMS_EPS);
            bf16* orp = act + (row0 + rowl) * ACT_LD + AC_OGLA + h * 256 + part * 8; const LAS float* nw = NW + part * 8;
#pragma unroll
            for (int q4 = 0; q4 < 4; ++q4) { const v4u gg = pgo[q4]; const f32x4 w0 = *(const LAS f32x4*)(nw + q4 * 64), w1 = *(const LAS f32x4*)(nw + q4 * 64 + 4); const v2u gb_ = pga[q4];
                const f32x4 ga0 = (f32x4){(float)(gb_.x & 0xffu), (float)((gb_.x >> 8) & 0xffu), (float)((gb_.x >> 16) & 0xffu), (float)(gb_.x >> 24)} * (1.f / 255.f), ga1 = (f32x4){(float)(gb_.y & 0xffu), (float)((gb_.y >> 8) & 0xffu), (float)((gb_.y >> 16) & 0xffu), (float)(gb_.y >> 24)} * (1.f / 255.f);
                const f32x4 a0 = ov[2 * q4] * rstd * w0 * ga0, a1 = ov[2 * q4 + 1] * rstd * w1 * ga1;
                const float g0 = bf_lo(gg.x), g1 = bf_hi(gg.x), g2 = bf_lo(gg.y), g3 = bf_hi(gg.y), g4 = bf_lo(gg.z), g5 = bf_hi(gg.z), g6 = bf_lo(gg.w), g7 = bf_hi(gg.w);
                v4u w; w.x = cvt_pk_bf16(a0.x * g0 * sigmoidf_(g0), a0.y * g1 * sigmoidf_(g1)); w.y = cvt_pk_bf16(a0.z * g2 * sigmoidf_(g2), a0.w * g3 * sigmoidf_(g3));
                w.z = cvt_pk_bf16(a1.x * g4 * sigmoidf_(g4), a1.y * g5 * sigmoidf_(g5)); w.w = cvt_pk_bf16(a1.z * g6 * sigmoidf_(g6), a1.w * g7 * sigmoidf_(g7));
                *(GAS v4u*)(orp + q4 * 64) = w; }
            LBAR();
            GST(5);
        }
    }
    if (gstamp) __hip_atomic_store(P.dbg, (unsigned)gacc, RLX_AGENT);
#undef GST
#undef GLA_DMA_KQ
#undef GLA_DMA_V
#undef GLA_DMA_G
#undef GLA_CBASE
    if (!OUT) { GLA_LANE_VARS;
#pragma unroll
        for (int i = 0; i < 4; ++i)
#pragma unroll
            for (int g = 0; g < 16; ++g) Hp[(32 * i + crow(g, hh)) * 256 + 32 * wid + r] = S[i][g];
        if (fq == 0) P.dt[bhs * 128 + col] = fexp(dsum);
    }
#undef GLA_LANE_VARS
}
__device__ __forceinline__ void gla_scan(const Ptrs& P, int gt, int NT) {
    for (int v = gt; v < 32 * 128 * 64; v += NT) {
        const int bh = v >> 13, rem = v & 8191, dk = rem >> 6, dv4 = rem & 63;
        f32x4 s = (f32x4){0.f, 0.f, 0.f, 0.f};
#pragma unroll
        for (int sc = 0; sc < 8; ++sc) { GAS f32x4* p = (GAS f32x4*)(P.hst + ((size_t)(bh * 8 + sc) * 128 + dk) * 256) + dv4;
            f32x4 hv = (f32x4){0.f, 0.f, 0.f, 0.f}; float dd = 0.f; if (sc < 7) { hv = *p; dd = P.dt[(bh * 8 + sc) * 128 + dk]; }
            *p = s; s = s * dd + hv; }
    }
}
#undef MFMA32
#undef MFMA16
}

__device__ __forceinline__ void p7_combine(const Ptrs& P, int gw, int NGW, int lane) {
    const float s1 = wave_sum(P.lq1[lane] * P.lk1[lane]), s2 = wave_sum(P.lq2[lane] * P.lk2[lane]);
    const float lam = expf(s1) - expf(s2) + LAM_INIT;
    f32x4 nw[4];
#pragma unroll
    for (int q = 0; q < 4; ++q) nw[q] = *(const f32x4*)(P.dnw + ((16 * lane) & 127) + 4 * q) * (1.f - LAM_INIT);
    for (int m = gw; m < T; m += NGW) {
        bf16* rp = P.act + (size_t)m * ACT_LD + 16 * lane;
        const v4u a0 = *(const GAS v4u*)(rp + AC_O1), a1 = *(const GAS v4u*)(rp + AC_O1 + 8), b0 = *(const GAS v4u*)(rp + AC_O2), b1 = *(const GAS v4u*)(rp + AC_O2 + 8);
        float v[16];
        v[0] = bf_lo(a0.x) - lam * bf_lo(b0.x); v[1] = bf_hi(a0.x) - lam * bf_hi(b0.x); v[2] = bf_lo(a0.y) - lam * bf_lo(b0.y); v[3] = bf_hi(a0.y) - lam * bf_hi(b0.y);
        v[4] = bf_lo(a0.z) - lam * bf_lo(b0.z); v[5] = bf_hi(a0.z) - lam * bf_hi(b0.z); v[6] = bf_lo(a0.w) - lam * bf_lo(b0.w); v[7] = bf_hi(a0.w) - lam * bf_hi(b0.w);
        v[8] = bf_lo(a1.x) - lam * bf_lo(b1.x); v[9] = bf_hi(a1.x) - lam * bf_hi(b1.x); v[10] = bf_lo(a1.y) - lam * bf_lo(b1.y); v[11] = bf_hi(a1.y) - lam * bf_hi(b1.y);
        v[12] = bf_lo(a1.z) - lam * bf_lo(b1.z); v[13] = bf_hi(a1.z) - lam * bf_hi(b1.z); v[14] = bf_lo(a1.w) - lam * bf_lo(b1.w); v[15] = bf_hi(a1.w) - lam * bf_hi(b1.w);
        float ss = 0.f;
#pragma unroll
        for (int e = 0; e < 16; ++e) ss += v[e] * v[e];
        ss += __shfl_xor(ss, 1); ss += __shfl_xor(ss, 2); ss += __shfl_xor(ss, 4);
        const float rstd = 1.f / sqrtf(ss * (1.f / 128.f) + RMS_EPS);
        v4u w0, w1;
        w0.x = cvt_pk_bf16(v[0] * rstd * nw[0].x, v[1] * rstd * nw[0].y); w0.y = cvt_pk_bf16(v[2] * rstd * nw[0].z, v[3] * rstd * nw[0].w); w0.z = cvt_pk_bf16(v[4] * rstd * nw[1].x, v[5] * rstd * nw[1].y); w0.w = cvt_pk_bf16(v[6] * rstd * nw[1].z, v[7] * rstd * nw[1].w);
        w1.x = cvt_pk_bf16(v[8] * rstd * nw[2].x, v[9] * rstd * nw[2].y); w1.y = cvt_pk_bf16(v[10] * rstd * nw[2].z, v[11] * rstd * nw[2].w); w1.z = cvt_pk_bf16(v[12] * rstd * nw[3].x, v[13] * rstd * nw[3].y); w1.w = cvt_pk_bf16(v[14] * rstd * nw[3].z, v[15] * rstd * nw[3].w);
        *(GAS v4u*)(rp + AC_ODIFF) = w0; *(GAS v4u*)(rp + AC_ODIFF + 8) = w1;
    }
}

namespace rtr {
constexpr int U_LD = 1032;
constexpr int L_UH = 0, L_UL = 16 * U_LD * 2, L_PART = 2 * 16 * U_LD * 2, L_LOG = L_PART + 8 * 3 * 256 * 4, L_HIST = L_LOG + 16 * 48 * 4, L_LN = L_HIST + 128, L_ADA = L_LN + 2 * D * 4, L_END = L_ADA + 2 * 3 * D * 4;
static_assert(L_END <= RING_BYTES, "router LDS map");
}
__device__ __forceinline__ void p10_ln_router(const Ptrs& P, LAS unsigned char* lds, int vcu, int G, int tid, int lane, int wave) {
    LAS bf16* UH = (LAS bf16*)(lds + RING_OFF + rtr::L_UH); LAS bf16* UL = (LAS bf16*)(lds + RING_OFF + rtr::L_UL);
    LAS float* PART = (LAS float*)(lds + RING_OFF + rtr::L_PART); LAS float* LOG = (LAS float*)(lds + RING_OFF + rtr::L_LOG); LAS int* hist = (LAS int*)(lds + RING_OFF + rtr::L_HIST);
    const int fr = lane & 15, fq = lane >> 4;
    bf16x8 bh[3][4], bl[3][4];
#pragma unroll
    for (int nt = 0; nt < 3; ++nt)
#pragma unroll
        for (int s = 0; s < 4; ++s) { const int n = nt * 16 + fr, k0 = 128 * wave + 32 * s + 8 * fq; unsigned hw[4], lw[4];
#pragma unroll
            for (int j = 0; j < 8; j += 2) { const int ng = n < 4 ? n : 3, ne = n < 4 ? 0 : (n < 36 ? n - 4 : 31);
                const float g0 = P.wrg[(k0 + j) * 4 + ng], g1 = P.wrg[(k0 + j + 1) * 4 + ng], e0 = P.wre[(k0 + j) * 32 + ne], e1 = P.wre[(k0 + j + 1) * 32 + ne];
                const float w0 = n < 4 ? g0 : (n < 36 ? e0 : 0.f), w1 = n < 4 ? g1 : (n < 36 ? e1 : 0.f);
                const unsigned h = cvt_pk_bf16(w0, w1); hw[j >> 1] = h; lw[j >> 1] = cvt_pk_bf16(w0 - bf_lo(h), w1 - bf_hi(h)); }
            bh[nt][s] = __builtin_bit_cast(bf16x8, (v4u){hw[0], hw[1], hw[2], hw[3]}); bl[nt][s] = __builtin_bit_cast(bf16x8, (v4u){lw[0], lw[1], lw[2], lw[3]}); }
    if (tid < 32) hist[tid] = 0;
    LAS f32x4* LNV = (LAS f32x4*)(lds + RING_OFF + rtr::L_LN); LAS f32x4* ADV = (LAS f32x4*)(lds + RING_OFF + rtr::L_ADA);
    LNV[tid] = tid < 256 ? *((const f32x4*)P.ln1w + tid) : *((const f32x4*)P.ln1b + (tid - 256));
    if (vcu < T / 16) { const f32x4* ap = (const f32x4*)(P.ada + (size_t)((vcu * 16) / SEQ) * 6 * D + 2 * D); ADV[tid] = ap[tid]; if (tid < 256) ADV[512 + tid] = ap[512 + tid]; }
    LBAR();
    int abuf = 0;
    f32x4 pre[2][4]; v2u prey[2][4];
    if (vcu < T / 16) {
#pragma unroll
        for (int rr = 0; rr < 2; ++rr) { const size_t m_ = (size_t)(vcu * 16 + wave * 2 + rr); const GAS f32x4* xr = (const GAS f32x4*)(P.x + m_ * D) + lane; const GAS v2u* yr = (const GAS v2u*)(P.act + m_ * ACT_LD + AC_Y) + lane;
#pragma unroll
            for (int j = 0; j < 4; ++j) { pre[rr][j] = xr[64 * j]; prey[rr][j] = yr[64 * j]; } } }
#ifndef RPROBE_K
#define RPROBE_K -1
#endif
    unsigned long long racc = 0ull, rt0 = 0ull; const bool rstamp = RPROBE_K >= 0 && blockIdx.x == 0 && tid == 0;
#define RST(k_) do { if (rstamp) { const unsigned long long t_ = __builtin_amdgcn_s_memrealtime(); if ((k_) == RPROBE_K) rt0 = t_; if ((k_) == RPROBE_K + 1) racc += t_ - rt0; } } while (0)
    for (int batch = vcu; batch < T / 16; batch += G) {
        RST(0);
        f32x4 adn0 = (f32x4){0.f, 0.f, 0.f, 0.f}, adn1 = adn0;
        if (batch + G < T / 16) { const f32x4* ap = (const f32x4*)(P.ada + (size_t)(((batch + G) * 16) / SEQ) * 6 * D + 2 * D); adn0 = ap[tid]; if (tid < 256) adn1 = ap[512 + tid]; }
#pragma unroll
        for (int rr = 0; rr < 2; ++rr) {
            const int rl = wave * 2 + rr, m = batch * 16 + rl, b = m / SEQ;
            GAS f32x4* xr = (GAS f32x4*)(P.out + (size_t)m * D) + lane;
            f32x4 v[4]; float s = 0.f;
#pragma unroll
            for (int j = 0; j < 4; ++j) { const f32x4 g1 = ADV[abuf * 768 + lane + 64 * j]; const v2u yv = prey[rr][j];
                v[j] = pre[rr][j] * ALPHA + g1 * (f32x4){bf_lo(yv.x), bf_hi(yv.x), bf_lo(yv.y), bf_hi(yv.y)}; s += (v[j].x + v[j].y) + (v[j].z + v[j].w); }
            float mean = wave_sum(s) * (1.f / D), s2 = 0.f;
#pragma unroll
            for (int j = 0; j < 4; ++j) { v[j] = v[j] - mean; s2 += dot4(v[j], v[j]); }
            float rstd = 1.f / sqrtf(wave_sum(s2) * (1.f / D) + LN_EPS);
            s = 0.f;
#pragma unroll
            for (int j = 0; j < 4; ++j) { const f32x4 w = LNV[lane + 64 * j], bb = LNV[256 + lane + 64 * j]; v[j] = v[j] * rstd * w + bb; xr[64 * j] = v[j]; s += (v[j].x + v[j].y) + (v[j].z + v[j].w); }
            mean = wave_sum(s) * (1.f / D); s2 = 0.f;
#pragma unroll
            for (int j = 0; j < 4; ++j) { v[j] = v[j] - mean; s2 += dot4(v[j], v[j]); }
            rstd = 1.f / sqrtf(wave_sum(s2) * (1.f / D) + LN_EPS);
            const LAS f32x4* sh = ADV + abuf * 768 + 256 + lane; const LAS f32x4* sl = ADV + abuf * 768 + 512 + lane;
            GAS v2u* o8 = (GAS v2u*)(P.u + (size_t)m * D) + lane;
#pragma unroll
            for (int j = 0; j < 4; ++j) { const f32x4 a = sh[64 * j], c = sl[64 * j]; const f32x4 uu = v[j] * rstd * (c + 1.f) + a;
                v2u hw; hw.x = cvt_pk_bf16(uu.x, uu.y); hw.y = cvt_pk_bf16(uu.z, uu.w); o8[64 * j] = hw;
                v2u lw; lw.x = cvt_pk_bf16(uu.x - bf_lo(hw.x), uu.y - bf_hi(hw.x)); lw.y = cvt_pk_bf16(uu.z - bf_lo(hw.y), uu.w - bf_hi(hw.y));
                *(LAS v2u*)(UH + rl * rtr::U_LD + 4 * lane + 256 * j) = hw; *(LAS v2u*)(UL + rl * rtr::U_LD + 4 * lane + 256 * j) = lw; }
        }
        if (batch + G < T / 16) {
#pragma unroll
            for (int rr = 0; rr < 2; ++rr) { const size_t m_ = (size_t)((batch + G) * 16 + wave * 2 + rr); const GAS f32x4* xr = (const GAS f32x4*)(P.x + m_ * D) + lane; const GAS v2u* yr = (const GAS v2u*)(P.act + m_ * ACT_LD + AC_Y) + lane;
#pragma unroll
                for (int j = 0; j < 4; ++j) { pre[rr][j] = xr[64 * j]; prey[rr][j] = yr[64 * j]; } }
            ADV[(abuf ^ 1) * 768 + tid] = adn0; if (tid < 256) ADV[(abuf ^ 1) * 768 + 512 + tid] = adn1; }
        abuf ^= 1;
        LBAR();
        RST(1);
        f32x4 acc[3];
#pragma unroll
        for (int nt = 0; nt < 3; ++nt) acc[nt] = (f32x4){0.f, 0.f, 0.f, 0.f};
#pragma unroll
        for (int s = 0; s < 4; ++s) { const int kk = 128 * wave + 32 * s + 8 * fq;
            const bf16x8 ah = *(const LAS bf16x8*)(UH + fr * rtr::U_LD + kk), al = *(const LAS bf16x8*)(UL + fr * rtr::U_LD + kk);
#pragma unroll
            for (int nt = 0; nt < 3; ++nt) { acc[nt] = __builtin_amdgcn_mfma_f32_16x16x32_bf16(ah, bh[nt][s], acc[nt], 0, 0, 0); acc[nt] = __builtin_amdgcn_mfma_f32_16x16x32_bf16(ah, bl[nt][s], acc[nt], 0, 0, 0);
                acc[nt] = __builtin_amdgcn_mfma_f32_16x16x32_bf16(al, bh[nt][s], acc[nt], 0, 0, 0); } }
#pragma unroll
        for (int nt = 0; nt < 3; ++nt)
#pragma unroll
            for (int g = 0; g < 4; ++g) PART[(wave * 3 + nt) * 256 + (4 * fq + g) * 16 + fr] = acc[nt][g];
        LBAR();
        RST(2);
        { const int row = tid >> 5, c = tid & 31;
#pragma unroll
            for (int hf = 0; hf < 2; ++hf) { const int cc = c + 32 * hf; if (cc < 48) { const int nt = cc >> 4, ci = cc & 15; float sm = 0.f;
#pragma unroll
                for (int w = 0; w < 8; ++w) sm += PART[(w * 3 + nt) * 256 + row * 16 + ci];
                LOG[row * 48 + cc] = sm; } } }
        LBAR();
        RST(3);
        if (tid < 16) { const int m = batch * 16 + tid; const LAS float* lgs = LOG + tid * 48;
            float lg[4], le[32];
#pragma unroll
            for (int c = 0; c < 4; ++c) lg[c] = lgs[c] + P.brg[c];
#pragma unroll
            for (int c = 0; c < 32; ++c) le[c] = lgs[4 + c] + P.bre[c];
            int g = 0; float gm = lg[0];
#pragma unroll
            for (int c = 1; c < 4; ++c) if (lg[c] > gm) { gm = lg[c]; g = c; }
            float gs = 0.f;
#pragma unroll
            for (int c = 0; c < 4; ++c) gs += expf(lg[c] - gm);
            const float wgrp = 1.f / gs;
            float es[8];
#pragma unroll
            for (int i = 0; i < 8; ++i) es[i] = g == 0 ? le[i] : (g == 1 ? le[8 + i] : (g == 2 ? le[16 + i] : le[24 + i]));
            int i0 = 0; float v0 = es[0];
#pragma unroll
            for (int i = 1; i < 8; ++i) if (es[i] > v0) { v0 = es[i]; i0 = i; }
            int i1 = -1; float v1 = -INFINITY;
#pragma unroll
            for (int i = 0; i < 8; ++i) if (i != i0 && es[i] > v1) { v1 = es[i]; i1 = i; }
            const float p1 = 1.f / (1.f + expf(v0 - v1)), p0 = 1.f - p1;
            const int e0 = g * 8 + i0, e1 = g * 8 + i1;
            P.toke[2 * m] = e0; P.toke[2 * m + 1] = e1; P.tokw[2 * m] = wgrp * p0; P.tokw[2 * m + 1] = wgrp * p1;
            __hip_atomic_fetch_add(hist + e0, 1, __ATOMIC_RELAXED, __HIP_MEMORY_SCOPE_WORKGROUP); __hip_atomic_fetch_add(hist + e1, 1, __ATOMIC_RELAXED, __HIP_MEMORY_SCOPE_WORKGROUP); }
        RST(4);
    }
    if (rstamp) __hip_atomic_store(P.dbg, (unsigned)racc, RLX_AGENT);
#undef RST
    LBAR();
    if (tid < 32) P.cnt[vcu * 32 + tid] = hist[tid];
}

__device__ __forceinline__ void p11_dispatch(const Ptrs& P, LAS unsigned char* lds, int vcu, int G, int tid, int lane) {
    LAS int* tot = (LAS int*)(lds + RING_OFF); LAS int* base = tot + 32; LAS int* cur = tot + 64; LAS int* pst = tot + 96;
    LAS int* CL = (LAS int*)(lds + RING_OFF + 1024);
    LAS int* PS = (LAS int*)(lds + RING_OFF + 1024 + 512 * 32 * 4);
    for (int i = tid; i < G * 32; i += NWAVES * 64) CL[i] = P.cnt[i];
    __syncthreads();
    { const int e = tid & 31, g = tid >> 5, per = (G + 15) / 16; int sm = 0;
        for (int w = g * per; w < (g + 1) * per && w < G; ++w) sm += CL[w * 32 + e];
        PS[g * 32 + e] = sm; }
    __syncthreads();
    if (tid < 32) { const int per = (G + 15) / 16, gm = vcu / per; int total = 0, mine = 0;
#pragma unroll
        for (int g = 0; g < 16; ++g) { const int c = PS[g * 32 + tid]; total += c; mine += (g < gm) ? c : 0; }
        for (int w = gm * per; w < vcu; ++w) mine += CL[w * 32 + tid];
        tot[tid] = total; base[tid] = mine; cur[tid] = 0; }
    __syncthreads();
    if (tid == 0) { int p = 0, nt = 0;
        for (int e = 0; e < 32; ++e) { pst[e] = p; const int nte = (tot[e] + 255) >> 8;
            for (int k = 0; k < nte; ++k) { if (vcu == 0) { P.tab[1 + nt] = e; P.tab[1 + pg8::TILE_MAX + nt] = p + 256 * k; } ++nt; }
            p += nte * 256; }
        pst[32] = p; if (vcu == 0) P.tab[0] = nt; }
    __syncthreads();
    const int nb = (T / 16 - vcu + G - 1) / G;
    for (int idx = tid; idx < nb * 32; idx += NWAVES * 64) { const int bi = idx >> 5, pr = idx & 31, ts = ((vcu + G * bi) * 16) * 2 + pr;
        const int e = P.toke[ts]; const int pos = pst[e] + base[e] + __hip_atomic_fetch_add(cur + e, 1, __ATOMIC_RELAXED, __HIP_MEMORY_SCOPE_WORKGROUP);
        P.rowtok[pos] = ts; P.roww[pos] = P.tokw[ts]; }
    if (vcu < 32) { const int e = vcu, lim = pst[e + 1] - pst[e];
        for (int r = tot[e] + tid; r < lim; r += NWAVES * 64) { P.rowtok[pst[e] + r] = -1; P.roww[pst[e] + r] = 0.f; } }
}

__device__ __forceinline__ void p14_final(const Ptrs& P, int gw, int NGW, int lane, float dscale) {
    f32x4 lw[4], lb[4];
#pragma unroll
    for (int j = 0; j < 4; ++j) { lw[j] = *((const f32x4*)P.ln2w + lane + 64 * j) * dscale; lb[j] = *((const f32x4*)P.ln2b + lane + 64 * j) * dscale; }
    for (int blk = gw; blk < T / 16; blk += NGW) {
        const int m0 = blk * 16, b = m0 / SEQ;
        f32x4 g2[4];
#pragma unroll
        for (int j = 0; j < 4; ++j) g2[j] = *((const f32x4*)(P.ada + (size_t)b * 6 * D + 5 * D) + lane + 64 * j);
        f32x4 px[2][4]; v2u pa[2][4], pc[2][4];
#define P14_LOAD(slot_, m_) do { const GAS f32x4* xr_ = (const GAS f32x4*)(P.out + (size_t)(m_) * D) + lane; \
            const GAS v2u* q0_ = (const GAS v2u*)(P.mout + (size_t)(2 * (m_)) * D) + lane; const GAS v2u* q1_ = (const GAS v2u*)(P.mout + (size_t)(2 * (m_) + 1) * D) + lane; \
            _Pragma("unroll") for (int j = 0; j < 4; ++j) { px[slot_][j] = xr_[64 * j]; pa[slot_][j] = q0_[64 * j]; pc[slot_][j] = q1_[64 * j]; } } while (0)
        P14_LOAD(0, m0); P14_LOAD(1, m0 + 1);
#define P14_ROW(sl_, m_, more_) do { const int m = (m_); f32x4 v[4]; float s = 0.f; \
            _Pragma("unroll") for (int j = 0; j < 4; ++j) { const v2u a = pa[sl_][j], c = pc[sl_][j]; const f32x4 mm = (f32x4){bf_lo(a.x) + bf_lo(c.x), bf_hi(a.x) + bf_hi(c.x), bf_lo(a.y) + bf_lo(c.y), bf_hi(a.y) + bf_hi(c.y)}; \
                v[j] = px[sl_][j] * ALPHA + g2[j] * mm; s += (v[j].x + v[j].y) + (v[j].z + v[j].w); } \
            if (more_) P14_LOAD(sl_, m + 2); \
            const float mean = wave_sum(s) * (1.f / D); float s2 = 0.f; \
            _Pragma("unroll") for (int j = 0; j < 4; ++j) { v[j] = v[j] - mean; s2 += dot4(v[j], v[j]); } \
            const float rstd = 1.f / sqrtf(wave_sum(s2) * (1.f / D) + LN_EPS); \
            GAS f32x4* xr = (GAS f32x4*)(P.out + (size_t)m * D) + lane; \
            _Pragma("unroll") for (int j = 0; j < 4; ++j) xr[64 * j] = v[j] * rstd * lw[j] + lb[j]; } while (0)
#pragma unroll 1
        for (int rp = 0; rp < 8; ++rp) { P14_ROW(0, m0 + 2 * rp, rp < 7); P14_ROW(1, m0 + 2 * rp + 1, rp < 7); }
#undef P14_ROW
#undef P14_LOAD
    }
}

constexpr int NPH = 15;
constexpr int N_LAUNCHES = MK_N_LAUNCHES;
static_assert(N_LAUNCHES == 1 || N_LAUNCHES == NPH, "MK_N_LAUNCHES is 1 or 15");
struct Args { const void* in[26]; float* out; unsigned char* ws; int ph_lo, ph_hi; };
__global__ void __launch_bounds__(NWAVES * 64, 2) fwd_kernel(Args args) {
    extern __shared__ __attribute__((aligned(16))) unsigned char lds_raw[];
    LAS unsigned char* lds = (LAS unsigned char*)lds_raw;
    volatile LAS unsigned* MISC = (volatile LAS unsigned*)(lds + MISC_OFF);
    const int tid = threadIdx.x, lane = tid & 63, wave = __builtin_amdgcn_readfirstlane(tid >> 6);
    const int G = gridDim.x; const int bx = blockIdx.x; const int vcu = (G % 8 == 0) ? (bx % 8) * (G / 8) + bx / 8 : bx;
    const int gw = vcu * NWAVES + wave, NGW = G * NWAVES;
    unsigned char* ws = args.ws;
    gu32* ctl = (gu32*)(ws + WS_CTL);
    Ptrs P;
    P.x = (const float*)args.in[0]; P.c = (const float*)args.in[1]; P.pos = (const int*)args.in[2]; P.w_ada = (const float*)args.in[3]; P.b_ada = (const float*)args.in[4]; P.w_in = (const float*)args.in[5];
    P.wg2 = (const float*)args.in[6]; P.bg2 = (const float*)args.in[7]; P.gnw = (const float*)args.in[8]; P.lq1 = (const float*)args.in[9]; P.lk1 = (const float*)args.in[10]; P.lq2 = (const float*)args.in[11]; P.lk2 = (const float*)args.in[12];
    P.dnw = (const float*)args.in[13]; P.w_out = (const float*)args.in[14]; P.ln1w = (const float*)args.in[15]; P.ln1b = (const float*)args.in[16]; P.wrg = (const float*)args.in[17]; P.brg = (const float*)args.in[18];
    P.wre = (const float*)args.in[19]; P.bre = (const float*)args.in[20]; P.weg = (const float*)args.in[21]; P.weu = (const float*)args.in[22]; P.wed = (const float*)args.in[23]; P.ln2w = (const float*)args.in[24]; P.ln2b = (const float*)args.in[25];
    P.out = args.out;
    P.ada = (float*)(ws + WS_ADA); P.wrt = (float*)(ws + WS_WRT); P.tokw = (float*)(ws + WS_TOKW); P.roww = (float*)(ws + WS_ROWW); P.dt = (float*)(ws + WS_DT); P.hst = (float*)(ws + WS_HST);
    P.cnt = (int*)(ws + WS_CNT); P.tab = (int*)(ws + WS_TAB); P.toke = (int*)(ws + WS_TOKE); P.rowtok = (int*)(ws + WS_ROWTOK);
    P.win = (bf16*)(ws + WS_WIN); P.wmg = (bf16*)(ws + WS_WMG); P.wout = (bf16*)(ws + WS_WOUT); P.wgu = (bf16*)(ws + WS_WGU); P.wd = (bf16*)(ws + WS_WD); P.u = (bf16*)(ws + WS_U); P.act = (bf16*)(ws + WS_ACT);
    P.hbuf = (bf16*)(ws + WS_HBUF); P.mout = (bf16*)(ws + WS_MOUT); P.dqk = (bf16*)args.out;
    P.dbg = (unsigned*)(ctl + 2); P.gates = ws + WS_GATES;
    for (int u = tid; u < (LDS_BYTES - LDSCTL_OFF) / 4; u += NWAVES * 64) ((LAS unsigned*)(lds + LDSCTL_OFF))[u] = 0u;
    __syncthreads();
    XcdBarrier bar; bar.bar = (unsigned*)(ctl + CW_BAR); bar.x = 0; bar.st = nullptr;
    if (N_LAUNCHES == 1) bar = xcd_barrier_post((unsigned*)(ctl + CW_BAR), MISC + 8);
#define GRID_BAR() do { if (N_LAUNCHES == 1) xcd_barrier(bar); } while (0)
    const int lo = args.ph_lo, hi = args.ph_hi;
#ifndef PHASE_MASK
#define PHASE_MASK 0x7fff
#endif
#define IN(k) ((((PHASE_MASK) >> (k)) & 1) && lo <= (k) && (k) < hi)
#ifndef TPROBE_K
#define TPROBE_K -1
#endif
    unsigned long long tp0 = 0ull;
#define TP_BEGIN(k) do { if ((k) == TPROBE_K && bx == 0 && tid == 0) tp0 = __builtin_amdgcn_s_memrealtime(); } while (0)
#define SEAM(k) do { if (IN(k) && IN((k) + 1)) GRID_BAR(); if ((k) == TPROBE_K && bx == 0 && tid == 0) __hip_atomic_store(ctl + 2, (unsigned)(__builtin_amdgcn_s_memrealtime() - tp0), RLX_AGENT); } while (0)
#ifndef REP_MASK
#define REP_MASK 0
#endif
#define PHASE(k, ...) do { if (IN(k)) { __VA_ARGS__ if (((REP_MASK) >> (k)) & 1) { GRID_BAR(); __VA_ARGS__ } } } while (0)

    TP_BEGIN(0);
    PHASE(0, p0_prologue(P, lds, vcu, G, tid, lane, wave); __syncthreads(); );
    SEAM(0);
    TP_BEGIN(1);
    PHASE(1, p1_ln_mod(P, lds, gw, NGW, lane, wave); __syncthreads(); );
    SEAM(1);
    TP_BEGIN(2);
    PHASE(2,
        pg8::DenseProb Q; Q.init(P.u, D, P.win, T, N1, D, G, bx);
        pg8::EpiProj E{P.act, P.dqk, P.pos, P.gates};
        pg8::gemm_phase<pg8::EpiProj, pg8::DenseProb, true, true>(lds + RING_OFF, Q, E);
    );
    SEAM(2);
    TP_BEGIN(3);
    PHASE(3, for (int u = vcu; u < 256; u += G) { const int b = u >> 5, h = (u >> 3) & 3, sc = u & 7; if (sc < 7) gla::gla_unit<false>(lds + RING_OFF, P, b, h, sc); } );
    SEAM(3);
    TP_BEGIN(4);
    PHASE(4, gla::gla_scan(P, vcu * (NWAVES * 64) + tid, G * NWAVES * 64); );
    SEAM(4);
    TP_BEGIN(5);
    PHASE(5, for (int u = vcu; u < 256; u += G) { const int b = u >> 5, h = (u >> 3) & 3, sc = u & 7; gla::gla_unit<true>(lds + RING_OFF, P, b, h, sc); } );
    SEAM(5);
    TP_BEGIN(6);
    PHASE(6,
        const attn_body::AttnTensors AT{(const attn_body::bf16*)P.dqk, (const attn_body::bf16*)P.act, (attn_body::bf16*)P.act};
        const attn_body::StaticOrder S(G, vcu);
        const float lam = expf(wave_sum(P.lq1[lane] * P.lk1[lane])) - expf(wave_sum(P.lq2[lane] * P.lk2[lane])) + LAM_INIT;
        LAS float* nws = (LAS float*)(lds + LDSCTL_OFF + 512);
        if (tid < 128) nws[tid] = P.dnw[tid] * (1.f - LAM_INIT);
        __syncthreads();
        attn_body::attn_phase<attn_body::StaticOrder>((char*)lds_raw + RING_OFF, AT, S, AC_DV, AC_ODIFF, AC_OGLA, P.gates, lam, (const float*)((char*)lds_raw + LDSCTL_OFF + 512));
    );
    SEAM(6);
    TP_BEGIN(9);
    PHASE(9,
        pg8::DenseProb Q; Q.init(P.act + AC_OGLA, ACT_LD, P.wout, T, D, D, G, bx);
        pg8::EpiY E{P.act};
        pg8::gemm_phase<pg8::EpiY, pg8::DenseProb, true, true>(lds + RING_OFF, Q, E);
    );
    SEAM(9);
    TP_BEGIN(10);
    PHASE(10, p10_ln_router(P, lds, vcu, G, tid, lane, wave); __syncthreads(); );
    SEAM(10);
    TP_BEGIN(11);
    PHASE(11, transpose_items(P, lds, gw, NGW, lane, wave, TI_DENSE, TI_ALL); __syncthreads();
              p11_dispatch(P, lds, vcu, G, tid, lane); __syncthreads(); );
    SEAM(11);
    TP_BEGIN(12);
    PHASE(12,
        LAS int* rows = (LAS int*)(lds + ROWS_OFF); LAS int* ltab = (LAS int*)(lds + TAB_OFF);
        for (int i = tid; i < 1 + 2 * pg8::TILE_MAX; i += NWAVES * 64) ltab[i] = P.tab[i];
        __syncthreads();
        pg8::MoeProb<true> Q; Q.A = (const char*)P.u; Q.Bt = (const char*)P.wgu; Q.lda = D; Q.K = D; Q.G = G; Q.c = vcu; Q.tab = ltab; Q.rows = rows; Q.bstride = (size_t)1024 * D * 2;
        {
            int nun = 0; { pg8::Unit un; while (nun < 8 && Q.next(nun, un)) ++nun; }
            for (int idx = tid; idx < nun * 256; idx += NWAVES * 64) { const int i = idx >> 8; const int t = (i * G + vcu) >> 2; const int rt = P.rowtok[ltab[1 + pg8::TILE_MAX + t] + (idx & 255)]; rows[idx] = rt < 0 ? 0 : (rt >> 1); } }
        __syncthreads();
        pg8::EpiUp E{P.hbuf};
        pg8::gemm_phase<pg8::EpiUp, pg8::MoeProb<true>, true>(lds + RING_OFF, Q, E);
    );
    SEAM(12);
    TP_BEGIN(13);
    PHASE(13,
        LAS int* ltab = (LAS int*)(lds + TAB_OFF);
        for (int i = tid; i < 1 + 2 * pg8::TILE_MAX; i += NWAVES * 64) ltab[i] = P.tab[i];
        __syncthreads();
        pg8::MoeProb<false> Q; Q.A = (const char*)P.hbuf; Q.Bt = (const char*)P.wd; Q.lda = FF; Q.K = FF; Q.G = G; Q.c = vcu; Q.tab = ltab; Q.rows = nullptr; Q.bstride = (size_t)D * FF * 2;
        pg8::EpiDown E{P.mout, P.rowtok, P.roww};
        pg8::gemm_phase<pg8::EpiDown, pg8::MoeProb<false>, true>(lds + RING_OFF, Q, E);
    );
    SEAM(13);
    TP_BEGIN(14);
    PHASE(14, p14_final(P, gw, NGW, lane, (TPROBE_K >= 0 || GPROBE_K >= 0 || P0PROBE || RPROBE_K >= 0) ? 1.f + (float)__hip_atomic_load(ctl + 2, RLX_AGENT) * 1e-6f : 1.f); );
#undef IN
#undef SEAM
#undef GRID_BAR
}

extern "C" void kernel_launch(void* const* d_in, const int* in_sizes, int n_in, void* d_out, int out_size, void* d_ws, size_t ws_size, hipStream_t stream) {
    static int grid = 0;
    if (grid == 0) {
        if (n_in != 26 || in_sizes[0] != T * D || out_size != T * D || ws_size < WS_END) { fprintf(stderr, "kernel_launch: unexpected shapes (n_in %d, in0 %d, out %d, ws %zu < %zu); nothing launched\n", n_in, n_in > 0 ? in_sizes[0] : -1, out_size, ws_size, (size_t)WS_END); grid = -1; return; }
        int dev = 0, cus = 0, per_cu = 0;
        if (hipGetDevice(&dev) != hipSuccess || hipDeviceGetAttribute(&cus, hipDeviceAttributeMultiprocessorCount, dev) != hipSuccess) { fprintf(stderr, "kernel_launch: device query failed\n"); grid = -1; return; }
        if (hipFuncSetAttribute((const void*)fwd_kernel, hipFuncAttributeMaxDynamicSharedMemorySize, LDS_BYTES) != hipSuccess) { fprintf(stderr, "kernel_launch: hipFuncSetAttribute failed\n"); grid = -1; return; }
        if (hipOccupancyMaxActiveBlocksPerMultiprocessor(&per_cu, (const void*)fwd_kernel, NWAVES * 64, LDS_BYTES) != hipSuccess || per_cu < 1)
            fprintf(stderr, "kernel_launch: note: occupancy query reports %d workgroups per CU\n", per_cu);
        (void)hipGetLastError();
        grid = cus;
    }
    if (grid < 0) return;
    if (hipMemsetAsync((char*)d_ws + WS_CTL, 0, CTL_ZERO_BYTES, stream) != hipSuccess) { fprintf(stderr, "kernel_launch: hipMemsetAsync failed\n"); return; }
    Args a{};
    for (int i = 0; i < 26; ++i) a.in[i] = d_in[i];
    a.out = (float*)d_out; a.ws = (unsigned char*)d_ws;
    for (int li = 0; li < N_LAUNCHES; ++li) {
        a.ph_lo = (N_LAUNCHES == 1) ? 0 : li; a.ph_hi = (N_LAUNCHES == 1) ? NPH : li + 1;
        hipLaunchKernelGGL(fwd_kernel, dim3(grid), dim3(NWAVES * 64), LDS_BYTES, stream, a);
        const hipError_t le = hipPeekAtLastError();
        if (le != hipSuccess) { fprintf(stderr, "kernel_launch: launch %d failed: %s\n", li, hipGetErrorName(le)); break; }
    }
}
```

```cpp
#include <hip/hip_runtime.h>
#include <hip/hip_bf16.h>
#include <cstdio>
#include <cstdint>
#include <cmath>

#ifndef MK_N_LAUNCHES
#define MK_N_LAUNCHES 1
#endif

namespace pg8 {
#define PG8_LAS __attribute__((address_space(3)))
typedef unsigned short bf16_t;
typedef short bf16x8 __attribute__((ext_vector_type(8)));
typedef float f32x4 __attribute__((ext_vector_type(4)));
typedef float f32x2 __attribute__((ext_vector_type(2)));
typedef unsigned u32x4 __attribute__((ext_vector_type(4)));
typedef unsigned u32x2 __attribute__((ext_vector_type(2)));
constexpr int BM = 256, BK = 64, HALF = 128, HTB = HALF * BK * 2  , STAGE_BYTES = 8 * HTB, NXCD = 8, WGM = 8;

__host__ __device__ __forceinline__ int lds_byte(int r, int c) { const int st = (r >> 4) * 2 + (c >> 5), rr = r & 15, cc = c & 31, ob = rr * 64 + cc * 2; return st * 1024 + (ob ^ (((ob >> 9) & 1) << 5)); }
__host__ __device__ __forceinline__ void stage_rc(int b, int& R, int& C) { const int st = b / 1024, sb = b % 1024, swz = sb ^ (((sb >> 9) & 1) << 5); R = (st >> 1) * 16 + swz / 64; C = (st & 1) * 32 + (swz % 64) / 2; }
__host__ __device__ __forceinline__ int perm32(int rho) { const int n = rho >> 4, i = rho & 15; return 8 * (i >> 2) + 4 * n + (i & 3); }

struct Unit { int pm, pn, e, row0; };

struct DenseProb {
    const char* A; const char* Bt; int lda, K; int nM, nN, nwg, G, c;
    __device__ __forceinline__ void init(const void* A_, int lda_, const void* Bt_, int M, int N, int K_, int G_, int c_) { A = (const char*)A_; Bt = (const char*)Bt_; lda = lda_; K = K_; nM = M / BM; nN = N / BM; nwg = nM * nN; G = G_; c = c_; }
    __device__ __forceinline__ bool next(int i, Unit& u) const {
        const long L = (long)i * G + c; if (L >= nwg) return false;
        int wgid = (int)L; { const int q = nwg / NXCD, r = nwg % NXCD, xcd = wgid % NXCD, off = wgid / NXCD; wgid = (xcd < r ? xcd * (q + 1) : r * (q + 1) + (xcd - r) * q) + off; }
        const int nig = WGM * nN, gid = wgid / nig, fm = gid * WGM, gsz = (nM - fm) < WGM ? (nM - fm) : WGM;
        u.pm = fm + ((wgid % nig) % gsz); u.pn = (wgid % nig) / gsz; u.e = 0; u.row0 = u.pm * BM; return true;
    }
    __device__ __forceinline__ void a_voff(const Unit& u, const int (&R)[2], const int (&C)[2], unsigned (&v)[4]) const {
#pragma unroll
        for (int h = 0; h < 2; ++h)
#pragma unroll
            for (int i = 0; i < 2; ++i) v[h * 2 + i] = (unsigned)((u.row0 + h * HALF + R[i]) * lda + C[i]) * 2u;
    }
    __device__ __forceinline__ size_t b_off(const Unit& u) const { return (size_t)u.pn * BM * K * 2; }
};

__device__ __forceinline__ unsigned cvt_pk_bf16(float lo, float hi) { typedef __bf16 bf16x2_t __attribute__((ext_vector_type(2))); f32x2 v = {lo, hi}; bf16x2_t b = __builtin_convertvector(v, bf16x2_t); return __builtin_bit_cast(unsigned, b); }
__device__ __forceinline__ float bf_lo(unsigned w) { return __uint_as_float(w << 16); }
__device__ __forceinline__ float bf_hi(unsigned w) { return __uint_as_float(w & 0xffff0000u); }
__device__ __forceinline__ float sigmoidf_(float x) { return __builtin_amdgcn_rcpf(1.f + __builtin_amdgcn_exp2f(x * -1.4426950408889634f)); }

__device__ __forceinline__ unsigned xr8(unsigned v) { return (unsigned)__builtin_amdgcn_update_dpp(0, (int)v, 0x128, 0xf, 0xf, false); }
__device__ __forceinline__ void store_pair16(bf16_t* pA, size_t row8, const u32x4 c0, const u32x4 c1, bool lo) {
    u32x4 dA, dB;
#pragma unroll
    for (int e = 0; e < 4; ++e) { const unsigned rcv = xr8(lo ? c1[e] : c0[e]); dA[e] = lo ? c0[e] : rcv; dB[e] = lo ? rcv : c1[e]; }
    *(u32x4*)pA = dA; *(u32x4*)(pA + row8) = dB;
}

template <class Epi, class Prob, bool ALIGN_EPI, bool C64 = false>
__device__ __forceinline__ void gemm_phase(PG8_LAS unsigned char* lds, const Prob& P, const Epi& E) {
    const int tid = threadIdx.x, wid = __builtin_amdgcn_readfirstlane(tid >> 6), lane = tid & 63, wr = wid >> 2, wc = wid & 3, fr = lane & 15, fq = lane >> 4;
    const int K = P.K, nt = K / BK;
    int sR[2], sC[2]; unsigned voffB[2];
#pragma unroll
    for (int i = 0; i < 2; ++i) { int R, C; stage_rc(tid * 16 + i * 8192, R, C); const int Rb = C64 ? (R >> 5) * 64 + perm32(R & 31) : (R & ~31) + perm32(R & 31); sR[i] = R; sC[i] = C; voffB[i] = (unsigned)(Rb * K + C) * 2u; }
    const size_t kstep = (size_t)(BK * 2);
    const size_t hstepB = (size_t)(C64 ? 32 : HALF) * K * 2;
    const unsigned ldsw = (unsigned)wid * 1024u;
    const int aoff = lds_byte(wr * 64 + fr, fq * 8), boff = lds_byte(wc * 32 + fr, fq * 8);
#define PG8_SA(b, h) (((b) * 2 + (h)) * HTB)
#define PG8_SB(b, h) ((4 + (b) * 2 + (h)) * HTB)
#define PG8_STAGE(bufoff, gbase, voff) do { _Pragma("unroll") for (int _i = 0; _i < 2; ++_i) \
        __builtin_amdgcn_global_load_lds((const unsigned*)((const char*)(gbase) + (voff)[_i]), (PG8_LAS unsigned*)(lds + (bufoff) + ldsw + _i * 8192), 16, 0, 0); } while (0)
#define PG8_STAGE_A(bufoff, kofs, V, h) do { _Pragma("unroll") for (int _i = 0; _i < 2; ++_i) \
        __builtin_amdgcn_global_load_lds((const unsigned*)(P.A + (kofs) + (V)[(h) * 2 + _i]), (PG8_LAS unsigned*)(lds + (bufoff) + ldsw + _i * 8192), 16, 0, 0); } while (0)
#define PG8_LDA(dst, b, h) do { _Pragma("unroll") for (int m = 0; m < 4; ++m) _Pragma("unroll") for (int k = 0; k < 2; ++k) dst[m][k] = *(const PG8_LAS bf16x8*)(lds + PG8_SA(b, h) + aoff + m * 2048 + k * 1024); } while (0)
#define PG8_LDB(dst, b, h) do { _Pragma("unroll") for (int n = 0; n < 2; ++n) _Pragma("unroll") for (int k = 0; k < 2; ++k) dst[n][k] = *(const PG8_LAS bf16x8*)(lds + PG8_SB(b, h) + boff + n * 2048 + k * 1024); } while (0)
#define PG8_MMA(ai, bj, At, Bt) do { __builtin_amdgcn_s_setprio(1); _Pragma("unroll") for (int m = 0; m < 4; ++m) _Pragma("unroll") for (int n = 0; n < 2; ++n) _Pragma("unroll") for (int k = 0; k < 2; ++k) \
        acc[ai][bj][m][n] = __builtin_amdgcn_mfma_f32_16x16x32_bf16(Bt[n][k], At[m][k], acc[ai][bj][m][n], 0, 0, 0); __builtin_amdgcn_s_setprio(0); } while (0)
#define PG8_WAIT_V(n) asm volatile("s_waitcnt vmcnt(" #n ")" ::: "memory")
#define PG8_WAIT_L(n) asm volatile("s_waitcnt lgkmcnt(" #n ")" ::: "memory")
#define PG8_BAR __builtin_amdgcn_s_barrier()
#define PG8_SCHED __builtin_amdgcn_sched_barrier(0)
    Unit cur, nxt; int ui = 0;
    if (!P.next(0, cur)) return;
    f32x4 acc[2][2][4][2];
#pragma unroll
    for (int a = 0; a < 2; ++a)
#pragma unroll
        for (int b = 0; b < 2; ++b)
#pragma unroll
            for (int m = 0; m < 4; ++m)
#pragma unroll
                for (int n = 0; n < 2; ++n) acc[a][b][m][n] = (f32x4){0.f, 0.f, 0.f, 0.f};
    bf16x8 At[4][2], B0[2][2], B1[2][2];
    unsigned vc[4], vn[4];
    P.a_voff(cur, sR, sC, vc);
    const char* cB = P.Bt + P.b_off(cur);
    PG8_STAGE(PG8_SB(0, 0), cB, voffB); PG8_STAGE(PG8_SB(0, 1), cB + hstepB, voffB); PG8_STAGE_A(PG8_SA(0, 0), 0, vc, 0); PG8_STAGE_A(PG8_SA(0, 1), 0, vc, 1);
    if (wr == 1) PG8_BAR;
    PG8_WAIT_V(2); PG8_BAR;
    PG8_STAGE(PG8_SB(1, 0), cB + kstep, voffB); PG8_STAGE_A(PG8_SA(1, 0), kstep, vc, 0); PG8_STAGE(PG8_SB(1, 1), cB + hstepB + kstep, voffB);
    PG8_WAIT_V(6); PG8_BAR;
    for (;;) {
        const bool has_next = P.next(ui + 1, nxt);
        const char* nB = cB;
        if (has_next) { P.a_voff(nxt, sR, sC, vn); nB = P.Bt + P.b_off(nxt); }
        else {
#pragma unroll
            for (int q = 0; q < 4; ++q) vn[q] = vc[q];
        }
        for (int t = 0; t < nt; t += 2) {
            const bool last = (t == nt - 2);
            const size_t ka1 = (size_t)(t + 1) * kstep;
            const size_t ka2 = last ? (size_t)0 : (size_t)(t + 2) * kstep, ka3 = ka2 + kstep;
            const char* b2 = last ? nB : cB + (size_t)(t + 2) * kstep; const char* b3 = b2 + kstep;
            unsigned v2[4];
#pragma unroll
            for (int q = 0; q < 4; ++q) v2[q] = last ? vn[q] : vc[q];
            PG8_LDB(B0, 0, 0); PG8_LDB(B1, 0, 1); PG8_SCHED; PG8_LDA(At, 0, 0); PG8_STAGE_A(PG8_SA(1, 1), ka1, vc, 1);
            PG8_WAIT_V(8); PG8_WAIT_L(0); PG8_BAR; PG8_MMA(0, 0, At, B0); PG8_MMA(0, 1, At, B1); PG8_BAR; PG8_SCHED;
            PG8_LDA(At, 0, 1); PG8_STAGE(PG8_SB(0, 0), b2, voffB); PG8_STAGE(PG8_SB(0, 1), b2 + hstepB, voffB); PG8_STAGE_A(PG8_SA(0, 0), ka2, v2, 0);
            PG8_WAIT_V(8); PG8_WAIT_L(0); PG8_BAR; PG8_MMA(1, 0, At, B0); PG8_MMA(1, 1, At, B1); PG8_BAR; PG8_SCHED;
            PG8_LDB(B0, 1, 0); PG8_LDB(B1, 1, 1); PG8_SCHED; PG8_LDA(At, 1, 0); PG8_STAGE_A(PG8_SA(0, 1), ka2, v2, 1);
            PG8_WAIT_V(8); PG8_WAIT_L(0); PG8_BAR; PG8_MMA(0, 0, At, B0); PG8_MMA(0, 1, At, B1); PG8_BAR; PG8_SCHED;
            PG8_LDA(At, 1, 1); PG8_STAGE(PG8_SB(1, 0), b3, voffB); PG8_STAGE(PG8_SB(1, 1), b3 + hstepB, voffB); PG8_STAGE_A(PG8_SA(1, 0), ka3, v2, 0);
            PG8_WAIT_V(8); PG8_WAIT_L(0); PG8_BAR; PG8_MMA(1, 0, At, B0); PG8_MMA(1, 1, At, B1); PG8_BAR; PG8_SCHED;
        }
        if constexpr (ALIGN_EPI) { if (wr == 0) PG8_BAR; }
        E(acc, cur, wr, wc, fr, fq);
        if (!has_next) break;
#pragma unroll
        for (int a = 0; a < 2; ++a)
#pragma unroll
            for (int b = 0; b < 2; ++b)
#pragma unroll
                for (int m = 0; m < 4; ++m)
#pragma unroll
                    for (int n = 0; n < 2; ++n) acc[a][b][m][n] = (f32x4){0.f, 0.f, 0.f, 0.f};
        cur = nxt; cB = nB; ++ui;
#pragma unroll
        for (int q = 0; q < 4; ++q) vc[q] = vn[q];
        if constexpr (ALIGN_EPI) { if (wr == 1) PG8_BAR; }
    }
    PG8_WAIT_V(0);
    if constexpr (!ALIGN_EPI) { if (wr == 0) PG8_BAR; }
    PG8_BAR;
#undef PG8_SA
#undef PG8_SB
#undef PG8_STAGE
#undef PG8_STAGE_A
#undef PG8_LDA
#undef PG8_LDB
#undef PG8_MMA
#undef PG8_WAIT_V
#undef PG8_WAIT_L
#undef PG8_BAR
#undef PG8_SCHED
}
}
constexpr int BATCH = 8, SEQ = 4096, D = 1024, T = BATCH * SEQ;
constexpr int IN_COLS = 8208;
constexpr int NEXP = 32, FF = 512;
constexpr float LN_EPS = 1e-5f, RMS_EPS = 1e-6f, ALPHA = 1.189207115002721f, LAM_INIT = 0.2f;
constexpr float ATT_C2 = 0.125f * 1.4426950408889634f;
constexpr int ACT_LD = 4352, AC_GQ = 0, AC_GK = 512, AC_GV = 1024, AC_GO = 2048, AC_DV = 3072, AC_GR = 4096;
constexpr int AC_O1 = 0, AC_O2 = 2048, AC_OGLA = 1024, AC_ODIFF = 0, AC_MERGED = 3072, AC_Y = 2048;
constexpr int DQK_LD = 2048;
constexpr int N1 = 32 * 256;

namespace pg8 {
struct EpiProj {
    bf16_t* act1; bf16_t* dqk; const int* pos; unsigned char* gates;
    __device__ __forceinline__ static unsigned q8(const f32x4 v) {
        const unsigned b0 = (unsigned)__builtin_rintf(sigmoidf_(v[0]) * 255.f), b1 = (unsigned)__builtin_rintf(sigmoidf_(v[1]) * 255.f), b2 = (unsigned)__builtin_rintf(sigmoidf_(v[2]) * 255.f), b3 = (unsigned)__builtin_rintf(sigmoidf_(v[3]) * 255.f);
        return b0 | (b1 << 8) | (b2 << 16) | (b3 << 24); }
    __device__ __forceinline__ void operator()(const f32x4 (&acc)[2][2][4][2], const Unit& u, int wr, int wc, int fr, int fq) const {
        const int pn = u.pn, row0 = u.row0 + wr * 64 + fr, rA = u.row0 + wr * 64 + (fr & 7), colx = wc * 64 + (fr >> 3) * 32 + 8 * fq; const bool lo = fr < 8;
        if (pn >= 24) {
            unsigned char* gbase = gates + (wc >= 2 ? 1024 : 0) + (pn - 24) * 128 + (wc & 1) * 64 + (fr >> 3) * 32 + 8 * fq;
#pragma unroll
            for (int ai = 0; ai < 2; ++ai)
#pragma unroll
                for (int m = 0; m < 4; ++m) { unsigned char* gp = gbase + (size_t)(rA + ai * HALF + m * 16) * 2048;
                    const u32x2 c0 = (u32x2){q8(acc[ai][0][m][0]), q8(acc[ai][0][m][1])}, c1 = (u32x2){q8(acc[ai][1][m][0]), q8(acc[ai][1][m][1])}; u32x2 dA, dB;
#pragma unroll
                    for (int e = 0; e < 2; ++e) { const unsigned rcv = xr8(lo ? c1[e] : c0[e]); dA[e] = lo ? c0[e] : rcv; dB[e] = lo ? rcv : c1[e]; }
                    *(u32x2*)gp = dA; *(u32x2*)(gp + 8 * 2048) = dB; }
        } else if (pn < 12 || pn >= 20) {
            const int coltile = pn < 12 ? pn * 256 : AC_DV + (pn - 20) * 256;
#pragma unroll
            for (int ai = 0; ai < 2; ++ai)
#pragma unroll
                for (int m = 0; m < 4; ++m) { u32x4 c[2];
#pragma unroll
                    for (int bj = 0; bj < 2; ++bj) { const f32x4 v0 = acc[ai][bj][m][0], v1 = acc[ai][bj][m][1];
                        c[bj].x = cvt_pk_bf16(v0[0], v0[1]); c[bj].y = cvt_pk_bf16(v0[2], v0[3]); c[bj].z = cvt_pk_bf16(v1[0], v1[1]); c[bj].w = cvt_pk_bf16(v1[2], v1[3]); }
                    store_pair16(act1 + (size_t)(rA + ai * HALF + m * 16) * ACT_LD + coltile + colx, (size_t)8 * ACT_LD, c[0], c[1], lo); }
        } else {
            const bool isq = pn < 16; const int coltile = isq ? (pn - 12) * 256 : 1024 + (pn - 16) * 256; const float sc = isq ? ATT_C2 : 1.f;
            float inv[2][4];
#pragma unroll
            for (int bj = 0; bj < 2; ++bj)
#pragma unroll
                for (int i = 0; i < 4; ++i) inv[bj][i] = exp2f(-(float)(4 * (4 * bj + fq) + i) * (13.287712379549449f / 32.f));
            int pp[2][4];
#pragma unroll
            for (int ai = 0; ai < 2; ++ai)
#pragma unroll
                for (int m = 0; m < 4; ++m) pp[ai][m] = pos[row0 + ai * HALF + m * 16];
#pragma unroll
            for (int ai = 0; ai < 2; ++ai)
#pragma unroll
                for (int m = 0; m < 4; ++m) { const float p = (float)pp[ai][m]; u32x4 c[2];
#pragma unroll
                    for (int bj = 0; bj < 2; ++bj) { const f32x4 v0 = acc[ai][bj][m][0], v1 = acc[ai][bj][m][1]; float o1[4], o2[4];
#pragma unroll
                        for (int i = 0; i < 4; ++i) { const float ang = p * inv[bj][i]; float rev = ang * 0.15915494309189535f; rev = rev - floorf(rev); const float sn = __builtin_amdgcn_sinf(rev), cs = __builtin_amdgcn_cosf(rev);
                            o1[i] = (v0[i] * cs - v1[i] * sn) * sc; o2[i] = (v1[i] * cs + v0[i] * sn) * sc; }
                        c[bj].x = cvt_pk_bf16(o1[0], o1[1]); c[bj].y = cvt_pk_bf16(o1[2], o1[3]); c[bj].z = cvt_pk_bf16(o2[0], o2[1]); c[bj].w = cvt_pk_bf16(o2[2], o2[3]); }
                    store_pair16(dqk + (size_t)(rA + ai * HALF + m * 16) * DQK_LD + coltile + colx, (size_t)8 * DQK_LD, c[0], c[1], lo); }
        }
    }
};
struct EpiMerge {
    bf16_t* act1;
    __device__ __forceinline__ void operator()(const f32x4 (&acc)[2][2][4][2], const Unit& u, int wr, int wc, int fr, int fq) const {
        const int row0 = u.row0 + wr * 64 + fr, j0 = u.pn * 128 + wc * 32 + 8 * fq;
#pragma unroll
        for (int ai = 0; ai < 2; ++ai) { u32x4 ogs[4], ods[4];
#pragma unroll
            for (int m = 0; m < 4; ++m) { const bf16_t* rowp = act1 + (size_t)(row0 + ai * HALF + m * 16) * ACT_LD; ogs[m] = *(const u32x4*)(rowp + AC_OGLA + j0); ods[m] = *(const u32x4*)(rowp + AC_ODIFF + j0); }
#pragma unroll
            for (int m = 0; m < 4; ++m) { bf16_t* rowp = act1 + (size_t)(row0 + ai * HALF + m * 16) * ACT_LD; u32x4 w;
#pragma unroll
                for (int n = 0; n < 2; ++n) { const f32x4 va = acc[ai][0][m][n], vb = acc[ai][1][m][n]; const unsigned g0 = ogs[m][2 * n], g1 = ogs[m][2 * n + 1], d0 = ods[m][2 * n], d1 = ods[m][2 * n + 1];
                    w[2 * n] = cvt_pk_bf16(sigmoidf_(va[0]) * bf_lo(g0) + sigmoidf_(vb[0]) * bf_lo(d0), sigmoidf_(va[1]) * bf_hi(g0) + sigmoidf_(vb[1]) * bf_hi(d0));
                    w[2 * n + 1] = cvt_pk_bf16(sigmoidf_(va[2]) * bf_lo(g1) + sigmoidf_(vb[2]) * bf_lo(d1), sigmoidf_(va[3]) * bf_hi(g1) + sigmoidf_(vb[3]) * bf_hi(d1)); }
                *(u32x4*)(rowp + AC_MERGED + j0) = w; } }
    }
};
struct EpiY {
    bf16_t* act1;
    __device__ __forceinline__ void operator()(const f32x4 (&acc)[2][2][4][2], const Unit& u, int wr, int wc, int fr, int fq) const {
        const int rA = u.row0 + wr * 64 + (fr & 7), col = u.pn * BM + wc * 64 + (fr >> 3) * 32 + 8 * fq; const bool lo = fr < 8;
#pragma unroll
        for (int ai = 0; ai < 2; ++ai)
#pragma unroll
            for (int m = 0; m < 4; ++m) { u32x4 c[2];
#pragma unroll
                for (int bj = 0; bj < 2; ++bj) { const f32x4 v0 = acc[ai][bj][m][0], v1 = acc[ai][bj][m][1];
                    c[bj].x = cvt_pk_bf16(v0[0], v0[1]); c[bj].y = cvt_pk_bf16(v0[2], v0[3]); c[bj].z = cvt_pk_bf16(v1[0], v1[1]); c[bj].w = cvt_pk_bf16(v1[2], v1[3]); }
                store_pair16(act1 + (size_t)(rA + ai * HALF + m * 16) * ACT_LD + AC_Y + col, (size_t)8 * ACT_LD, c[0], c[1], lo); }
    }
};
struct EpiUp {
    bf16_t* hbuf;
    __device__ __forceinline__ void operator()(const f32x4 (&acc)[2][2][4][2], const Unit& u, int wr, int wc, int fr, int fq) const {
        const int row0 = u.row0 + wr * 64 + fr, j0 = u.pn * 128 + wc * 32 + 8 * fq;
#pragma unroll
        for (int ai = 0; ai < 2; ++ai)
#pragma unroll
            for (int m = 0; m < 4; ++m) { bf16_t* rowp = hbuf + (size_t)(row0 + ai * HALF + m * 16) * FF; u32x4 w;
#pragma unroll
                for (int n = 0; n < 2; ++n) { const f32x4 g = acc[ai][0][m][n], v = acc[ai][1][m][n];
                    w[2 * n] = cvt_pk_bf16(g[0] * sigmoidf_(g[0]) * v[0], g[1] * sigmoidf_(g[1]) * v[1]); w[2 * n + 1] = cvt_pk_bf16(g[2] * sigmoidf_(g[2]) * v[2], g[3] * sigmoidf_(g[3]) * v[3]); }
                *(u32x4*)(rowp + j0) = w; }
    }
};
struct EpiDown {
    bf16_t* mout; const int* rowtok; const float* roww;
    __device__ __forceinline__ void operator()(const f32x4 (&acc)[2][2][4][2], const Unit& u, int wr, int wc, int fr, int fq) const {
        const int row0 = u.row0 + wr * 64 + fr, col = u.pn * BM + wc * 64 + (fr >> 3) * 32 + 8 * fq; const bool lo = fr < 8;
        int rts[2][4]; float ws[2][4];
#pragma unroll
        for (int ai = 0; ai < 2; ++ai)
#pragma unroll
            for (int m = 0; m < 4; ++m) { const int pr = row0 + ai * HALF + m * 16; rts[ai][m] = rowtok[pr]; ws[ai][m] = roww[pr]; }
#pragma unroll
        for (int ai = 0; ai < 2; ++ai)
#pragma unroll
            for (int m = 0; m < 4; ++m) { const int rt = rts[ai][m]; const float w = ws[ai][m]; u32x4 c[2];
#pragma unroll
                for (int bj = 0; bj < 2; ++bj) { const f32x4 v0 = acc[ai][bj][m][0] * w, v1 = acc[ai][bj][m][1] * w;
                    c[bj].x = cvt_pk_bf16(v0[0], v0[1]); c[bj].y = cvt_pk_bf16(v0[2], v0[3]); c[bj].z = cvt_pk_bf16(v1[0], v1[1]); c[bj].w = cvt_pk_bf16(v1[2], v1[3]); }
                const int rtp = (int)xr8((unsigned)rt), rtA = lo ? rt : rtp, rtB = lo ? rtp : rt;
                u32x4 dA, dB;
#pragma unroll
                for (int e = 0; e < 4; ++e) { const unsigned rcv = xr8(lo ? c[1][e] : c[0][e]); dA[e] = lo ? c[0][e] : rcv; dB[e] = lo ? rcv : c[1][e]; }
                if (rtA >= 0) *(u32x4*)(mout + (size_t)rtA * D + col) = dA;
                if (rtB >= 0) *(u32x4*)(mout + (size_t)rtB * D + col) = dB; }
    }
};
constexpr int TILE_MAX = 512;
template <bool GATHER> struct MoeProb {
    const char* A; const char* Bt; int lda, K; int G, c; PG8_LAS const int* tab; PG8_LAS const int* rows; size_t bstride;
    __device__ __forceinline__ bool next(int i, Unit& u) const {
        const int idx = i * G + c, ntile = tab[0]; if (idx >= ntile * 4) return false;
        const int t = idx >> 2; u.pn = idx & 3; u.e = tab[1 + t]; u.row0 = tab[1 + TILE_MAX + t]; u.pm = i; return true;
    }
    __device__ __forceinline__ void a_voff(const Unit& u, const int (&R)[2], const int (&C)[2], unsigned (&v)[4]) const {
#pragma unroll
        for (int h = 0; h < 2; ++h)
#pragma unroll
            for (int i = 0; i < 2; ++i) { const int row = GATHER ? rows[u.pm * 256 + h * HALF + R[i]] : (u.row0 + h * HALF + R[i]); v[h * 2 + i] = (unsigned)(row * lda + C[i]) * 2u; }
    }
    __device__ __forceinline__ size_t b_off(const Unit& u) const { return (size_t)u.e * bstride + (size_t)u.pn * BM * K * 2; }
};
}
#include <hip/hip_bf16.h>
#include <cmath>
namespace attn_body {
using bf16=__hip_bfloat16;
using bf16x8=__attribute__((ext_vector_type(8)))short;
using s16x4=__attribute__((ext_vector_type(4)))short;
using f32x16=__attribute__((ext_vector_type(16)))float;
using u32x4=__attribute__((ext_vector_type(4)))unsigned;
constexpr int SEQ=4096,D=64,PQ=2048,PK=2048,PV=4352,PO=4352;
constexpr int NW=8,QBLK=32,QB=QBLK*NW,KVBLK=64,NQB=SEQ/QB;
constexpr int ATTN_UNIT_ROWS=QB;
__device__ __forceinline__ int crow(int r,int hi){return (r&3)+8*(r>>2)+4*hi;}
#define SBAR() __builtin_amdgcn_sched_barrier(0)
__device__ __forceinline__ void cmask(f32x16&p0,f32x16&p1,int jb,int qrel,int hi){
  const float NEG=-INFINITY; int kb=64*jb+4*hi;
  #pragma unroll
  for(int r=0;r<16;++r){int kv=kb+(r&3)+8*(r>>2); if(kv>qrel)p0[r]=NEG; if(kv+32>qrel)p1[r]=NEG;}
}

constexpr int NSLOT=3, SLOTB=8192;
constexpr int LDS_K=0, LDS_V=NSLOT*SLOTB, LDS_WS=3*NSLOT*SLOTB, LDS_OST=LDS_WS+NW*64*4, LDS_BYTES=LDS_OST+NW*4096;
constexpr float C2=0.125f*1.4426950408889634f;
__device__ __forceinline__ void glds16(const void*gsrc,unsigned lds_dst){unsigned keep;
  asm volatile("s_mov_b32 %0, m0\n\ts_mov_b32 m0, %2\n\ts_nop 0\n\tglobal_load_lds_dwordx4 %1, off\n\ts_mov_b32 m0, %0":"=&s"(keep):"v"(gsrc),"s"(lds_dst):"memory");}
__device__ __forceinline__ float max3f(float a,float b,float c){float r;asm("v_max3_f32 %0, %1, %2, %3":"=v"(r):"v"(a),"v"(b),"v"(c));return r;}
__device__ __forceinline__ float max2f(float a,float b){float r;asm("v_max_f32_e32 %0, %1, %2":"=v"(r):"v"(a),"v"(b));return r;}
__device__ __forceinline__ float fadd_s(float a,float b){float r;asm("v_add_f32_e32 %0, %1, %2":"=v"(r):"v"(a),"v"(b));return r;}
__device__ __forceinline__ float fsub_s(float a,float b){float r;asm("v_sub_f32_e32 %0, %1, %2":"=v"(r):"v"(a),"v"(b));return r;}
typedef float f32x2_t __attribute__((ext_vector_type(2))); typedef __bf16 bf16x2_t __attribute__((ext_vector_type(2)));
__device__ __forceinline__ unsigned cvtpk_s(float lo,float hi){f32x2_t v={lo,hi};bf16x2_t b=__builtin_convertvector(v,bf16x2_t);return __builtin_bit_cast(unsigned,b);}
#define WAIT_BAR(N) asm volatile("s_waitcnt vmcnt(" #N ") lgkmcnt(0)\n\ts_barrier":::"memory")

__device__ __forceinline__ void qkt(f32x16&p0,f32x16&p1,const char*Kslot,const bf16x8*qr,int r32,int hi){ const f32x16 negm=f32x16{};
  const char*kb=Kslot+hi*1024+r32*16;
  #pragma unroll
  for(int d0=0;d0<4;++d0){
    const bf16x8 b0=*reinterpret_cast<const bf16x8*>(kb+d0*2048);
    const bf16x8 b1=*reinterpret_cast<const bf16x8*>(kb+d0*2048+512);
    if(d0==0){p0=__builtin_amdgcn_mfma_f32_32x32x16_bf16(b0,qr[0],negm,0,0,0);p1=__builtin_amdgcn_mfma_f32_32x32x16_bf16(b1,qr[0],negm,0,0,0);}
    else{p0=__builtin_amdgcn_mfma_f32_32x32x16_bf16(b0,qr[d0],p0,0,0,0);p1=__builtin_amdgcn_mfma_f32_32x32x16_bf16(b1,qr[d0],p1,0,0,0);}}
}
typedef __attribute__((address_space(3))) const char* lds_cptr;
typedef short v4i16_t __attribute__((ext_vector_type(4)));
__device__ __forceinline__ void kload8(bf16x8*kf,lds_cptr kp){
  kf[0]=*(const __attribute__((address_space(3))) bf16x8*)(kp);      kf[1]=*(const __attribute__((address_space(3))) bf16x8*)(kp+512);
  kf[2]=*(const __attribute__((address_space(3))) bf16x8*)(kp+2048); kf[3]=*(const __attribute__((address_space(3))) bf16x8*)(kp+2560);
  kf[4]=*(const __attribute__((address_space(3))) bf16x8*)(kp+4096); kf[5]=*(const __attribute__((address_space(3))) bf16x8*)(kp+4608);
  kf[6]=*(const __attribute__((address_space(3))) bf16x8*)(kp+6144); kf[7]=*(const __attribute__((address_space(3))) bf16x8*)(kp+6656);
}
__device__ __forceinline__ void kload2(bf16x8*kf,lds_cptr kp,int j){ kf[2*j]=*(const __attribute__((address_space(3))) bf16x8*)(kp+j*2048); kf[2*j+1]=*(const __attribute__((address_space(3))) bf16x8*)(kp+j*2048+512); }
__device__ __forceinline__ s16x4 vtr(lds_cptr p){ return __builtin_bit_cast(s16x4,__builtin_amdgcn_ds_read_tr16_b64_v4i16((__attribute__((address_space(3))) v4i16_t*)p)); }
__device__ __forceinline__ float rowmax(const f32x16&p0,const f32x16&p1){
  float a=max3f(p0[0],p0[1],p1[0]),b=max3f(p0[2],p0[3],p1[1]);a=max3f(a,p1[2],p1[3]);
  #pragma unroll
  for(int r=4;r<16;r+=4){a=max3f(a,p0[r],p0[r+1]);b=max3f(b,p0[r+2],p0[r+3]);a=max3f(a,p1[r],p1[r+1]);b=max3f(b,p1[r+2],p1[r+3]);}
  const float m=max2f(a,b);
  auto rr=__builtin_amdgcn_permlane32_swap(__float_as_uint(m),__float_as_uint(m),false,false);
  return max2f(__uint_as_float(rr[0]),__uint_as_float(rr[1]));
}
__device__ __forceinline__ void pv(f32x16*o,int vb,bf16x8 pa0,bf16x8 pa1,bf16x8 pa2,bf16x8 pa3){
  #pragma unroll
  for(int d0=0;d0<4;++d0){s16x4 lo[4],hi[4];
    #pragma unroll
    for(int ks=0;ks<4;++ks){
      asm volatile("ds_read_b64_tr_b16 %0,%1 offset:%c2":"=&v"(lo[ks]):"v"(vb),"i"(d0*4096+ks*1024):"memory");
      asm volatile("ds_read_b64_tr_b16 %0,%1 offset:%c2":"=&v"(hi[ks]):"v"(vb),"i"(d0*4096+ks*1024+512):"memory");}
    asm volatile("s_waitcnt lgkmcnt(0)":::"memory");SBAR();
    #define PK(k) (bf16x8){lo[k][0],lo[k][1],lo[k][2],lo[k][3],hi[k][0],hi[k][1],hi[k][2],hi[k][3]}
    o[d0]=__builtin_amdgcn_mfma_f32_32x32x16_bf16(pa0,PK(0),o[d0],0,0,0);
    o[d0]=__builtin_amdgcn_mfma_f32_32x32x16_bf16(pa1,PK(1),o[d0],0,0,0);
    o[d0]=__builtin_amdgcn_mfma_f32_32x32x16_bf16(pa2,PK(2),o[d0],0,0,0);
    o[d0]=__builtin_amdgcn_mfma_f32_32x32x16_bf16(pa3,PK(3),o[d0],0,0,0);
    #undef PK
  }
}

#ifndef ATTN_STORE16
#define ATTN_STORE16(p,v) (*(u32x4*)(p)=(v))
#endif
template<int THRL,int CM> __device__ __forceinline__ void attn_unit(int b,int qb,int qcol,int vcol,int ocol,int mcol,int gcol,const bf16*QK,const bf16*__restrict__ V,bf16*O,const unsigned char*gates,char*shm,float lam,const float*nwp){
  int tid_=threadIdx.x; asm volatile("":"+v"(tid_));
  const int tid=tid_,lane=tid&63,r32=lane&31,hi=lane>>5; const int wid=__builtin_amdgcn_readfirstlane(tid>>6);
  const long rowbase=(long)b*SEQ; const int q0=qb*QB;
  const bf16*Qw=QK+(rowbase+q0+wid*QBLK)*PQ+qcol;
  const bf16*Kh=QK+rowbase*PK+1024+qcol,*Vh=V+rowbase*PV+vcol;
  const unsigned lds0=(unsigned)(uintptr_t)shm;
  float*wsf=(float*)(shm+LDS_WS)+wid*64;
  const bf16*ksrc=Kh+(long)lane*PK+wid*8;
  const bf16*vsrc=Vh+(long)(16*(wid&3)+(lane>>2))*PV+(wid>>2)*32+(lane&3)*8;
  const unsigned kdst=lds0+LDS_K+wid*1024, vdst=lds0+LDS_V+wid*1024;
  #define DMA_K(t,slot) glds16(ksrc+(long)(t)*KVBLK*PK,(unsigned)__builtin_amdgcn_readfirstlane(kdst+(slot)))
  #define DMA_V(t,slot) do{ glds16(vsrc+(long)(t)*KVBLK*PV,(unsigned)__builtin_amdgcn_readfirstlane(vdst+2*(slot))); glds16(vsrc+(long)(t)*KVBLK*PV+64,(unsigned)__builtin_amdgcn_readfirstlane(vdst+2*(slot)+8192)); }while(0)
  const int vb0=(int)(lds0+LDS_V)+((lane>>4)&1)*32+(lane&3)*8+(4*hi+((lane&15)>>2))*64;
  const char*Kbase=shm+LDS_K; bf16x8 kf[8];
  const lds_cptr shm3=(lds_cptr)shm; const lds_cptr kp0=shm3+LDS_K+hi*1024+r32*16; const lds_cptr vp0=shm3+LDS_V+((lane>>4)&1)*32+(lane&3)*8+(4*hi+((lane&15)>>2))*64;
  const int NT=(q0+QB)/KVBLK;
  DMA_K(0,0);DMA_V(0,0);DMA_K(1,SLOTB);
  bf16x8 qr[4];
  #pragma unroll
  for(int d0=0;d0<4;++d0)qr[d0]=*reinterpret_cast<const bf16x8*>(&Qw[(long)r32*PQ+d0*16+hi*8]);
  float mhat=0.f,l_reg=0.f;f32x16 o[4];o[0]=f32x16{};o[1]=f32x16{};o[2]=f32x16{};o[3]=f32x16{};
  const int qrel=wid*QBLK+r32;
  #define CMASK(P0,P1,t) do{int jb_=(t)-(NT-4); if(jb_>=0)cmask(P0,P1,jb_,qrel,hi);}while(0)
  bool resc=false;
  #define START(P0,P1) do{ const float rm=rowmax(P0,P1); resc=false; mhat=rm; \
    _Pragma("unroll") for(int r=0;r<16;++r)P0[r]=__builtin_amdgcn_exp2f(fsub_s(P0[r],mhat)); }while(0)
  #define RESC() do{ if(resc){ asm volatile("s_waitcnt lgkmcnt(0)":::"memory"); \
      _Pragma("unroll") for(int d_=0;d_<4;++d_) _Pragma("unroll") for(int r=0;r<16;++r)o[d_][r]*=wsf[crow(r,hi)]; } }while(0)
  f32x16 pA0,pA1,pB0,pB1;
  int sl_prev=0,sl_cur=0,sl_next=SLOTB;
  #define ROT() do{sl_prev=sl_cur;sl_cur=sl_next;sl_next=(sl_next==(NSLOT-1)*SLOTB)?0:sl_next+SLOTB;}while(0)
  DMA_K(2,2*SLOTB);
  WAIT_BAR(3);
  qkt(pA0,pA1,Kbase,qr,r32,hi);asm volatile("s_nop 15\n\ts_nop 7":"+v"(pA0),"+v"(pA1));CMASK(pA0,pA1,0);
  START(pA0,pA1);
  _Pragma("unroll") for(int r=0;r<16;++r)pA1[r]=__builtin_amdgcn_exp2f(fsub_s(pA1[r],mhat));
  WAIT_BAR(0);
  DMA_K(3,0);DMA_V(1,SLOTB);
  ROT();
  kload8(kf,kp0+sl_cur);
  WAIT_BAR(3);
  s16x4 vlo[8],vhi[8]; u32x4 pw0,pw1,pw2,pw3; const f32x16 zc=f32x16{};
  #define PKW(P,B) cvtpk_s(P[B],P[B+1])
  #define PAF(k) __builtin_bit_cast(bf16x8,pw##k)
  #define VFR(i) (bf16x8){vlo[i][0],vlo[i][1],vlo[i][2],vlo[i][3],vhi[i][0],vhi[i][1],vhi[i][2],vhi[i][3]}
  #define PIN(x) asm volatile("":"+v"(x))
  #define MX3(a,b,c) __builtin_fmaxf(__builtin_fmaxf((a),(b)),(c))
  #define GAPA(MF,A0,A1,A2,A3,W0,W1,PW) do{ MF; sacc+=A0; sacc+=A1; sacc+=A2; sacc+=A3; PIN(sacc); W0; W1; PIN(PW); SBAR(); }while(0)
  #define EX(v) __builtin_amdgcn_exp2f((v)-mhat)
  #define GAPB(MF,X,B) do{ MF; X[B]=EX(X[B]); X[B+1]=EX(X[B+1]); PIN(X); SBAR(); }while(0)
  #define VRD(i) do{ vlo[(i)&7]=vtr(vp_+(((i)>>2)*4096+((i)&3)*1024)); vhi[(i)&7]=vtr(vp_+(((i)>>2)*4096+((i)&3)*1024+512)); SBAR(); }while(0)
  #define KRD(G,j) do{ if(G){ kload2(kf,kp0+sl_next,j); SBAR(); } }while(0)
  #define STEP(C0,C1,P0,P1,t,GK,GV,GL) do{ SBAR(); \
    const lds_cptr vp_=vp0+2*sl_prev; \
    VRD(0); float sacc=(P0[0]+P0[1]); \
    GAPA(C0=__builtin_amdgcn_mfma_f32_32x32x16_bf16(kf[0],qr[0],zc,0,0,0), P0[2],P0[3],P0[4],P0[5],     pw0[0]=PKW(P0,0), pw0[1]=PKW(P0,2), pw0); \
    VRD(4); GAPA(C1=__builtin_amdgcn_mfma_f32_32x32x16_bf16(kf[1],qr[0],zc,0,0,0), P0[6],P0[7],P0[8],P0[9],     pw0[2]=PKW(P0,4), pw0[3]=PKW(P0,6), pw0); \
    VRD(1); GAPA(C0=__builtin_amdgcn_mfma_f32_32x32x16_bf16(kf[2],qr[1],C0,0,0,0),   P0[10],P0[11],P0[12],P0[13], pw1[0]=PKW(P0,8), pw1[1]=PKW(P0,10), pw1); \
    VRD(5); GAPA(C1=__builtin_amdgcn_mfma_f32_32x32x16_bf16(kf[3],qr[1],C1,0,0,0),   P0[14],P0[15],P1[0],P1[1],   pw1[2]=PKW(P0,12),pw1[3]=PKW(P0,14), pw1); \
    VRD(2); GAPA(C0=__builtin_amdgcn_mfma_f32_32x32x16_bf16(kf[4],qr[2],C0,0,0,0),   P1[2],P1[3],P1[4],P1[5],     pw2[0]=PKW(P1,0), pw2[1]=PKW(P1,2), pw2); \
    VRD(6); GAPA(C1=__builtin_amdgcn_mfma_f32_32x32x16_bf16(kf[5],qr[2],C1,0,0,0),   P1[6],P1[7],P1[8],P1[9],     pw2[2]=PKW(P1,4), pw2[3]=PKW(P1,6), pw2); \
    VRD(3); GAPA(C0=__builtin_amdgcn_mfma_f32_32x32x16_bf16(kf[6],qr[3],C0,0,0,0),   P1[10],P1[11],P1[12],P1[13], pw3[0]=PKW(P1,8), pw3[1]=PKW(P1,10), pw3); \
    VRD(7); GAPA(C1=__builtin_amdgcn_mfma_f32_32x32x16_bf16(kf[7],qr[3],C1,0,0,0),   P1[14],P1[15],0.f,0.f,       pw3[2]=PKW(P1,12),pw3[3]=PKW(P1,14), pw3); \
    l_reg+=sacc; \
    if(GK){DMA_K((t)+3,sl_cur);} if(GV){DMA_V((t)+1,sl_next);} \
    CMASK(C0,C1,t); \
    { float a=MX3(C0[0],C0[1],C1[0]),b=MX3(C0[2],C0[3],C1[1]); a=MX3(a,C1[2],C1[3]); \
      _Pragma("unroll") for(int r=4;r<16;r+=4){a=MX3(a,C0[r],C0[r+1]);b=MX3(b,C0[r+2],C0[r+3]);a=MX3(a,C1[r],C1[r+1]);b=MX3(b,C1[r+2],C1[r+3]);} \
      float rm=__builtin_fmaxf(a,b); { auto rr=__builtin_amdgcn_permlane32_swap(__float_as_uint(rm),__float_as_uint(rm),false,false); rm=__builtin_fmaxf(__uint_as_float(rr[0]),__uint_as_float(rr[1])); } \
      resc=false; rm-=mhat; \
      if(__builtin_expect(__any(rm>(float)THRL),0)){ const float dl=__builtin_fmaxf(rm,0.f); mhat+=dl; \
        const float f=__builtin_amdgcn_exp2f(-dl); l_reg*=f; if(hi==0)wsf[r32]=f; resc=true; } } \
    SBAR(); \
    GAPB(o[0]=__builtin_amdgcn_mfma_f32_32x32x16_bf16(PAF(0),VFR(0),o[0],0,0,0), C0,0);  VRD(8); \
    GAPB(o[1]=__builtin_amdgcn_mfma_f32_32x32x16_bf16(PAF(0),VFR(4),o[1],0,0,0), C0,2);  VRD(12); \
    GAPB(o[0]=__builtin_amdgcn_mfma_f32_32x32x16_bf16(PAF(1),VFR(1),o[0],0,0,0), C0,4);  VRD(9); \
    GAPB(o[1]=__builtin_amdgcn_mfma_f32_32x32x16_bf16(PAF(1),VFR(5),o[1],0,0,0), C0,6);  VRD(13); \
    GAPB(o[0]=__builtin_amdgcn_mfma_f32_32x32x16_bf16(PAF(2),VFR(2),o[0],0,0,0), C0,8);  VRD(10); \
    GAPB(o[1]=__builtin_amdgcn_mfma_f32_32x32x16_bf16(PAF(2),VFR(6),o[1],0,0,0), C0,10); VRD(14); \
    GAPB(o[0]=__builtin_amdgcn_mfma_f32_32x32x16_bf16(PAF(3),VFR(3),o[0],0,0,0), C0,12); VRD(11); \
    GAPB(o[1]=__builtin_amdgcn_mfma_f32_32x32x16_bf16(PAF(3),VFR(7),o[1],0,0,0), C0,14); VRD(15); \
    GAPB(o[2]=__builtin_amdgcn_mfma_f32_32x32x16_bf16(PAF(0),VFR(0),o[2],0,0,0), C1,0); \
    GAPB(o[3]=__builtin_amdgcn_mfma_f32_32x32x16_bf16(PAF(0),VFR(4),o[3],0,0,0), C1,2); \
    KRD(GL,0); GAPB(o[2]=__builtin_amdgcn_mfma_f32_32x32x16_bf16(PAF(1),VFR(1),o[2],0,0,0), C1,4); \
    KRD(GL,1); GAPB(o[3]=__builtin_amdgcn_mfma_f32_32x32x16_bf16(PAF(1),VFR(5),o[3],0,0,0), C1,6); \
    KRD(GL,2); GAPB(o[2]=__builtin_amdgcn_mfma_f32_32x32x16_bf16(PAF(2),VFR(2),o[2],0,0,0), C1,8); \
    KRD(GL,3); GAPB(o[3]=__builtin_amdgcn_mfma_f32_32x32x16_bf16(PAF(2),VFR(6),o[3],0,0,0), C1,10); \
    GAPB(o[2]=__builtin_amdgcn_mfma_f32_32x32x16_bf16(PAF(3),VFR(3),o[2],0,0,0), C1,12); \
    GAPB(o[3]=__builtin_amdgcn_mfma_f32_32x32x16_bf16(PAF(3),VFR(7),o[3],0,0,0), C1,14); \
    }while(0)
  int t=1;
  #undef CMASK
  #define CMASK(P0,P1,t) do{}while(0)
  for(;t+5<NT;t+=2){
    STEP(pB0,pB1,pA0,pA1,t,true,true,true);     WAIT_BAR(3); RESC(); ROT();
    STEP(pA0,pA1,pB0,pB1,t+1,true,true,true);   WAIT_BAR(3); RESC(); ROT();
  }
  #undef CMASK
  #define CMASK(P0,P1,t) do{int jb_=(t)-(NT-4); if(jb_>=0)cmask(P0,P1,jb_,qrel,hi);}while(0)
  #define ENDW(tt) do{ if((tt)+3<NT){WAIT_BAR(3);} else if((tt)+2<NT){WAIT_BAR(2);} else {WAIT_BAR(0);} }while(0)
  for(;t+1<NT;t+=2){
    STEP(pB0,pB1,pA0,pA1,t,(t+3<NT),(t+1<NT),(t+1<NT));       ENDW(t);   RESC(); ROT();
    STEP(pA0,pA1,pB0,pB1,t+1,(t+4<NT),(t+2<NT),(t+2<NT));     ENDW(t+1); RESC(); ROT();
  }
  STEP(pB0,pB1,pA0,pA1,NT-1,false,false,false); RESC();
  { float sacc=pB0[0]+pB0[1]; _Pragma("unroll") for(int r=2;r<16;++r)sacc+=pB0[r]; _Pragma("unroll") for(int r=0;r<16;++r)sacc+=pB1[r]; l_reg+=sacc;
    pw0=(u32x4){PKW(pB0,0),PKW(pB0,2),PKW(pB0,4),PKW(pB0,6)};pw1=(u32x4){PKW(pB0,8),PKW(pB0,10),PKW(pB0,12),PKW(pB0,14)};pw2=(u32x4){PKW(pB1,0),PKW(pB1,2),PKW(pB1,4),PKW(pB1,6)};pw3=(u32x4){PKW(pB1,8),PKW(pB1,10),PKW(pB1,12),PKW(pB1,14)};
    SBAR(); pv(o,vb0+2*sl_cur,PAF(0),PAF(1),PAF(2),PAF(3)); }
  #undef PKW
  #undef PAF
  #undef VFR
  #undef PIN
  #undef MX3
  #undef GAPA
  #undef GAPB
  #undef EX
  #undef VRD
  #undef KRD
  #undef STEP
  #undef ENDW
  {auto rr=__builtin_amdgcn_permlane32_swap(__float_as_uint(l_reg),__float_as_uint(l_reg),false,false);l_reg=__uint_as_float(rr[0])+__uint_as_float(rr[1]);}
  if(hi==0)wsf[32+r32]=l_reg;asm volatile("s_waitcnt lgkmcnt(0)":::"memory");
  float rli[16];
  #pragma unroll
  for(int r=0;r<16;++r)rli[r]=__builtin_amdgcn_rcpf(wsf[32+crow(r,hi)]);
  bf16*Ow=O+(rowbase+q0+wid*QBLK)*PO+ocol;
  { bf16*stg=(bf16*)(shm+LDS_OST)+wid*2048;
    float vv[2][4][8];
    u32x4 w1s[2][4];
    if constexpr(CM==1){ const bf16*p0=Ow+(long)(lane>>3)*PO+(lane&7)*8;
      asm volatile("global_load_dwordx4 %0, %8, off sc0 sc1\n\tglobal_load_dwordx4 %1, %9, off sc0 sc1\n\tglobal_load_dwordx4 %2, %10, off sc0 sc1\n\tglobal_load_dwordx4 %3, %11, off sc0 sc1\n\t"
                   "global_load_dwordx4 %4, %12, off sc0 sc1\n\tglobal_load_dwordx4 %5, %13, off sc0 sc1\n\tglobal_load_dwordx4 %6, %14, off sc0 sc1\n\tglobal_load_dwordx4 %7, %15, off sc0 sc1\n\ts_waitcnt vmcnt(0)"
                   :"=&v"(w1s[0][0]),"=&v"(w1s[0][1]),"=&v"(w1s[0][2]),"=&v"(w1s[0][3]),"=&v"(w1s[1][0]),"=&v"(w1s[1][1]),"=&v"(w1s[1][2]),"=&v"(w1s[1][3])
                   :"v"(p0),"v"(p0+8L*PO),"v"(p0+16L*PO),"v"(p0+24L*PO),"v"(p0+64),"v"(p0+8L*PO+64),"v"(p0+16L*PO+64),"v"(p0+24L*PO+64):"memory"); }
    #pragma unroll
    for(int hf=0;hf<2;++hf){
      #pragma unroll
      for(int r=0;r<16;++r){const int orow=crow(r,hi);
        #pragma unroll
        for(int d0=0;d0<2;++d0)stg[orow*64+d0*32+r32]=__float2bfloat16(o[2*hf+d0][r]*rli[r]);}
      asm volatile("s_waitcnt lgkmcnt(0)":::"memory");
      #pragma unroll
      for(int i=0;i<4;++i){const int row=i*8+(lane>>3),ch=lane&7; const u32x4 v=*(const u32x4*)(stg+row*64+ch*8);
        if constexpr(CM==0){ ATTN_STORE16(Ow+(long)row*PO+hf*64+ch*8,v); }
        else { const u32x4 w1=w1s[hf][i];
          #pragma unroll
          for(int e=0;e<4;++e){ vv[hf][i][2*e]=__uint_as_float(w1[e]<<16)-lam*__uint_as_float(v[e]<<16); vv[hf][i][2*e+1]=__uint_as_float(w1[e]&0xffff0000u)-lam*__uint_as_float(v[e]&0xffff0000u); } } }
      asm volatile("s_waitcnt lgkmcnt(0)":::"memory"); }
    if constexpr(CM==1){
      bf16*Mw=O+(rowbase+q0+wid*QBLK)*PO+mcol; const unsigned char*Gw=gates+(rowbase+q0+wid*QBLK)*2048+gcol;
      u32x4 mg[2][4]; unsigned gbw[2][4][2];
      #pragma unroll
      for(int hf=0;hf<2;++hf)
        #pragma unroll
        for(int i=0;i<4;++i){ const int row=i*8+(lane>>3),ch=lane&7; mg[hf][i]=*(const u32x4*)(Mw+(long)row*PO+hf*64+ch*8);
          const unsigned long long g8=*(const unsigned long long*)(Gw+(long)row*2048+hf*64+ch*8); gbw[hf][i][0]=(unsigned)g8; gbw[hf][i][1]=(unsigned)(g8>>32); }
      float nw[2][8];
      #pragma unroll
      for(int hf=0;hf<2;++hf)
        #pragma unroll
        for(int e=0;e<8;++e)nw[hf][e]=nwp[hf*64+(lane&7)*8+e];
      #pragma unroll
      for(int i=0;i<4;++i){ float ss=0.f;
        #pragma unroll
        for(int hf=0;hf<2;++hf)
          #pragma unroll
          for(int e=0;e<8;++e)ss+=vv[hf][i][e]*vv[hf][i][e];
        ss+=__shfl_xor(ss,1); ss+=__shfl_xor(ss,2); ss+=__shfl_xor(ss,4);
        const float rstd=1.f/sqrtf(ss*(1.f/128.f)+1e-6f); const int row=i*8+(lane>>3),ch=lane&7;
        #pragma unroll
        for(int hf=0;hf<2;++hf){ u32x4 w;
          #pragma unroll
          for(int e=0;e<4;++e){ const unsigned gw_=gbw[hf][i][e>>1]; const float g0=(float)((gw_>>(16*(e&1)))&0xffu)*(1.f/255.f),g1=(float)((gw_>>(16*(e&1)+8))&0xffu)*(1.f/255.f);
            const unsigned m_=mg[hf][i][e];
            w[e]=cvtpk_s(__uint_as_float(m_<<16)+g0*(vv[hf][i][2*e]*rstd*nw[hf][2*e]),__uint_as_float(m_&0xffff0000u)+g1*(vv[hf][i][2*e+1]*rstd*nw[hf][2*e+1])); }
          ATTN_STORE16(Mw+(long)row*PO+hf*64+ch*8,w); } } } }
  asm volatile("s_waitcnt lgkmcnt(0)\n\ts_barrier":::"memory");
  #undef DMA_K
  #undef DMA_V
  #undef CMASK
  #undef START
  #undef RESC
  #undef ROT
}
constexpr int ATTN_LDS_BYTES=LDS_BYTES;
struct AttnTensors { const bf16* QK; const bf16* V; bf16* O; };
struct AttnUnit { int bh; int qb; };
struct StaticOrder {
  int vcu, G;
  __device__ __forceinline__ explicit StaticOrder(int grid,int vcu_):vcu(vcu_),G(grid){}
  __device__ __forceinline__ bool next(int i,AttnUnit&u)const{ const int L=i*G+vcu; if(L>=64*NQB)return false; const int v=L&255,j=L>>8,sx=v&3; u.bh=v>>2; u.qb=(j==0)?15-sx:(j==1)?8+sx:(j==2)?7-sx:sx; return true; }
};
template<class Sched,int THRL=8> __device__ __forceinline__ void attn_phase(char*lds,const AttnTensors&T,const Sched&S,int vcol,int ocol,int mcol,const unsigned char*gates,float lam,const float*nwp){
  AttnUnit u;
  for(int i=0;S.next(i,u);++i){
    const int b=u.bh>>3,h=u.bh&7;
    attn_unit<THRL,0>(b,u.qb,h*128,vcol+h*128,ocol+h*128,mcol+h*128,1024+h*128,T.QK,T.V,T.O,gates,lds,lam,nwp);
    attn_unit<THRL,1>(b,u.qb,h*128+64,vcol+h*128,ocol+h*128,mcol+h*128,1024+h*128,T.QK,T.V,T.O,gates,lds,lam,nwp);
  }
}
#undef SBAR
#undef WAIT_BAR
}
constexpr size_t MiB = 1u << 20;
constexpr size_t WS_CTL = 0, CTL_ZERO_BYTES = 64 * 1024;
constexpr size_t WS_ADA = 1 * MiB;
constexpr size_t WS_WRT = 1 * MiB + 256 * 1024;
constexpr size_t WS_CNT = 1 * MiB + 512 * 1024;
constexpr size_t WS_TAB = 1 * MiB + 640 * 1024;
constexpr size_t WS_TOKE = 2 * MiB;
constexpr size_t WS_TOKW = 2 * MiB + 256 * 1024;
constexpr size_t WS_ROWTOK = 2 * MiB + 512 * 1024;
constexpr size_t WS_ROWW = 3 * MiB;
constexpr size_t WS_DT = 3 * MiB + 512 * 1024;
constexpr size_t WS_WIN = 8 * MiB;
constexpr size_t WS_WMG = 20 * MiB;
constexpr size_t WS_WOUT = 25 * MiB;
constexpr size_t WS_WGU = 27 * MiB;
constexpr size_t WS_WD = 91 * MiB;
constexpr size_t WS_U = 123 * MiB;
constexpr size_t WS_ACT = 187 * MiB;
constexpr size_t WS_HST = 459 * MiB;
constexpr size_t WS_END = 491 * MiB;
constexpr size_t WS_GATES = WS_WGU;
constexpr size_t WS_HBUF = WS_ACT;
constexpr int PROWS = 73728;
constexpr size_t WS_MOUT = WS_ACT + 72 * MiB;
static_assert(WS_HBUF + (size_t)PROWS * FF * 2 <= WS_MOUT && WS_MOUT + (size_t)T * 2 * D * 2 <= WS_HST && WS_ACT + (size_t)T * ACT_LD * 2 <= WS_HST, "d_ws map");
constexpr int CW_TMO = 0, CW_CODE = 1, CW_BAR = 4096;
static_assert((CW_BAR + 3456) * 4 <= (int)CTL_ZERO_BYTES, "barrier words inside the memset region");

constexpr int NWAVES = 8;
constexpr int RING_OFF = 0, RING_BYTES = 131072;
constexpr int LDSCTL_OFF = RING_BYTES, MISC_OFF = LDSCTL_OFF + 320;
constexpr int ROWS_OFF = RING_BYTES + 1024;
constexpr int TAB_OFF = ROWS_OFF + 8 * 256 * 4;
constexpr int LDS_BYTES = 147456;
static_assert(TAB_OFF + (1 + 2 * 512) * 4 <= LDS_BYTES, "LDS map");

#define GAS __attribute__((address_space(1)))
#define LAS __attribute__((address_space(3)))
typedef unsigned short bf16;
typedef unsigned v4u __attribute__((ext_vector_type(4)));
typedef float f32x4 __attribute__((ext_vector_type(4)));
typedef short bf16x8 __attribute__((ext_vector_type(8)));
typedef GAS unsigned gu32;
typedef GAS unsigned long long gu64;
#define RLX_AGENT __ATOMIC_RELAXED, __HIP_MEMORY_SCOPE_AGENT
#define LDS_WAIT() asm volatile("s_waitcnt lgkmcnt(0)" ::: "memory")
#define VM_WAIT() asm volatile("s_waitcnt vmcnt(0)" ::: "memory")
__device__ __forceinline__ unsigned long long rt() { return __builtin_amdgcn_s_memrealtime(); }
__device__ __forceinline__ unsigned f2bf(float f) { unsigned u = __builtin_bit_cast(unsigned, f); return (u + 0x7fffu + ((u >> 16) & 1u)) >> 16; }
__device__ __forceinline__ unsigned pk2(float lo, float hi) { return f2bf(lo) | (f2bf(hi) << 16); }

#define XB_TMO      128
#define XB_XCNT(j)  (256  + 64 * (j))
#define XB_XSUB(j)  (1280 + 64 * (j))
#define XB_XGEN(j)  (2304 + 64 * (j))
#define XB_TOP      3328
#define XB_TOPGEN   3392
#define XCD_BAR_WORDS 3456
#define XB_SPIN_CAP (1u << 18)

__device__ __forceinline__ unsigned xb_ld(unsigned* p)              { return __hip_atomic_load(p, __ATOMIC_RELAXED, __HIP_MEMORY_SCOPE_AGENT); }
__device__ __forceinline__ unsigned xb_add(unsigned* p, unsigned v) { return __hip_atomic_fetch_add(p, v, __ATOMIC_RELAXED, __HIP_MEMORY_SCOPE_AGENT); }
__device__ __forceinline__ unsigned xb_xcc_id() { return (unsigned)__builtin_amdgcn_s_getreg((3 << 11) | 20) & 0xFu; }
#define XB_SPIN(cond, bar) do { unsigned _sp = 0; while (cond) { __builtin_amdgcn_s_sleep(1); \
    if ((++_sp & 255u) == 0u) { if (xb_ld(&(bar)[XB_TMO])) break; if (_sp > XB_SPIN_CAP) { atomicAdd(&(bar)[XB_TMO], 1u); break; } } } } while (0)

struct XcdBarrier {
    unsigned* bar; unsigned x;
    volatile LAS unsigned* st;
};

__device__ __forceinline__ XcdBarrier xcd_barrier_post(unsigned* bar, volatile LAS unsigned* st) {
    XcdBarrier b; b.bar = bar; b.x = xb_xcc_id(); b.st = st;
    if (threadIdx.x == 0) (void)xb_add(&bar[XB_XCNT(b.x)], 1u);
    return b;
}
__device__ __forceinline__ void xcd_barrier_complete(unsigned* bar, unsigned x, unsigned& nloc, unsigned& nx) {
    const unsigned G = gridDim.x * gridDim.y * gridDim.z;
    unsigned sum, cnt, mine, sp = 0u;
    for (;;) {
        sum = 0u; cnt = 0u; mine = 0u;
#pragma unroll
        for (unsigned j = 0; j < 16; ++j) { const unsigned c = xb_ld(&bar[XB_XCNT(j)]); sum += c; cnt += (c > 0u) ? 1u : 0u; mine = (j == x) ? c : mine; }
        if (sum == G) break;
        __builtin_amdgcn_s_sleep(1);
        if ((++sp & 255u) == 0u) { if (xb_ld(&bar[XB_TMO])) break; if (sp > XB_SPIN_CAP) { atomicAdd(&bar[XB_TMO], 1u); break; } }
    }
    nloc = mine > 0u ? mine : 1u; nx = cnt > 0u ? cnt : 1u;
}

__device__ __forceinline__ void xcd_barrier(const XcdBarrier& b) {
    asm volatile("s_waitcnt vmcnt(0)" ::: "memory");
    __syncthreads();
    if (threadIdx.x == 0) {
        unsigned* bar = b.bar;
        __builtin_amdgcn_s_waitcnt(0);
        unsigned nloc = b.st[0], nx = b.st[1];
        if (nloc == 0u) { xcd_barrier_complete(bar, b.x, nloc, nx); b.st[0] = nloc; b.st[1] = nx; }
        const unsigned old = xb_add(&bar[XB_XSUB(b.x)], 1u);
        const unsigned gen = old / nloc;
        if (old + 1u == (gen + 1u) * nloc) {
            __builtin_amdgcn_fence(__ATOMIC_RELEASE, "agent");
            asm volatile("s_waitcnt vmcnt(0)" ::: "memory");
            const unsigned og = xb_add(&bar[XB_TOP], 1u);
            const unsigned tg = og / nx;
            if (og + 1u == (tg + 1u) * nx) xb_add(&bar[XB_TOPGEN], 1u);
            else XB_SPIN(xb_ld(&bar[XB_TOPGEN]) == tg, bar);
            __builtin_amdgcn_fence(__ATOMIC_ACQUIRE, "agent");
            xb_add(&bar[XB_XGEN(b.x)], 1u);
            asm volatile("s_waitcnt vmcnt(0)" ::: "memory");
        } else {
            XB_SPIN(xb_ld(&bar[XB_XGEN(b.x)]) == gen, bar);
            __builtin_amdgcn_fence(__ATOMIC_ACQUIRE, "agent");
            asm volatile("s_waitcnt vmcnt(0)" ::: "memory");
        }
    }
    __syncthreads();
}

typedef float f32x16 __attribute__((ext_vector_type(16)));
typedef short s16x4 __attribute__((ext_vector_type(4)));
typedef unsigned v2u __attribute__((ext_vector_type(2)));
using pg8::cvt_pk_bf16; using pg8::bf_lo; using pg8::bf_hi; using pg8::sigmoidf_; using pg8::f32x2;
#define WS_DPP(v_, ctrl_) (v_ + __builtin_bit_cast(float, __builtin_amdgcn_update_dpp(0, __builtin_bit_cast(int, v_), (ctrl_), 0xf, 0xf, false)))
__device__ __forceinline__ float wave_sum(float v) {
    v = WS_DPP(v, 0xB1);
    v = WS_DPP(v, 0x4E);
    v = WS_DPP(v, 0x141);
    v = WS_DPP(v, 0x140);
    { auto rr = __builtin_amdgcn_permlane16_swap(__float_as_uint(v), __float_as_uint(v), false, false); v = __uint_as_float(rr[0]) + __uint_as_float(rr[1]); }
    { auto rr = __builtin_amdgcn_permlane32_swap(__float_as_uint(v), __float_as_uint(v), false, false); v = __uint_as_float(rr[0]) + __uint_as_float(rr[1]); }
    return v;
}
#define LBAR() do { asm volatile("s_waitcnt lgkmcnt(0)" ::: "memory"); __builtin_amdgcn_s_barrier(); asm volatile("" ::: "memory"); } while (0)
__device__ __forceinline__ float dot4(f32x4 a, f32x4 b) { return (a.x * b.x + a.y * b.y) + (a.z * b.z + a.w * b.w); }

struct MapIn { bf16* win; bf16* wmg;
    __device__ __forceinline__ bf16* operator()(int n) const {
        if (n < 3072) return win + (size_t)n * D;
        if (n < 3088) return nullptr;
        if (n < 5136) { const int c = n - 3088, blk = c >> 6, d = c & 63, g = (d & 31) >> 2, e = (d & 3) + ((d >> 5) << 2); return win + (size_t)(3072 + blk * 64 + 8 * g + e) * D; }
        if (n < 6160) return win + (size_t)(5120 + n - 5136) * D;
        const int c = n - 6160, j = c & 1023, half = c >> 10; return wmg + (size_t)(256 * (j >> 7) + 128 * half + (j & 127)) * D; } };
struct MapPlain { bf16* w; int K;
    __device__ __forceinline__ bf16* operator()(int n) const { return w + (size_t)n * K; } };
struct MapIl { bf16* w; int half;
    __device__ __forceinline__ bf16* operator()(int n) const { return w + (size_t)(256 * (n >> 7) + 128 * half + (n & 127)) * D; } };
struct TItem { const float* W; int K, N, it, kind, e; };
__device__ __forceinline__ void titem_load(const TItem& t, int lane, float (&r)[32]) {
    const int nblk = (t.N + 31) / 32, kb = t.it / nblk, nb = t.it % nblk, k0 = 64 * kb; int nn = 32 * nb + (lane & 31); nn = nn < t.N ? nn : t.N - 1;
    const float* p = t.W + (size_t)(k0 + (lane >> 5)) * t.N + nn;
#pragma unroll
    for (int i = 0; i < 32; ++i) r[i] = p[(size_t)(2 * i) * t.N];
}
template <class MapFn>
__device__ __forceinline__ void titem_store_map(const TItem& t, const float (&r)[32], LAS float* scr, int lane, const MapFn& map) {
    const int nblk = (t.N + 31) / 32, kb = t.it / nblk, nb = t.it % nblk, k0 = 64 * kb, n0 = 32 * nb;
#pragma unroll
    for (int i = 0; i < 32; ++i) scr[(2 * i + (lane >> 5)) * 33 + (lane & 31)] = r[i];
    LDS_WAIT(); asm volatile("" ::: "memory");
    const int c = lane & 7;
#pragma unroll
    for (int j = 0; j < 4; ++j) { const int nl = (lane >> 3) + 8 * j; const LAS float* s = scr + (8 * c) * 33 + nl;
        v4u o; o.x = cvt_pk_bf16(s[0 * 33], s[1 * 33]); o.y = cvt_pk_bf16(s[2 * 33], s[3 * 33]); o.z = cvt_pk_bf16(s[4 * 33], s[5 * 33]); o.w = cvt_pk_bf16(s[6 * 33], s[7 * 33]);
        if (n0 + nl < t.N) { bf16* dst = map(n0 + nl); if (dst) *(GAS v4u*)(dst + k0 + 8 * c) = o; } }
    LDS_WAIT(); asm volatile("" ::: "memory");
}

struct Ptrs {
    const float *x, *c, *w_ada, *b_ada, *w_in, *wg2, *bg2, *gnw, *lq1, *lk1, *lq2, *lk2, *dnw, *w_out, *ln1w, *ln1b, *wrg, *brg, *wre, *bre, *weg, *weu, *wed, *ln2w, *ln2b;
    const int* pos;
    float* out;
    float *ada, *wrt, *tokw, *roww, *dt, *hst;
    int *cnt, *tab, *toke, *rowtok;
    bf16 *win, *wmg, *wout, *wgu, *wd, *u, *act, *hbuf, *mout, *dqk;
    unsigned* dbg;
    unsigned char* gates;
};

constexpr int TI_IN = 16 * 257, TI_OUT = 16 * 32, TI_E = 16 * 16, TI_D = 8 * 32;
constexpr int TI_DENSE = TI_IN + TI_OUT, TI_ALL = TI_DENSE + NEXP * (2 * TI_E + TI_D);
__device__ __forceinline__ void transpose_items(const Ptrs& P, LAS unsigned char* lds, int gw, int NGW, int lane, int wave, int lo, int hi) {
    LAS float* scr = (LAS float*)(lds + RING_OFF + wave * 16384);
#define P0_DECODE(t_, idx_) do { int r_ = (idx_); \
        if (r_ < TI_IN) { t_ = TItem{P.w_in, D, IN_COLS, r_, 0, 0}; } else { r_ -= TI_IN; \
        if (r_ < TI_OUT) { t_ = TItem{P.w_out, D, D, r_, 1, 0}; } else { r_ -= TI_OUT; \
        if (r_ < NEXP * TI_E) { t_ = TItem{P.weg + (size_t)(r_ / TI_E) * D * FF, D, FF, r_ % TI_E, 2, r_ / TI_E}; } else { r_ -= NEXP * TI_E; \
        if (r_ < NEXP * TI_E) { t_ = TItem{P.weu + (size_t)(r_ / TI_E) * D * FF, D, FF, r_ % TI_E, 3, r_ / TI_E}; } else { r_ -= NEXP * TI_E; \
        t_ = TItem{P.wed + (size_t)(r_ / TI_D) * FF * D, FF, D, r_ % TI_D, 4, r_ / TI_D}; } } } } } while (0)
#define P0_STORE(t_, r_) do { \
        if (t_.kind == 0) titem_store_map(t_, r_, scr, lane, MapIn{P.win, P.wmg}); \
        else if (t_.kind == 1) titem_store_map(t_, r_, scr, lane, MapPlain{P.wout, D}); \
        else if (t_.kind == 2) titem_store_map(t_, r_, scr, lane, MapIl{P.wgu + (size_t)t_.e * 1024 * D, 0}); \
        else if (t_.kind == 3) titem_store_map(t_, r_, scr, lane, MapIl{P.wgu + (size_t)t_.e * 1024 * D, 1}); \
        else titem_store_map(t_, r_, scr, lane, MapPlain{P.wd + (size_t)t_.e * D * FF, FF}); } while (0)
    int it = lo + gw; TItem ta{}, tb{}; float ra[32], rb[32];
    if (it < hi) { P0_DECODE(ta, it); titem_load(ta, lane, ra); }
    while (it < hi) {
        const int it2 = it + NGW; if (it2 < hi) { P0_DECODE(tb, it2); titem_load(tb, lane, rb); }
        P0_STORE(ta, ra);
        it = it2; if (it >= hi) break;
        const int it3 = it + NGW; if (it3 < hi) { P0_DECODE(ta, it3); titem_load(ta, lane, ra); }
        P0_STORE(tb, rb);
        it = it3;
    }
#undef P0_DECODE
#undef P0_STORE
}

__device__ __forceinline__ void p0_prologue(const Ptrs& P, LAS unsigned char* lds, int vcu, int G, int tid, int lane, int wave) {
#ifndef P0PROBE
#define P0PROBE 0
#endif
    unsigned long long p0t = 0ull; if (P0PROBE && blockIdx.x == 0 && tid == 0) p0t = __builtin_amdgcn_s_memrealtime();
    if (vcu < 192) {
        LAS float* sc = (LAS float*)(lds + RING_OFF);
        LAS float* red = (LAS float*)(lds + RING_OFF + 32768);
        for (int i = tid; i < 8 * D; i += NWAVES * 64) { const float v = P.c[i]; sc[i] = v / (1.f + __expf(-v)); }
        __syncthreads();
        for (int item = vcu; item < 192; item += G) {
            const int col = item * 32 + (tid & 31), kg = tid >> 5;
            float a[8];
#pragma unroll
            for (int b = 0; b < 8; ++b) a[b] = 0.f;
#pragma unroll 16
            for (int i = 0; i < 64; ++i) { const int k = kg + 16 * i; const float w = P.w_ada[(size_t)k * (6 * D) + col];
#pragma unroll
                for (int b = 0; b < 8; ++b) a[b] += sc[b * D + k] * w; }
#pragma unroll
            for (int b = 0; b < 8; ++b) red[(kg * 8 + b) * 32 + (tid & 31)] = a[b];
            __syncthreads();
            if (tid < 256) { const int b = tid >> 5, cc = tid & 31; float s = 0.f;
#pragma unroll
                for (int q = 0; q < 16; ++q) s += red[(q * 8 + b) * 32 + cc];
                P.ada[(size_t)b * (6 * D) + item * 32 + cc] = s + P.b_ada[item * 32 + cc]; }
            __syncthreads();
        }
    }
    if (P0PROBE && blockIdx.x == 0 && tid == 0) __hip_atomic_store(P.dbg, (unsigned)(__builtin_amdgcn_s_memrealtime() - p0t), RLX_AGENT);
    const int gt = vcu * (NWAVES * 64) + tid, NT = G * NWAVES * 64;
    for (int i = gt; i < 36 * D; i += NT) { const int cc = i >> 10, k = i & 1023; P.wrt[i] = cc < 4 ? P.wrg[k * 4 + cc] : P.wre[k * 32 + (cc - 4)]; }
    transpose_items(P, lds, vcu * NWAVES + wave, G * NWAVES, lane, wave, 0, TI_DENSE);
}

namespace p1n { constexpr int U_LD = 1032, WAVE_BYTES = 4 * U_LD * 2, L_BF = 8 * WAVE_BYTES; static_assert(L_BF + 32 * 64 * 16 <= RING_BYTES, "P1 LDS map"); }
__device__ __forceinline__ void p1_ln_mod(const Ptrs& P, LAS unsigned char* lds, int gw, int NGW, int lane, int wave) {
    LAS bf16* UW = (LAS bf16*)(lds + RING_OFF + wave * p1n::WAVE_BYTES);
    const int fr = lane & 15, fq = lane >> 4;
    LAS v4u* BF = (LAS v4u*)(lds + RING_OFF + p1n::L_BF);
#pragma unroll
    for (int ss = 0; ss < 4; ++ss) { const int s = wave * 4 + ss, k0 = 32 * s + 8 * fq; unsigned hw[4];
#pragma unroll
        for (int j = 0; j < 8; j += 2) hw[j >> 1] = cvt_pk_bf16(P.w_in[(size_t)(k0 + j) * IN_COLS + 3072 + fr], P.w_in[(size_t)(k0 + j + 1) * IN_COLS + 3072 + fr]);
        BF[s * 64 + lane] = (v4u){hw[0], hw[1], hw[2], hw[3]}; }
    __syncthreads();
    for (int blk = gw; blk < T / 16; blk += NGW) {
        const int m0 = blk * 16, b = m0 / SEQ;
        f32x4 sh[4], sl[4];
#pragma unroll
        for (int j = 0; j < 4; ++j) { sh[j] = *((const f32x4*)(P.ada + (size_t)b * 6 * D) + lane + 64 * j); sl[j] = *((const f32x4*)(P.ada + (size_t)b * 6 * D + D) + lane + 64 * j) + 1.f; }
        f32x4 pre[4][4];
#pragma unroll
        for (int rr = 0; rr < 4; ++rr)
#pragma unroll
            for (int j = 0; j < 4; ++j) pre[rr][j] = *((const GAS f32x4*)(P.x + (size_t)(m0 + rr) * D) + lane + 64 * j);
#pragma unroll 1
        for (int g4 = 0; g4 < 4; ++g4) {
#pragma unroll
            for (int rr = 0; rr < 4; ++rr) {
                const int m = m0 + 4 * g4 + rr;
                f32x4 v[4]; float s = 0.f;
#pragma unroll
                for (int j = 0; j < 4; ++j) { v[j] = pre[rr][j]; s += (v[j].x + v[j].y) + (v[j].z + v[j].w); }
                if (g4 < 3) {
#pragma unroll
                    for (int j = 0; j < 4; ++j) pre[rr][j] = *((const GAS f32x4*)(P.x + (size_t)(m + 4) * D) + lane + 64 * j); }
                const float mean = wave_sum(s) * (1.f / D); float s2 = 0.f;
#pragma unroll
                for (int j = 0; j < 4; ++j) { v[j] = v[j] - mean; s2 += dot4(v[j], v[j]); }
                const float rstd = 1.f / sqrtf(wave_sum(s2) * (1.f / D) + LN_EPS);
                GAS v2u* o8 = (GAS v2u*)(P.u + (size_t)m * D) + lane;
#pragma unroll
                for (int j = 0; j < 4; ++j) { const f32x4 uu = v[j] * rstd * sl[j] + sh[j];
                    v2u w; w.x = cvt_pk_bf16(uu.x, uu.y); w.y = cvt_pk_bf16(uu.z, uu.w); o8[64 * j] = w; *(LAS v2u*)(UW + rr * p1n::U_LD + 4 * lane + 256 * j) = w; }
            }
            asm volatile("s_waitcnt lgkmcnt(0)" ::: "memory");
            f32x4 acc = (f32x4){0.f, 0.f, 0.f, 0.f};
#pragma unroll
            for (int s = 0; s < 32; ++s) { const bf16x8 a = *(const LAS bf16x8*)(UW + (fr & 3) * p1n::U_LD + 32 * s + 8 * fq); const bf16x8 bb = __builtin_bit_cast(bf16x8, BF[s * 64 + lane]); acc = __builtin_amdgcn_mfma_f32_16x16x32_bf16(a, bb, acc, 0, 0, 0); }
            if (fq == 0) {
#pragma unroll
                for (int g = 0; g < 4; ++g) P.act[(size_t)(m0 + 4 * g4 + g) * ACT_LD + AC_GR + fr] = (bf16)f2bf(acc[g]); }
            asm volatile("s_waitcnt lgkmcnt(0)" ::: "memory");
        }
    }
}

namespace gla {
constexpr int QT_LD = 136, KD_LD = 72, AT_LD = 72, OS_LD = 264;
constexpr int L_QT = 0, L_KT = L_QT + 64 * QT_LD * 2, L_KDT = L_KT + 64 * QT_LD * 2, L_VB = L_KDT + 128 * KD_LD * 2, L_AT = L_VB + 32768, L_KRAW = L_AT + 64 * AT_LD * 2, L_QRAW = L_KRAW + 16384, L_ENDC = L_QRAW + 16384, L_OS = 0;
constexpr int A_KDT = 0, A_VB = A_KDT + 128 * KD_LD * 2, A_KRAW = A_VB + 2 * 32768, A_END = A_KRAW + 2 * 16384;
constexpr int X_GL = ROWS_OFF, X_NW = X_GL + 2 * 2048, X_DEC = X_NW + 1024, X_END = X_DEC + 512;
static_assert(L_ENDC <= RING_BYTES && A_END <= RING_BYTES && 64 * OS_LD * 2 <= L_KDT && X_END <= LDS_BYTES, "GLA LDS map");
__device__ __forceinline__ int crow(int reg, int h) { return (reg & 3) + 8 * (reg >> 2) + 4 * h; }
__device__ __forceinline__ float fexp(float x) { return __builtin_amdgcn_exp2f(x * 1.4426950408889634f); }
__device__ __forceinline__ float flog(float x) { return __builtin_amdgcn_logf(x) * 0.6931471805599453f; }
__device__ __forceinline__ unsigned bf1(float x) { return cvt_pk_bf16(x, x) & 0xffffu; }
__device__ __forceinline__ unsigned vswz(unsigned row) { return ((row & 3) << 2) | ((row >> 2) & 3); }
__device__ __forceinline__ unsigned voff_b(unsigned row, unsigned ch) { return 256u * row + 16u * (ch ^ vswz(row)); }
__device__ __forceinline__ unsigned vtr_addr(unsigned lane, unsigned c, unsigned ks, unsigned t) {
    const unsigned h = lane >> 5, blk = (lane >> 4) & 1, q = (lane & 15) >> 2, p = lane & 3;
    return voff_b(16 * ks + 8 * h + 4 * t + q, 4 * c + 2 * blk + (p >> 1)) + 8 * (p & 1);
}
typedef short v4i16_t __attribute__((ext_vector_type(4)));
__device__ __forceinline__ void glds16(const void* gsrc, unsigned lds_dst) { unsigned keep;
    asm volatile("s_mov_b32 %0, m0\n\ts_mov_b32 m0, %2\n\ts_nop 0\n\tglobal_load_lds_dwordx4 %1, off\n\ts_mov_b32 m0, %0" : "=&s"(keep) : "v"(gsrc), "s"(lds_dst) : "memory"); }
#define GLA_LDSA(p_) ((unsigned)__builtin_amdgcn_readfirstlane((int)(unsigned)(size_t)(p_)))
#define MFMA32(a, b, c) __builtin_amdgcn_mfma_f32_32x32x16_bf16((a), (b), (c), 0, 0, 0)
#define MFMA16(a, b, c) __builtin_amdgcn_mfma_f32_16x16x32_bf16((a), (b), (c), 0, 0, 0)
template <bool OUT>
__device__ __forceinline__ void gla_unit(LAS unsigned char* lds, const Ptrs& P, int b, int h, int sc) {
    const int tid = threadIdx.x, lane0 = tid & 63, wid = __builtin_amdgcn_readfirstlane(tid >> 6);
#define GLA_LANE_VARS int lanev_ = lane0; asm volatile("" : "+v"(lanev_)); const int lane = lanev_, r = lane & 31, hh = lane >> 5, fr = lane & 15, fq = lane >> 4, col = 16 * wid + fr; (void)r; (void)hh; (void)fr; (void)fq; (void)col
    LAS bf16* QT = (LAS bf16*)(lds + L_QT); LAS bf16* KT = (LAS bf16*)(lds + L_KT); LAS bf16* KDT = (LAS bf16*)(lds + (OUT ? L_KDT : A_KDT)); LAS bf16* AT = (LAS bf16*)(lds + L_AT); LAS bf16* OS = (LAS bf16*)(lds + L_OS);
    LAS unsigned char* VB0 = lds + (OUT ? L_VB : A_VB); LAS unsigned char* KRAW0 = lds + (OUT ? L_KRAW : A_KRAW); LAS unsigned char* QRAW = lds + L_QRAW;
    LAS unsigned char* GLRAW0 = lds - RING_OFF + X_GL; LAS float* NW = (LAS float*)(lds - RING_OFF + X_NW); LAS float* DEC = (LAS float*)(lds - RING_OFF + X_DEC);
    bf16* act = P.act;
    float bias; bf16x8 bh, bl;
    { GLA_LANE_VARS;
        bias = P.bg2[h * 128 + col];
        unsigned hw[4], lw[4];
#pragma unroll
        for (int j = 0; j < 8; j += 2) { const float m_ = fq < 2 ? 1.f : 0.f; const float w0 = P.wg2[(8 * (fq & 1) + j) * 512 + h * 128 + col] * m_, w1 = P.wg2[(8 * (fq & 1) + j + 1) * 512 + h * 128 + col] * m_;
            const unsigned hp = cvt_pk_bf16(w0, w1); hw[j >> 1] = hp; lw[j >> 1] = cvt_pk_bf16(w0 - bf_lo(hp), w1 - bf_hi(hp)); }
        bh = __builtin_bit_cast(bf16x8, (v4u){hw[0], hw[1], hw[2], hw[3]}); bl = __builtin_bit_cast(bf16x8, (v4u){lw[0], lw[1], lw[2], lw[3]}); }
    if (OUT && tid < 256) NW[tid] = P.gnw[tid];
    const int bhs = (b * 4 + h) * 8 + sc;
    float* Hp = P.hst + (size_t)bhs * (128 * 256);
    float dsum = 0.f;
    v4u pgo[4]; v2u pga[4];
    const size_t rowu = (size_t)b * SEQ + sc * 512;
    unsigned okq[2], ov_[4], og_ = 0u, ogo_ = 0u, oga_ = 0u;
    { GLA_LANE_VARS;
#pragma unroll
        for (int pp_ = 0; pp_ < 2; ++pp_) okq[pp_] = (unsigned)((4 * (wid + 8 * pp_) + (lane >> 4)) * ACT_LD + h * 128 + (lane & 15) * 8) * 2u;
#pragma unroll
        for (int pp_ = 0; pp_ < 4; ++pp_) { const int q_ = wid + 8 * pp_, t_ = q_ >> 3; const unsigned rin_ = 4 * (q_ & 7) + (lane >> 4), chin_ = (lane & 15) ^ vswz(rin_);
            ov_[pp_] = (unsigned)((32 * (t_ >> 1) + rin_) * ACT_LD + AC_GV + h * 256 + (16 * (t_ & 1) + chin_) * 8) * 2u; }
        og_ = (unsigned)((32 * wid + (lane >> 1)) * ACT_LD + AC_GR + (lane & 1) * 8) * 2u;
        ogo_ = (unsigned)((8 * wid + (lane >> 3)) * ACT_LD + AC_GO + h * 256 + (lane & 7) * 8) * 2u;
        oga_ = (unsigned)((8 * wid + (lane >> 3)) * 2048 + h * 256 + (lane & 7) * 8); }
#define GLA_CBASE(n_) ((const char*)act + (rowu + (size_t)(n_) * 64) * (ACT_LD * 2))
#define GLA_DMA_KQ(n_, dst_, ac_) do { const char* cb_ = GLA_CBASE(n_) + (ac_) * 2; \
        _Pragma("unroll") for (int pp_ = 0; pp_ < 2; ++pp_) glds16(cb_ + okq[pp_], GLA_LDSA((dst_) + (wid + 8 * pp_) * 1024)); } while (0)
#define GLA_DMA_V(n_, dst_) do { const char* cb_ = GLA_CBASE(n_); \
        _Pragma("unroll") for (int pp_ = 0; pp_ < 4; ++pp_) glds16(cb_ + ov_[pp_], GLA_LDSA((dst_) + (wid + 8 * pp_) * 1024)); } while (0)
#define GLA_DMA_G(n_, dst_) do { if (wid < 2) glds16(GLA_CBASE(n_) + og_, GLA_LDSA((dst_) + wid * 1024)); } while (0)
    f32x16 S[4];
    { GLA_LANE_VARS;
        GLA_DMA_KQ(0, KRAW0, AC_GK); if (OUT) GLA_DMA_KQ(0, QRAW, AC_GQ); GLA_DMA_G(0, GLRAW0); GLA_DMA_V(0, VB0);
#pragma unroll
        for (int i = 0; i < 4; ++i) { const float* hp = Hp + (size_t)(32 * i + 4 * hh) * 256 + 32 * wid + r;
#pragma unroll
            for (int g = 0; g < 16; ++g) S[i][g] = OUT ? hp[((g & 3) + 8 * (g >> 2)) * 256] : 0.f;
            asm volatile("" ::: "memory"); } }
    asm volatile("s_waitcnt vmcnt(0)" ::: "memory");
    LBAR();
#ifndef GPROBE_K
#define GPROBE_K -1
#endif
    unsigned long long gacc = 0ull, gt0 = 0ull; const bool gstamp = OUT && GPROBE_K >= 0 && blockIdx.x == 0 && tid == 0;
#define GST(k_) do { if (gstamp) { const unsigned long long t_ = __builtin_amdgcn_s_memrealtime(); if ((k_) == GPROBE_K) gt0 = t_; if ((k_) == GPROBE_K + 1) gacc += t_ - gt0; } } while (0)
    for (int n = 0; n < 8; ++n) {
        GLA_LANE_VARS;
        GST(0);
        size_t row0 = rowu + n * 64; asm volatile("" : "+s"(row0));
        const int bsel = OUT ? 0 : (n & 1);
        LAS unsigned char* KB = KRAW0 + bsel * 16384; LAS unsigned char* GB = GLRAW0 + bsel * 2048; LAS unsigned char* VB = VB0 + bsel * 32768;
        if (!OUT && n + 1 < 8) { GLA_DMA_KQ(n + 1, KRAW0 + (bsel ^ 1) * 16384, AC_GK); GLA_DMA_G(n + 1, GLRAW0 + (bsel ^ 1) * 2048); GLA_DMA_V(n + 1, VB0 + (bsel ^ 1) * 32768); }
        bf16x8 bv[4];
#pragma unroll
        for (int ks = 0; ks < 4; ++ks) { LAS unsigned char* tb = VB + ((ks >> 1) * 2 + (wid >> 2)) * 8192;
            const v4i16_t lo = __builtin_amdgcn_ds_read_tr16_b64_v4i16((LAS v4i16_t*)(tb + vtr_addr(lane, wid & 3, ks & 1, 0))), hi = __builtin_amdgcn_ds_read_tr16_b64_v4i16((LAS v4i16_t*)(tb + vtr_addr(lane, wid & 3, ks & 1, 1)));
            bv[ks] = __builtin_shufflevector(lo, hi, 0, 1, 2, 3, 4, 5, 6, 7); }
        f32x4 lg[4];
#pragma unroll
        for (int mi = 0; mi < 4; ++mi) { const bf16x8 a = *(const LAS bf16x8*)(GB + (16 * mi + fr) * 32 + (fq & 1) * 16);
            lg[mi] = MFMA16(a, bh, ((f32x4){bias, bias, bias, bias})); lg[mi] = MFMA16(a, bl, lg[mi]); }
        float bq[4][4]; float run = 0.f;
#pragma unroll
        for (int mi = 0; mi < 4; ++mi) { float c = 0.f;
#pragma unroll
            for (int g = 0; g < 4; ++g) { const float l = lg[mi][g]; c += (fminf(l, 0.f) - flog(1.f + fexp(-fabsf(l)))) * (1.f / 16.f); bq[mi][g] = c; }
            const float p1 = __shfl_xor(c, 16), pp = c + p1, p2 = __shfl_xor(pp, 32);
            const float base = run + ((fq & 1) ? p1 : 0.f) + ((fq & 2) ? p2 : 0.f);
#pragma unroll
            for (int g = 0; g < 4; ++g) bq[mi][g] += base;
            run += pp + p2; }
        const float tot = run, etot = fexp(tot);
#pragma unroll
        for (int mi = 0; mi < 4; ++mi) { float kd[4];
#pragma unroll
            for (int g = 0; g < 4; ++g) { const int row = 16 * mi + 4 * fq + g; const float bi = bq[mi][g];
                const float kraw = __uint_as_float((unsigned)(*(const LAS bf16*)(KB + (row * 128 + col) * 2)) << 16);
                const float kt = kraw * fexp(-bi);
                kd[g] = kt * etot;
                if (OUT) { const float qraw = __uint_as_float((unsigned)(*(const LAS bf16*)(QRAW + (row * 128 + col) * 2)) << 16);
                    QT[row * QT_LD + col] = (bf16)bf1(qraw * 0.08838834764831845f * fexp(bi)); KT[row * QT_LD + col] = (bf16)bf1(kt); } }
            *(LAS v2u*)(KDT + col * KD_LD + 16 * mi + 4 * fq) = (v2u){cvt_pk_bf16(kd[0], kd[1]), cvt_pk_bf16(kd[2], kd[3])}; }
        if (fq == 0) DEC[col] = etot;
        dsum += tot;
        LBAR();
        GST(1);
        f32x16 o[2];
        if (OUT) {
#pragma unroll
            for (int tt = 0; tt < 2; ++tt) { const int t = 2 * wid + tt, mi = t >> 2, nj = t & 3; f32x4 a4 = (f32x4){0.f, 0.f, 0.f, 0.f};
                if (nj <= mi) {
#pragma unroll
                    for (int s = 0; s < 4; ++s) { const bf16x8 a = *(const LAS bf16x8*)(QT + (16 * mi + fr) * QT_LD + 32 * s + 8 * fq); const bf16x8 bb = *(const LAS bf16x8*)(KT + (16 * nj + fr) * QT_LD + 32 * s + 8 * fq); a4 = MFMA16(a, bb, a4); } }
#pragma unroll
                for (int g = 0; g < 4; ++g) { const int row = 16 * mi + 4 * fq + g, cc = 16 * nj + fr; AT[row * AT_LD + cc] = (bf16)bf1(cc <= row ? a4[g] : 0.f); } }
            LBAR();
            GST(2);
            const bool more = n + 1 < 8;
            if (more) GLA_DMA_KQ(n + 1, KRAW0, AC_GK);
#pragma unroll
            for (int mt = 0; mt < 2; ++mt) {
#pragma unroll
                for (int g = 0; g < 16; ++g) o[mt][g] = 0.f;
#pragma unroll
                for (int ks = 0; ks < 4; ++ks) if (mt == 1 || ks < 2) { const bf16x8 a = *(const LAS bf16x8*)(AT + (32 * mt + r) * AT_LD + 16 * ks + 8 * hh); o[mt] = MFMA32(a, bv[ks], o[mt]); }
            }
            if (more) { GLA_DMA_KQ(n + 1, QRAW, AC_GQ); GLA_DMA_G(n + 1, GLRAW0); }
#pragma unroll
            for (int i = 0; i < 4; ++i) {
                bf16x8 sp[2];
#pragma unroll
                for (int s = 0; s < 2; ++s) { v4u w; w.x = cvt_pk_bf16(S[i][8 * s + 0], S[i][8 * s + 1]); w.y = cvt_pk_bf16(S[i][8 * s + 2], S[i][8 * s + 3]); w.z = cvt_pk_bf16(S[i][8 * s + 4], S[i][8 * s + 5]); w.w = cvt_pk_bf16(S[i][8 * s + 6], S[i][8 * s + 7]); sp[s] = __builtin_bit_cast(bf16x8, w); }
#pragma unroll
                for (int mt = 0; mt < 2; ++mt)
#pragma unroll
                    for (int s = 0; s < 2; ++s) { const s16x4 lo = *(const LAS s16x4*)(QT + (32 * mt + r) * QT_LD + 32 * i + 16 * s + 4 * hh); const s16x4 hi = *(const LAS s16x4*)(QT + (32 * mt + r) * QT_LD + 32 * i + 16 * s + 8 + 4 * hh);
                        const bf16x8 a = __builtin_shufflevector(lo, hi, 0, 1, 2, 3, 4, 5, 6, 7); o[mt] = MFMA32(a, sp[s], o[mt]); }
                if (i == 1 && more) GLA_DMA_V(n + 1, VB0);
            }
            { const char* gop = GLA_CBASE(n) + ogo_;
#pragma unroll
                for (int q4 = 0; q4 < 4; ++q4) pgo[q4] = *(const GAS v4u*)(gop + q4 * 128);
                const unsigned char* gap = P.gates + (rowu + (size_t)n * 64) * 2048 + oga_;
#pragma unroll
                for (int q4 = 0; q4 < 4; ++q4) pga[q4] = *(const GAS v2u*)(gap + q4 * 64); }
        }
#pragma unroll
        for (int i = 0; i < 4; ++i) {
#pragma unroll
            for (int g = 0; g < 16; ++g) S[i][g] *= DEC[32 * i + crow(g, hh)];
#pragma unroll
            for (int ks = 0; ks < 4; ++ks) { const bf16x8 a = *(const LAS bf16x8*)(KDT + (32 * i + r) * KD_LD + 16 * ks + 8 * hh); S[i] = MFMA32(a, bv[ks], S[i]); }
        }
        if (!OUT) { asm volatile("s_waitcnt vmcnt(0)" ::: "memory"); LBAR(); }
        if (OUT) {
            LBAR();
            GST(3);
#pragma unroll
            for (int mt = 0; mt < 2; ++mt)
#pragma unroll
                for (int g = 0; g < 16; ++g) OS[(32 * mt + crow(g, hh)) * OS_LD + 32 * wid + r] = (bf16)bf1(o[mt][g]);
            LBAR();
            GST(4);
            asm volatile("s_waitcnt vmcnt(0)" ::: "memory");
            const int rowl = 8 * wid + (lane >> 3), part = lane & 7; const LAS bf16* orow = OS + rowl * OS_LD + part * 8;
            f32x4 ov[8]; float ss = 0.f;
#pragma unroll
            for (int q4 = 0; q4 < 4; ++q4) { const v4u w = *(const LAS v4u*)(orow + 64 * q4); ov[2 * q4] = (f32x4){bf_lo(w.x), bf_hi(w.x), bf_lo(w.y), bf_hi(w.y)}; ov[2 * q4 + 1] = (f32x4){bf_lo(w.z), bf_hi(w.z), bf_lo(w.w), bf_hi(w.w)};
                ss += dot4(ov[2 * q4], ov[2 * q4]) + dot4(ov[2 * q4 + 1], ov[2 * q4 + 1]); }
            ss += __shfl_xor(ss, 1); ss += __shfl_xor(ss, 2); ss += __shfl_xor(ss, 4);
            const float rstd = 1.f / sqrtf(ss * (1.f / 256.f) + RMS_EPS);
            bf16* orp = act + (row0 + rowl) * ACT_LD + AC_OGLA + h * 256 + part * 8; const LAS float* nw = NW + part * 8;
#pragma unroll
            for (int q4 = 0; q4 < 4; ++q4) { const v4u gg = pgo[q4]; const f32x4 w0 = *(const LAS f32x4*)(nw + q4 * 64), w1 = *(const LAS f32x4*)(nw + q4 * 64 + 4); const v2u gb_ = pga[q4];
                const f32x4 ga0 = (f32x4){(float)(gb_.x & 0xffu), (float)((gb_.x >> 8) & 0xffu), (float)((gb_.x >> 16) & 0xffu), (float)(gb_.x >> 24)} * (1.f / 255.f), ga1 = (f32x4){(float)(gb_.y & 0xffu), (float)((gb_.y >> 8) & 0xffu), (float)((gb_.y >> 16) & 0xffu), (float)(gb_.y >> 24)} * (1.f / 255.f);
                const f32x4 a0 = ov[2 * q4] * rstd * w0 * ga0, a1 = ov[2 * q4 + 1] * rstd * w1 * ga1;
                const float g0 = bf_lo(gg.x), g1 = bf_hi(gg.x), g2 = bf_lo(gg.y), g3 = bf_hi(gg.y), g4 = bf_lo(gg.z), g5 = bf_hi(gg.z), g6 = bf_lo(gg.w), g7 = bf_hi(gg.w);
                v4u w; w.x = cvt_pk_bf16(a0.x * g0 * sigmoidf_(g0), a0.y * g1 * sigmoidf_(g1)); w.y = cvt_pk_bf16(a0.z * g2 * sigmoidf_(g2), a0.w * g3 * sigmoidf_(g3));
                w.z = cvt_pk_bf16(a1.x * g4 * sigmoidf_(g4), a1.y * g5 * sigmoidf_(g5)); w.w = cvt_pk_bf16(a1.z * g6 * sigmoidf_(g6), a1.w * g7 * sigmoidf_(g7));
                *(GAS v4u*)(orp + q4 * 64) = w; }
            LBAR();
            GST(5);
        }
    }
    if (gstamp) __hip_atomic_store(P.dbg, (unsigned)gacc, RLX_AGENT);
#undef GST
#undef GLA_DMA_KQ
#undef GLA_DMA_V
#undef GLA_DMA_G
#undef GLA_CBASE
    if (!OUT) { GLA_LANE_VARS;
#pragma unroll
        for (int i = 0; i < 4; ++i)
#pragma unroll
            for (int g = 0; g < 16; ++g) Hp[(32 * i + crow(g, hh)) * 256 + 32 * wid + r] = S[i][g];
        if (fq == 0) P.dt[bhs * 128 + col] = fexp(dsum);
    }
#undef GLA_LANE_VARS
}
__device__ __forceinline__ void gla_scan(const Ptrs& P, int gt, int NT) {
    for (int v = gt; v < 32 * 128 * 64; v += NT) {
        const int bh = v >> 13, rem = v & 8191, dk = rem >> 6, dv4 = rem & 63;
        f32x4 s = (f32x4){0.f, 0.f, 0.f, 0.f};
#pragma unroll
        for (int sc = 0; sc < 8; ++sc) { GAS f32x4* p = (GAS f32x4*)(P.hst + ((size_t)(bh * 8 + sc) * 128 + dk) * 256) + dv4;
            f32x4 hv = (f32x4){0.f, 0.f, 0.f, 0.f}; float dd = 0.f; if (sc < 7) { hv = *p; dd = P.dt[(bh * 8 + sc) * 128 + dk]; }
            *p = s; s = s * dd + hv; }
    }
}
#undef MFMA32
#undef MFMA16
}

__device__ __forceinline__ void p7_combine(const Ptrs& P, int gw, int NGW, int lane) {
    const float s1 = wave_sum(P.lq1[lane] * P.lk1[lane]), s2 = wave_sum(P.lq2[lane] * P.lk2[lane]);
    const float lam = expf(s1) - expf(s2) + LAM_INIT;
    f32x4 nw[4];
#pragma unroll
    for (int q = 0; q < 4; ++q) nw[q] = *(const f32x4*)(P.dnw + ((16 * lane) & 127) + 4 * q) * (1.f - LAM_INIT);
    for (int m = gw; m < T; m += NGW) {
        bf16* rp = P.act + (size_t)m * ACT_LD + 16 * lane;
        const v4u a0 = *(const GAS v4u*)(rp + AC_O1), a1 = *(const GAS v4u*)(rp + AC_O1 + 8), b0 = *(const GAS v4u*)(rp + AC_O2), b1 = *(const GAS v4u*)(rp + AC_O2 + 8);
        float v[16];
        v[0] = bf_lo(a0.x) - lam * bf_lo(b0.x); v[1] = bf_hi(a0.x) - lam * bf_hi(b0.x); v[2] = bf_lo(a0.y) - lam * bf_lo(b0.y); v[3] = bf_hi(a0.y) - lam * bf_hi(b0.y);
        v[4] = bf_lo(a0.z) - lam * bf_lo(b0.z); v[5] = bf_hi(a0.z) - lam * bf_hi(b0.z); v[6] = bf_lo(a0.w) - lam * bf_lo(b0.w); v[7] = bf_hi(a0.w) - lam * bf_hi(b0.w);
        v[8] = bf_lo(a1.x) - lam * bf_lo(b1.x); v[9] = bf_hi(a1.x) - lam * bf_hi(b1.x); v[10] = bf_lo(a1.y) - lam * bf_lo(b1.y); v[11] = bf_hi(a1.y) - lam * bf_hi(b1.y);
        v[12] = bf_lo(a1.z) - lam * bf_lo(b1.z); v[13] = bf_hi(a1.z) - lam * bf_hi(b1.z); v[14] = bf_lo(a1.w) - lam * bf_lo(b1.w); v[15] = bf_hi(a1.w) - lam * bf_hi(b1.w);
        float ss = 0.f;
#pragma unroll
        for (int e = 0; e < 16; ++e) ss += v[e] * v[e];
        ss += __shfl_xor(ss, 1); ss += __shfl_xor(ss, 2); ss += __shfl_xor(ss, 4);
        const float rstd = 1.f / sqrtf(ss * (1.f / 128.f) + RMS_EPS);
        v4u w0, w1;
        w0.x = cvt_pk_bf16(v[0] * rstd * nw[0].x, v[1] * rstd * nw[0].y); w0.y = cvt_pk_bf16(v[2] * rstd * nw[0].z, v[3] * rstd * nw[0].w); w0.z = cvt_pk_bf16(v[4] * rstd * nw[1].x, v[5] * rstd * nw[1].y); w0.w = cvt_pk_bf16(v[6] * rstd * nw[1].z, v[7] * rstd * nw[1].w);
        w1.x = cvt_pk_bf16(v[8] * rstd * nw[2].x, v[9] * rstd * nw[2].y); w1.y = cvt_pk_bf16(v[10] * rstd * nw[2].z, v[11] * rstd * nw[2].w); w1.z = cvt_pk_bf16(v[12] * rstd * nw[3].x, v[13] * rstd * nw[3].y); w1.w = cvt_pk_bf16(v[14] * rstd * nw[3].z, v[15] * rstd * nw[3].w);
        *(GAS v4u*)(rp + AC_ODIFF) = w0; *(GAS v4u*)(rp + AC_ODIFF + 8) = w1;
    }
}

namespace rtr {
constexpr int U_LD = 1032;
constexpr int L_UH = 0, L_UL = 16 * U_LD * 2, L_PART = 2 * 16 * U_LD * 2, L_LOG = L_PART + 8 * 3 * 256 * 4, L_HIST = L_LOG + 16 * 48 * 4, L_LN = L_HIST + 128, L_ADA = L_LN + 2 * D * 4, L_END = L_ADA + 2 * 3 * D * 4;
static_assert(L_END <= RING_BYTES, "router LDS map");
}
__device__ __forceinline__ void p10_ln_router(const Ptrs& P, LAS unsigned char* lds, int vcu, int G, int tid, int lane, int wave) {
    LAS bf16* UH = (LAS bf16*)(lds + RING_OFF + rtr::L_UH); LAS bf16* UL = (LAS bf16*)(lds + RING_OFF + rtr::L_UL);
    LAS float* PART = (LAS float*)(lds + RING_OFF + rtr::L_PART); LAS float* LOG = (LAS float*)(lds + RING_OFF + rtr::L_LOG); LAS int* hist = (LAS int*)(lds + RING_OFF + rtr::L_HIST);
    const int fr = lane & 15, fq = lane >> 4;
    bf16x8 bh[3][4], bl[3][4];
#pragma unroll
    for (int nt = 0; nt < 3; ++nt)
#pragma unroll
        for (int s = 0; s < 4; ++s) { const int n = nt * 16 + fr, k0 = 128 * wave + 32 * s + 8 * fq; unsigned hw[4], lw[4];
#pragma unroll
            for (int j = 0; j < 8; j += 2) { const int ng = n < 4 ? n : 3, ne = n < 4 ? 0 : (n < 36 ? n - 4 : 31);
                const float g0 = P.wrg[(k0 + j) * 4 + ng], g1 = P.wrg[(k0 + j + 1) * 4 + ng], e0 = P.wre[(k0 + j) * 32 + ne], e1 = P.wre[(k0 + j + 1) * 32 + ne];
                const float w0 = n < 4 ? g0 : (n < 36 ? e0 : 0.f), w1 = n < 4 ? g1 : (n < 36 ? e1 : 0.f);
                const unsigned h = cvt_pk_bf16(w0, w1); hw[j >> 1] = h; lw[j >> 1] = cvt_pk_bf16(w0 - bf_lo(h), w1 - bf_hi(h)); }
            bh[nt][s] = __builtin_bit_cast(bf16x8, (v4u){hw[0], hw[1], hw[2], hw[3]}); bl[nt][s] = __builtin_bit_cast(bf16x8, (v4u){lw[0], lw[1], lw[2], lw[3]}); }
    if (tid < 32) hist[tid] = 0;
    LAS f32x4* LNV = (LAS f32x4*)(lds + RING_OFF + rtr::L_LN); LAS f32x4* ADV = (LAS f32x4*)(lds + RING_OFF + rtr::L_ADA);
    LNV[tid] = tid < 256 ? *((const f32x4*)P.ln1w + tid) : *((const f32x4*)P.ln1b + (tid - 256));
    if (vcu < T / 16) { const f32x4* ap = (const f32x4*)(P.ada + (size_t)((vcu * 16) / SEQ) * 6 * D + 2 * D); ADV[tid] = ap[tid]; if (tid < 256) ADV[512 + tid] = ap[512 + tid]; }
    LBAR();
    int abuf = 0;
    f32x4 pre[2][4]; v2u prey[2][4];
    if (vcu < T / 16) {
#pragma unroll
        for (int rr = 0; rr < 2; ++rr) { const size_t m_ = (size_t)(vcu * 16 + wave * 2 + rr); const GAS f32x4* xr = (const GAS f32x4*)(P.x + m_ * D) + lane; const GAS v2u* yr = (const GAS v2u*)(P.act + m_ * ACT_LD + AC_Y) + lane;
#pragma unroll
            for (int j = 0; j < 4; ++j) { pre[rr][j] = xr[64 * j]; prey[rr][j] = yr[64 * j]; } } }
#ifndef RPROBE_K
#define RPROBE_K -1
#endif
    unsigned long long racc = 0ull, rt0 = 0ull; const bool rstamp = RPROBE_K >= 0 && blockIdx.x == 0 && tid == 0;
#define RST(k_) do { if (rstamp) { const unsigned long long t_ = __builtin_amdgcn_s_memrealtime(); if ((k_) == RPROBE_K) rt0 = t_; if ((k_) == RPROBE_K + 1) racc += t_ - rt0; } } while (0)
    for (int batch = vcu; batch < T / 16; batch += G) {
        RST(0);
        f32x4 adn0 = (f32x4){0.f, 0.f, 0.f, 0.f}, adn1 = adn0;
        if (batch + G < T / 16) { const f32x4* ap = (const f32x4*)(P.ada + (size_t)(((batch + G) * 16) / SEQ) * 6 * D + 2 * D); adn0 = ap[tid]; if (tid < 256) adn1 = ap[512 + tid]; }
#pragma unroll
        for (int rr = 0; rr < 2; ++rr) {
            const int rl = wave * 2 + rr, m = batch * 16 + rl, b = m / SEQ;
            GAS f32x4* xr = (GAS f32x4*)(P.out + (size_t)m * D) + lane;
            f32x4 v[4]; float s = 0.f;
#pragma unroll
            for (int j = 0; j < 4; ++j) { const f32x4 g1 = ADV[abuf * 768 + lane + 64 * j]; const v2u yv = prey[rr][j];
                v[j] = pre[rr][j] * ALPHA + g1 * (f32x4){bf_lo(yv.x), bf_hi(yv.x), bf_lo(yv.y), bf_hi(yv.y)}; s += (v[j].x + v[j].y) + (v[j].z + v[j].w); }
            float mean = wave_sum(s) * (1.f / D), s2 = 0.f;
#pragma unroll
            for (int j = 0; j < 4; ++j) { v[j] = v[j] - mean; s2 += dot4(v[j], v[j]); }
            float rstd = 1.f / sqrtf(wave_sum(s2) * (1.f / D) + LN_EPS);
            s = 0.f;
#pragma unroll
            for (int j = 0; j < 4; ++j) { const f32x4 w = LNV[lane + 64 * j], bb = LNV[256 + lane + 64 * j]; v[j] = v[j] * rstd * w + bb; xr[64 * j] = v[j]; s += (v[j].x + v[j].y) + (v[j].z + v[j].w); }
            mean = wave_sum(s) * (1.f / D); s2 = 0.f;
#pragma unroll
            for (int j = 0; j < 4; ++j) { v[j] = v[j] - mean; s2 += dot4(v[j], v[j]); }
            rstd = 1.f / sqrtf(wave_sum(s2) * (1.f / D) + LN_EPS);
            const LAS f32x4* sh = ADV + abuf * 768 + 256 + lane; const LAS f32x4* sl = ADV + abuf * 768 + 512 + lane;
            GAS v2u* o8 = (GAS v2u*)(P.u + (size_t)m * D) + lane;
#pragma unroll
            for (int j = 0; j < 4; ++j) { const f32x4 a = sh[64 * j], c = sl[64 * j]; const f32x4 uu = v[j] * rstd * (c + 1.f) + a;
                v2u hw; hw.x = cvt_pk_bf16(uu.x, uu.y); hw.y = cvt_pk_bf16(uu.z, uu.w); o8[64 * j] = hw;
                v2u lw; lw.x = cvt_pk_bf16(uu.x - bf_lo(hw.x), uu.y - bf_hi(hw.x)); lw.y = cvt_pk_bf16(uu.z - bf_lo(hw.y), uu.w - bf_hi(hw.y));
                *(LAS v2u*)(UH + rl * rtr::U_LD + 4 * lane + 256 * j) = hw; *(LAS v2u*)(UL + rl * rtr::U_LD + 4 * lane + 256 * j) = lw; }
        }
        if (batch + G < T / 16) {
#pragma unroll
            for (int rr = 0; rr < 2; ++rr) { const size_t m_ = (size_t)((batch + G) * 16 + wave * 2 + rr); const GAS f32x4* xr = (const GAS f32x4*)(P.x + m_ * D) + lane; const GAS v2u* yr = (const GAS v2u*)(P.act + m_ * ACT_LD + AC_Y) + lane;
#pragma unroll
                for (int j = 0; j < 4; ++j) { pre[rr][j] = xr[64 * j]; prey[rr][j] = yr[64 * j]; } }
            ADV[(abuf ^ 1) * 768 + tid] = adn0; if (tid < 256) ADV[(abuf ^ 1) * 768 + 512 + tid] = adn1; }
        abuf ^= 1;
        LBAR();
        RST(1);
        f32x4 acc[3];
#pragma unroll
        for (int nt = 0; nt < 3; ++nt) acc[nt] = (f32x4){0.f, 0.f, 0.f, 0.f};
#pragma unroll
        for (int s = 0; s < 4; ++s) { const int kk = 128 * wave + 32 * s + 8 * fq;
            const bf16x8 ah = *(const LAS bf16x8*)(UH + fr * rtr::U_LD + kk), al = *(const LAS bf16x8*)(UL + fr * rtr::U_LD + kk);
#pragma unroll
            for (int nt = 0; nt < 3; ++nt) { acc[nt] = __builtin_amdgcn_mfma_f32_16x16x32_bf16(ah, bh[nt][s], acc[nt], 0, 0, 0); acc[nt] = __builtin_amdgcn_mfma_f32_16x16x32_bf16(ah, bl[nt][s], acc[nt], 0, 0, 0);
                acc[nt] = __builtin_amdgcn_mfma_f32_16x16x32_bf16(al, bh[nt][s], acc[nt], 0, 0, 0); } }
#pragma unroll
        for (int nt = 0; nt < 3; ++nt)
#pragma unroll
            for (int g = 0; g < 4; ++g) PART[(wave * 3 + nt) * 256 + (4 * fq + g) * 16 + fr] = acc[nt][g];
        LBAR();
        RST(2);
        { const int row = tid >> 5, c = tid & 31;
#pragma unroll
            for (int hf = 0; hf < 2; ++hf) { const int cc = c + 32 * hf; if (cc < 48) { const int nt = cc >> 4, ci = cc & 15; float sm = 0.f;
#pragma unroll
                for (int w = 0; w < 8; ++w) sm += PART[(w * 3 + nt) * 256 + row * 16 + ci];
                LOG[row * 48 + cc] = sm; } } }
        LBAR();
        RST(3);
        if (tid < 16) { const int m = batch * 16 + tid; const LAS float* lgs = LOG + tid * 48;
            float lg[4], le[32];
#pragma unroll
            for (int c = 0; c < 4; ++c) lg[c] = lgs[c] + P.brg[c];
#pragma unroll
            for (int c = 0; c < 32; ++c) le[c] = lgs[4 + c] + P.bre[c];
            int g = 0; float gm = lg[0];
#pragma unroll
            for (int c = 1; c < 4; ++c) if (lg[c] > gm) { gm = lg[c]; g = c; }
            float gs = 0.f;
#pragma unroll
            for (int c = 0; c < 4; ++c) gs += expf(lg[c] - gm);
            const float wgrp = 1.f / gs;
            float es[8];
#pragma unroll
            for (int i = 0; i < 8; ++i) es[i] = g == 0 ? le[i] : (g == 1 ? le[8 + i] : (g == 2 ? le[16 + i] : le[24 + i]));
            int i0 = 0; float v0 = es[0];
#pragma unroll
            for (int i = 1; i < 8; ++i) if (es[i] > v0) { v0 = es[i]; i0 = i; }
            int i1 = -1; float v1 = -INFINITY;
#pragma unroll
            for (int i = 0; i < 8; ++i) if (i != i0 && es[i] > v1) { v1 = es[i]; i1 = i; }
            const float p1 = 1.f / (1.f + expf(v0 - v1)), p0 = 1.f - p1;
            const int e0 = g * 8 + i0, e1 = g * 8 + i1;
            P.toke[2 * m] = e0; P.toke[2 * m + 1] = e1; P.tokw[2 * m] = wgrp * p0; P.tokw[2 * m + 1] = wgrp * p1;
            __hip_atomic_fetch_add(hist + e0, 1, __ATOMIC_RELAXED, __HIP_MEMORY_SCOPE_WORKGROUP); __hip_atomic_fetch_add(hist + e1, 1, __ATOMIC_RELAXED, __HIP_MEMORY_SCOPE_WORKGROUP); }
        RST(4);
    }
    if (rstamp) __hip_atomic_store(P.dbg, (unsigned)racc, RLX_AGENT);
#undef RST
    LBAR();
    if (tid < 32) P.cnt[vcu * 32 + tid] = hist[tid];
}

__device__ __forceinline__ void p11_dispatch(const Ptrs& P, LAS unsigned char* lds, int vcu, int G, int tid, int lane) {
    LAS int* tot = (LAS int*)(lds + RING_OFF); LAS int* base = tot + 32; LAS int* cur = tot + 64; LAS int* pst = tot + 96;
    LAS int* CL = (LAS int*)(lds + RING_OFF + 1024);
    LAS int* PS = (LAS int*)(lds + RING_OFF + 1024 + 512 * 32 * 4);
    for (int i = tid; i < G * 32; i += NWAVES * 64) CL[i] = P.cnt[i];
    __syncthreads();
    { const int e = tid & 31, g = tid >> 5, per = (G + 15) / 16; int sm = 0;
        for (int w = g * per; w < (g + 1) * per && w < G; ++w) sm += CL[w * 32 + e];
        PS[g * 32 + e] = sm; }
    __syncthreads();
    if (tid < 32) { const int per = (G + 15) / 16, gm = vcu / per; int total = 0, mine = 0;
#pragma unroll
        for (int g = 0; g < 16; ++g) { const int c = PS[g * 32 + tid]; total += c; mine += (g < gm) ? c : 0; }
        for (int w = gm * per; w < vcu; ++w) mine += CL[w * 32 + tid];
        tot[tid] = total; base[tid] = mine; cur[tid] = 0; }
    __syncthreads();
    if (tid == 0) { int p = 0, nt = 0;
        for (int e = 0; e < 32; ++e) { pst[e] = p; const int nte = (tot[e] + 255) >> 8;
            for (int k = 0; k < nte; ++k) { if (vcu == 0) { P.tab[1 + nt] = e; P.tab[1 + pg8::TILE_MAX + nt] = p + 256 * k; } ++nt; }
            p += nte * 256; }
        pst[32] = p; if (vcu == 0) P.tab[0] = nt; }
    __syncthreads();
    const int nb = (T / 16 - vcu + G - 1) / G;
    for (int idx = tid; idx < nb * 32; idx += NWAVES * 64) { const int bi = idx >> 5, pr = idx & 31, ts = ((vcu + G * bi) * 16) * 2 + pr;
        const int e = P.toke[ts]; const int pos = pst[e] + base[e] + __hip_atomic_fetch_add(cur + e, 1, __ATOMIC_RELAXED, __HIP_MEMORY_SCOPE_WORKGROUP);
        P.rowtok[pos] = ts; P.roww[pos] = P.tokw[ts]; }
    if (vcu < 32) { const int e = vcu, lim = pst[e + 1] - pst[e];
        for (int r = tot[e] + tid; r < lim; r += NWAVES * 64) { P.rowtok[pst[e] + r] = -1; P.roww[pst[e] + r] = 0.f; } }
}

__device__ __forceinline__ void p14_final(const Ptrs& P, int gw, int NGW, int lane, float dscale) {
    f32x4 lw[4], lb[4];
#pragma unroll
    for (int j = 0; j < 4; ++j) { lw[j] = *((const f32x4*)P.ln2w + lane + 64 * j) * dscale; lb[j] = *((const f32x4*)P.ln2b + lane + 64 * j) * dscale; }
    for (int blk = gw; blk < T / 16; blk += NGW) {
        const int m0 = blk * 16, b = m0 / SEQ;
        f32x4 g2[4];
#pragma unroll
        for (int j = 0; j < 4; ++j) g2[j] = *((const f32x4*)(P.ada + (size_t)b * 6 * D + 5 * D) + lane + 64 * j);
        f32x4 px[2][4]; v2u pa[2][4], pc[2][4];
#define P14_LOAD(slot_, m_) do { const GAS f32x4* xr_ = (const GAS f32x4*)(P.out + (size_t)(m_) * D) + lane; \
            const GAS v2u* q0_ = (const GAS v2u*)(P.mout + (size_t)(2 * (m_)) * D) + lane; const GAS v2u* q1_ = (const GAS v2u*)(P.mout + (size_t)(2 * (m_) + 1) * D) + lane; \
            _Pragma("unroll") for (int j = 0; j < 4; ++j) { px[slot_][j] = xr_[64 * j]; pa[slot_][j] = q0_[64 * j]; pc[slot_][j] = q1_[64 * j]; } } while (0)
        P14_LOAD(0, m0); P14_LOAD(1, m0 + 1);
#define P14_ROW(sl_, m_, more_) do { const int m = (m_); f32x4 v[4]; float s = 0.f; \
            _Pragma("unroll") for (int j = 0; j < 4; ++j) { const v2u a = pa[sl_][j], c = pc[sl_][j]; const f32x4 mm = (f32x4){bf_lo(a.x) + bf_lo(c.x), bf_hi(a.x) + bf_hi(c.x), bf_lo(a.y) + bf_lo(c.y), bf_hi(a.y) + bf_hi(c.y)}; \
                v[j] = px[sl_][j] * ALPHA + g2[j] * mm; s += (v[j].x + v[j].y) + (v[j].z + v[j].w); } \
            if (more_) P14_LOAD(sl_, m + 2); \
            const float mean = wave_sum(s) * (1.f / D); float s2 = 0.f; \
            _Pragma("unroll") for (int j = 0; j < 4; ++j) { v[j] = v[j] - mean; s2 += dot4(v[j], v[j]); } \
            const float rstd = 1.f / sqrtf(wave_sum(s2) * (1.f / D) + LN_EPS); \
            GAS f32x4* xr = (GAS f32x4*)(P.out + (size_t)m * D) + lane; \
            _Pragma("unroll") for (int j = 0; j < 4; ++j) xr[64 * j] = v[j] * rstd * lw[j] + lb[j]; } while (0)
#pragma unroll 1
        for (int rp = 0; rp < 8; ++rp) { P14_ROW(0, m0 + 2 * rp, rp < 7); P14_ROW(1, m0 + 2 * rp + 1, rp < 7); }
#undef P14_ROW
#undef P14_LOAD
    }
}

constexpr int NPH = 15;
constexpr int N_LAUNCHES = MK_N_LAUNCHES;
static_assert(N_LAUNCHES == 1 || N_LAUNCHES == NPH, "MK_N_LAUNCHES is 1 or 15");
struct Args { const void* in[26]; float* out; unsigned char* ws; int ph_lo, ph_hi; };
__global__ void __launch_bounds__(NWAVES * 64, 2) fwd_kernel(Args args) {
    extern __shared__ __attribute__((aligned(16))) unsigned char lds_raw[];
    LAS unsigned char* lds = (LAS unsigned char*)lds_raw;
    volatile LAS unsigned* MISC = (volatile LAS unsigned*)(lds + MISC_OFF);
    const int tid = threadIdx.x, lane = tid & 63, wave = __builtin_amdgcn_readfirstlane(tid >> 6);
    const int G = gridDim.x; const int bx = blockIdx.x; const int vcu = (G % 8 == 0) ? (bx % 8) * (G / 8) + bx / 8 : bx;
    const int gw = vcu * NWAVES + wave, NGW = G * NWAVES;
    unsigned char* ws = args.ws;
    gu32* ctl = (gu32*)(ws + WS_CTL);
    Ptrs P;
    P.x = (const float*)args.in[0]; P.c = (const float*)args.in[1]; P.pos = (const int*)args.in[2]; P.w_ada = (const float*)args.in[3]; P.b_ada = (const float*)args.in[4]; P.w_in = (const float*)args.in[5];
    P.wg2 = (const float*)args.in[6]; P.bg2 = (const float*)args.in[7]; P.gnw = (const float*)args.in[8]; P.lq1 = (const float*)args.in[9]; P.lk1 = (const float*)args.in[10]; P.lq2 = (const float*)args.in[11]; P.lk2 = (const float*)args.in[12];
    P.dnw = (const float*)args.in[13]; P.w_out = (const float*)args.in[14]; P.ln1w = (const float*)args.in[15]; P.ln1b = (const float*)args.in[16]; P.wrg = (const float*)args.in[17]; P.brg = (const float*)args.in[18];
    P.wre = (const float*)args.in[19]; P.bre = (const float*)args.in[20]; P.weg = (const float*)args.in[21]; P.weu = (const float*)args.in[22]; P.wed = (const float*)args.in[23]; P.ln2w = (const float*)args.in[24]; P.ln2b = (const float*)args.in[25];
    P.out = args.out;
    P.ada = (float*)(ws + WS_ADA); P.wrt = (float*)(ws + WS_WRT); P.tokw = (float*)(ws + WS_TOKW); P.roww = (float*)(ws + WS_ROWW); P.dt = (float*)(ws + WS_DT); P.hst = (float*)(ws + WS_HST);
    P.cnt = (int*)(ws + WS_CNT); P.tab = (int*)(ws + WS_TAB); P.toke = (int*)(ws + WS_TOKE); P.rowtok = (int*)(ws + WS_ROWTOK);
    P.win = (bf16*)(ws + WS_WIN); P.wmg = (bf16*)(ws + WS_WMG); P.wout = (bf16*)(ws + WS_WOUT); P.wgu = (bf16*)(ws + WS_WGU); P.wd = (bf16*)(ws + WS_WD); P.u = (bf16*)(ws + WS_U); P.act = (bf16*)(ws + WS_ACT);
    P.hbuf = (bf16*)(ws + WS_HBUF); P.mout = (bf16*)(ws + WS_MOUT); P.dqk = (bf16*)args.out;
    P.dbg = (unsigned*)(ctl + 2); P.gates = ws + WS_GATES;
    for (int u = tid; u < (LDS_BYTES - LDSCTL_OFF) / 4; u += NWAVES * 64) ((LAS unsigned*)(lds + LDSCTL_OFF))[u] = 0u;
    __syncthreads();
    XcdBarrier bar; bar.bar = (unsigned*)(ctl + CW_BAR); bar.x = 0; bar.st = nullptr;
    if (N_LAUNCHES == 1) bar = xcd_barrier_post((unsigned*)(ctl + CW_BAR), MISC + 8);
#define GRID_BAR() do { if (N_LAUNCHES == 1) xcd_barrier(bar); } while (0)
    const int lo = args.ph_lo, hi = args.ph_hi;
#ifndef PHASE_MASK
#define PHASE_MASK 0x7fff
#endif
#define IN(k) ((((PHASE_MASK) >> (k)) & 1) && lo <= (k) && (k) < hi)
#ifndef TPROBE_K
#define TPROBE_K -1
#endif
    unsigned long long tp0 = 0ull;
#define TP_BEGIN(k) do { if ((k) == TPROBE_K && bx == 0 && tid == 0) tp0 = __builtin_amdgcn_s_memrealtime(); } while (0)
#define SEAM(k) do { if (IN(k) && IN((k) + 1)) GRID_BAR(); if ((k) == TPROBE_K && bx == 0 && tid == 0) __hip_atomic_store(ctl + 2, (unsigned)(__builtin_amdgcn_s_memrealtime() - tp0), RLX_AGENT); } while (0)
#ifndef REP_MASK
#define REP_MASK 0
#endif
#define PHASE(k, ...) do { if (IN(k)) { __VA_ARGS__ if (((REP_MASK) >> (k)) & 1) { GRID_BAR(); __VA_ARGS__ } } } while (0)

    TP_BEGIN(0);
    PHASE(0, p0_prologue(P, lds, vcu, G, tid, lane, wave); __syncthreads(); );
    SEAM(0);
    TP_BEGIN(1);
    PHASE(1, p1_ln_mod(P, lds, gw, NGW, lane, wave); __syncthreads(); );
    SEAM(1);
    TP_BEGIN(2);
    PHASE(2,
        pg8::DenseProb Q; Q.init(P.u, D, P.win, T, N1, D, G, bx);
        pg8::EpiProj E{P.act, P.dqk, P.pos, P.gates};
        pg8::gemm_phase<pg8::EpiProj, pg8::DenseProb, true, true>(lds + RING_OFF, Q, E);
    );
    SEAM(2);
    TP_BEGIN(3);
    PHASE(3, for (int u = vcu; u < 256; u += G) { const int b = u >> 5, h = (u >> 3) & 3, sc = u & 7; if (sc < 7) gla::gla_unit<false>(lds + RING_OFF, P, b, h, sc); } );
    SEAM(3);
    TP_BEGIN(4);
    PHASE(4, gla::gla_scan(P, vcu * (NWAVES * 64) + tid, G * NWAVES * 64); );
    SEAM(4);
    TP_BEGIN(5);
    PHASE(5, for (int u = vcu; u < 256; u += G) { const int b = u >> 5, h = (u >> 3) & 3, sc = u & 7; gla::gla_unit<true>(lds + RING_OFF, P, b, h, sc); } );
    SEAM(5);
    TP_BEGIN(6);
    PHASE(6,
        const attn_body::AttnTensors AT{(const attn_body::bf16*)P.dqk, (const attn_body::bf16*)P.act, (attn_body::bf16*)P.act};
        const attn_body::StaticOrder S(G, vcu);
        const float lam = expf(wave_sum(P.lq1[lane] * P.lk1[lane])) - expf(wave_sum(P.lq2[lane] * P.lk2[lane])) + LAM_INIT;
        LAS float* nws = (LAS float*)(lds + LDSCTL_OFF + 512);
        if (tid < 128) nws[tid] = P.dnw[tid] * (1.f - LAM_INIT);
        __syncthreads();
        attn_body::attn_phase<attn_body::StaticOrder>((char*)lds_raw + RING_OFF, AT, S, AC_DV, AC_ODIFF, AC_OGLA, P.gates, lam, (const float*)((char*)lds_raw + LDSCTL_OFF + 512));
    );
    SEAM(6);
    TP_BEGIN(9);
    PHASE(9,
        pg8::DenseProb Q; Q.init(P.act + AC_OGLA, ACT_LD, P.wout, T, D, D, G, bx);
        pg8::EpiY E{P.act};
        pg8::gemm_phase<pg8::EpiY, pg8::DenseProb, true, true>(lds + RING_OFF, Q, E);
    );
    SEAM(9);
    TP_BEGIN(10);
    PHASE(10, p10_ln_router(P, lds, vcu, G, tid, lane, wave); __syncthreads(); );
    SEAM(10);
    TP_BEGIN(11);
    PHASE(11, transpose_items(P, lds, gw, NGW, lane, wave, TI_DENSE, TI_ALL); __syncthreads();
              p11_dispatch(P, lds, vcu, G, tid, lane); __syncthreads(); );
    SEAM(11);
    TP_BEGIN(12);
    PHASE(12,
        LAS int* rows = (LAS int*)(lds + ROWS_OFF); LAS int* ltab = (LAS int*)(lds + TAB_OFF);
        for (int i = tid; i < 1 + 2 * pg8::TILE_MAX; i += NWAVES * 64) ltab[i] = P.tab[i];
        __syncthreads();
        pg8::MoeProb<true> Q; Q.A = (const char*)P.u; Q.Bt = (const char*)P.wgu; Q.lda = D; Q.K = D; Q.G = G; Q.c = vcu; Q.tab = ltab; Q.rows = rows; Q.bstride = (size_t)1024 * D * 2;
        {
            int nun = 0; { pg8::Unit un; while (nun < 8 && Q.next(nun, un)) ++nun; }
            for (int idx = tid; idx < nun * 256; idx += NWAVES * 64) { const int i = idx >> 8; const int t = (i * G + vcu) >> 2; const int rt = P.rowtok[ltab[1 + pg8::TILE_MAX + t] + (idx & 255)]; rows[idx] = rt < 0 ? 0 : (rt >> 1); } }
        __syncthreads();
        pg8::EpiUp E{P.hbuf};
        pg8::gemm_phase<pg8::EpiUp, pg8::MoeProb<true>, true>(lds + RING_OFF, Q, E);
    );
    SEAM(12);
    TP_BEGIN(13);
    PHASE(13,
        LAS int* ltab = (LAS int*)(lds + TAB_OFF);
        for (int i = tid; i < 1 + 2 * pg8::TILE_MAX; i += NWAVES * 64) ltab[i] = P.tab[i];
        __syncthreads();
        pg8::MoeProb<false> Q; Q.A = (const char*)P.hbuf; Q.Bt = (const char*)P.wd; Q.lda = FF; Q.K = FF; Q.G = G; Q.c = vcu; Q.tab = ltab; Q.rows = nullptr; Q.bstride = (size_t)D * FF * 2;
        pg8::EpiDown E{P.mout, P.rowtok, P.roww};
        pg8::gemm_phase<pg8::EpiDown, pg8::MoeProb<false>, true, true>(lds + RING_OFF, Q, E);
    );
    SEAM(13);
    TP_BEGIN(14);
    PHASE(14, p14_final(P, gw, NGW, lane, (TPROBE_K >= 0 || GPROBE_K >= 0 || P0PROBE || RPROBE_K >= 0) ? 1.f + (float)__hip_atomic_load(ctl + 2, RLX_AGENT) * 1e-6f : 1.f); );
#undef IN
#undef SEAM
#undef GRID_BAR
}

extern "C" void kernel_launch(void* const* d_in, const int* in_sizes, int n_in, void* d_out, int out_size, void* d_ws, size_t ws_size, hipStream_t stream) {
    static int grid = 0;
    if (grid == 0) {
        if (n_in != 26 || in_sizes[0] != T * D || out_size != T * D || ws_size < WS_END) { fprintf(stderr, "kernel_launch: unexpected shapes (n_in %d, in0 %d, out %d, ws %zu < %zu); nothing launched\n", n_in, n_in > 0 ? in_sizes[0] : -1, out_size, ws_size, (size_t)WS_END); grid = -1; return; }
        int dev = 0, cus = 0, per_cu = 0;
        if (hipGetDevice(&dev) != hipSuccess || hipDeviceGetAttribute(&cus, hipDeviceAttributeMultiprocessorCount, dev) != hipSuccess) { fprintf(stderr, "kernel_launch: device query failed\n"); grid = -1; return; }
        if (hipFuncSetAttribute((const void*)fwd_kernel, hipFuncAttributeMaxDynamicSharedMemorySize, LDS_BYTES) != hipSuccess) { fprintf(stderr, "kernel_launch: hipFuncSetAttribute failed\n"); grid = -1; return; }
        if (hipOccupancyMaxActiveBlocksPerMultiprocessor(&per_cu, (const void*)fwd_kernel, NWAVES * 64, LDS_BYTES) != hipSuccess || per_cu < 1)
            fprintf(stderr, "kernel_launch: note: occupancy query reports %d workgroups per CU\n", per_cu);
        (void)hipGetLastError();
        grid = cus;
    }
    if (grid < 0) return;
    if (hipMemsetAsync((char*)d_ws + WS_CTL, 0, CTL_ZERO_BYTES, stream) != hipSuccess) { fprintf(stderr, "kernel_launch: hipMemsetAsync failed\n"); return; }
    Args a{};
    for (int i = 0; i < 26; ++i) a.in[i] = d_in[i];
    a.out = (float*)d_out; a.ws = (unsigned char*)d_ws;
    for (int li = 0; li < N_LAUNCHES; ++li) {
        a.ph_lo = (N_LAUNCHES == 1) ? 0 : li; a.ph_hi = (N_LAUNCHES == 1) ? NPH : li + 1;
        hipLaunchKernelGGL(fwd_kernel, dim3(grid), dim3(NWAVES * 64), LDS_BYTES, stream, a);
        const hipError_t le = hipPeekAtLastError();
        if (le != hipSuccess) { fprintf(stderr, "kernel_launch: launch %d failed: %s\n", li, hipGetErrorName(le)); break; }
    }
}
```

```cpp
#include <hip/hip_runtime.h>
#include <hip/hip_bf16.h>
#include <cstdio>
#include <cstdint>
#include <cmath>

#ifndef MK_N_LAUNCHES
#define MK_N_LAUNCHES 1
#endif

namespace pg8 {
#define PG8_LAS __attribute__((address_space(3)))
typedef unsigned short bf16_t;
typedef short bf16x8 __attribute__((ext_vector_type(8)));
typedef float f32x4 __attribute__((ext_vector_type(4)));
typedef float f32x2 __attribute__((ext_vector_type(2)));
typedef unsigned u32x4 __attribute__((ext_vector_type(4)));
typedef unsigned u32x2 __attribute__((ext_vector_type(2)));
constexpr int BM = 256, BK = 64, HALF = 128, HTB = HALF * BK * 2  , STAGE_BYTES = 8 * HTB, NXCD = 8, WGM = 8;

__host__ __device__ __forceinline__ int lds_byte(int r, int c) { const int st = (r >> 4) * 2 + (c >> 5), rr = r & 15, cc = c & 31, ob = rr * 64 + cc * 2; return st * 1024 + (ob ^ (((ob >> 9) & 1) << 5)); }
__host__ __device__ __forceinline__ void stage_rc(int b, int& R, int& C) { const int st = b / 1024, sb = b % 1024, swz = sb ^ (((sb >> 9) & 1) << 5); R = (st >> 1) * 16 + swz / 64; C = (st & 1) * 32 + (swz % 64) / 2; }
__host__ __device__ __forceinline__ int perm32(int rho) { const int n = rho >> 4, i = rho & 15; return 8 * (i >> 2) + 4 * n + (i & 3); }

struct Unit { int pm, pn, e, row0; };

struct DenseProb {
    const char* A; const char* Bt; int lda, K; int nM, nN, nwg, G, c;
    __device__ __forceinline__ void init(const void* A_, int lda_, const void* Bt_, int M, int N, int K_, int G_, int c_) { A = (const char*)A_; Bt = (const char*)Bt_; lda = lda_; K = K_; nM = M / BM; nN = N / BM; nwg = nM * nN; G = G_; c = c_; }
    __device__ __forceinline__ bool next(int i, Unit& u) const {
        const long L = (long)i * G + c; if (L >= nwg) return false;
        int wgid = (int)L; { const int q = nwg / NXCD, r = nwg % NXCD, xcd = wgid % NXCD, off = wgid / NXCD; wgid = (xcd < r ? xcd * (q + 1) : r * (q + 1) + (xcd - r) * q) + off; }
        const int nig = WGM * nN, gid = wgid / nig, fm = gid * WGM, gsz = (nM - fm) < WGM ? (nM - fm) : WGM;
        u.pm = fm + ((wgid % nig) % gsz); u.pn = (wgid % nig) / gsz; u.e = 0; u.row0 = u.pm * BM; return true;
    }
    __device__ __forceinline__ void a_voff(const Unit& u, const int (&R)[2], const int (&C)[2], unsigned (&v)[4]) const {
#pragma unroll
        for (int h = 0; h < 2; ++h)
#pragma unroll
            for (int i = 0; i < 2; ++i) v[h * 2 + i] = (unsigned)((u.row0 + h * HALF + R[i]) * lda + C[i]) * 2u;
    }
    __device__ __forceinline__ size_t b_off(const Unit& u) const { return (size_t)u.pn * BM * K * 2; }
};

__device__ __forceinline__ unsigned cvt_pk_bf16(float lo, float hi) { typedef __bf16 bf16x2_t __attribute__((ext_vector_type(2))); f32x2 v = {lo, hi}; bf16x2_t b = __builtin_convertvector(v, bf16x2_t); return __builtin_bit_cast(unsigned, b); }
__device__ __forceinline__ float bf_lo(unsigned w) { return __uint_as_float(w << 16); }
__device__ __forceinline__ float bf_hi(unsigned w) { return __uint_as_float(w & 0xffff0000u); }
__device__ __forceinline__ float sigmoidf_(float x) { return __builtin_amdgcn_rcpf(1.f + __builtin_amdgcn_exp2f(x * -1.4426950408889634f)); }

template <class Epi, class Prob, bool ALIGN_EPI>
__device__ __forceinline__ void gemm_phase(PG8_LAS unsigned char* lds, const Prob& P, const Epi& E) {
    const int tid = threadIdx.x, wid = __builtin_amdgcn_readfirstlane(tid >> 6), lane = tid & 63, wr = wid >> 2, wc = wid & 3, fr = lane & 15, fq = lane >> 4;
    const int K = P.K, nt = K / BK;
    int sR[2], sC[2]; unsigned voffB[2];
#pragma unroll
    for (int i = 0; i < 2; ++i) { int R, C; stage_rc(tid * 16 + i * 8192, R, C); const int Rb = (R & ~31) + perm32(R & 31); sR[i] = R; sC[i] = C; voffB[i] = (unsigned)(Rb * K + C) * 2u; }
    const size_t kstep = (size_t)(BK * 2);
    const size_t hstepB = (size_t)HALF * K * 2;
    const unsigned ldsw = (unsigned)wid * 1024u;
    const int aoff = lds_byte(wr * 64 + fr, fq * 8), boff = lds_byte(wc * 32 + fr, fq * 8);
#define PG8_SA(b, h) (((b) * 2 + (h)) * HTB)
#define PG8_SB(b, h) ((4 + (b) * 2 + (h)) * HTB)
#define PG8_STAGE(bufoff, gbase, voff) do { _Pragma("unroll") for (int _i = 0; _i < 2; ++_i) \
        __builtin_amdgcn_global_load_lds((const unsigned*)((const char*)(gbase) + (voff)[_i]), (PG8_LAS unsigned*)(lds + (bufoff) + ldsw + _i * 8192), 16, 0, 0); } while (0)
#define PG8_STAGE_A(bufoff, kofs, V, h) do { _Pragma("unroll") for (int _i = 0; _i < 2; ++_i) \
        __builtin_amdgcn_global_load_lds((const unsigned*)(P.A + (kofs) + (V)[(h) * 2 + _i]), (PG8_LAS unsigned*)(lds + (bufoff) + ldsw + _i * 8192), 16, 0, 0); } while (0)
#define PG8_LDA(dst, b, h) do { _Pragma("unroll") for (int m = 0; m < 4; ++m) _Pragma("unroll") for (int k = 0; k < 2; ++k) dst[m][k] = *(const PG8_LAS bf16x8*)(lds + PG8_SA(b, h) + aoff + m * 2048 + k * 1024); } while (0)
#define PG8_LDB(dst, b, h) do { _Pragma("unroll") for (int n = 0; n < 2; ++n) _Pragma("unroll") for (int k = 0; k < 2; ++k) dst[n][k] = *(const PG8_LAS bf16x8*)(lds + PG8_SB(b, h) + boff + n * 2048 + k * 1024); } while (0)
#define PG8_MMA(ai, bj, At, Bt) do { __builtin_amdgcn_s_setprio(1); _Pragma("unroll") for (int m = 0; m < 4; ++m) _Pragma("unroll") for (int n = 0; n < 2; ++n) _Pragma("unroll") for (int k = 0; k < 2; ++k) \
        acc[ai][bj][m][n] = __builtin_amdgcn_mfma_f32_16x16x32_bf16(Bt[n][k], At[m][k], acc[ai][bj][m][n], 0, 0, 0); __builtin_amdgcn_s_setprio(0); } while (0)
#define PG8_WAIT_V(n) asm volatile("s_waitcnt vmcnt(" #n ")" ::: "memory")
#define PG8_WAIT_L(n) asm volatile("s_waitcnt lgkmcnt(" #n ")" ::: "memory")
#define PG8_BAR __builtin_amdgcn_s_barrier()
#define PG8_SCHED __builtin_amdgcn_sched_barrier(0)
    Unit cur, nxt; int ui = 0;
    if (!P.next(0, cur)) return;
    f32x4 acc[2][2][4][2];
#pragma unroll
    for (int a = 0; a < 2; ++a)
#pragma unroll
        for (int b = 0; b < 2; ++b)
#pragma unroll
            for (int m = 0; m < 4; ++m)
#pragma unroll
                for (int n = 0; n < 2; ++n) acc[a][b][m][n] = (f32x4){0.f, 0.f, 0.f, 0.f};
    bf16x8 At[4][2], B0[2][2], B1[2][2];
    unsigned vc[4], vn[4];
    P.a_voff(cur, sR, sC, vc);
    const char* cB = P.Bt + P.b_off(cur);
    PG8_STAGE(PG8_SB(0, 0), cB, voffB); PG8_STAGE(PG8_SB(0, 1), cB + hstepB, voffB); PG8_STAGE_A(PG8_SA(0, 0), 0, vc, 0); PG8_STAGE_A(PG8_SA(0, 1), 0, vc, 1);
    if (wr == 1) PG8_BAR;
    PG8_WAIT_V(2); PG8_BAR;
    PG8_STAGE(PG8_SB(1, 0), cB + kstep, voffB); PG8_STAGE_A(PG8_SA(1, 0), kstep, vc, 0); PG8_STAGE(PG8_SB(1, 1), cB + hstepB + kstep, voffB);
    PG8_WAIT_V(6); PG8_BAR;
    for (;;) {
        const bool has_next = P.next(ui + 1, nxt);
        const char* nB = cB;
        if (has_next) { P.a_voff(nxt, sR, sC, vn); nB = P.Bt + P.b_off(nxt); }
        else {
#pragma unroll
            for (int q = 0; q < 4; ++q) vn[q] = vc[q];
        }
        for (int t = 0; t < nt; t += 2) {
            const bool last = (t == nt - 2);
            const size_t ka1 = (size_t)(t + 1) * kstep;
            const size_t ka2 = last ? (size_t)0 : (size_t)(t + 2) * kstep, ka3 = ka2 + kstep;
            const char* b2 = last ? nB : cB + (size_t)(t + 2) * kstep; const char* b3 = b2 + kstep;
            unsigned v2[4];
#pragma unroll
            for (int q = 0; q < 4; ++q) v2[q] = last ? vn[q] : vc[q];
            PG8_LDB(B0, 0, 0); PG8_LDB(B1, 0, 1); PG8_SCHED; PG8_LDA(At, 0, 0); PG8_STAGE_A(PG8_SA(1, 1), ka1, vc, 1);
            PG8_WAIT_V(8); PG8_WAIT_L(0); PG8_BAR; PG8_MMA(0, 0, At, B0); PG8_MMA(0, 1, At, B1); PG8_BAR; PG8_SCHED;
            PG8_LDA(At, 0, 1); PG8_STAGE(PG8_SB(0, 0), b2, voffB); PG8_STAGE(PG8_SB(0, 1), b2 + hstepB, voffB); PG8_STAGE_A(PG8_SA(0, 0), ka2, v2, 0);
            PG8_WAIT_V(8); PG8_WAIT_L(0); PG8_BAR; PG8_MMA(1, 0, At, B0); PG8_MMA(1, 1, At, B1); PG8_BAR; PG8_SCHED;
            PG8_LDB(B0, 1, 0); PG8_LDB(B1, 1, 1); PG8_SCHED; PG8_LDA(At, 1, 0); PG8_STAGE_A(PG8_SA(0, 1), ka2, v2, 1);
            PG8_WAIT_V(8); PG8_WAIT_L(0); PG8_BAR; PG8_MMA(0, 0, At, B0); PG8_MMA(0, 1, At, B1); PG8_BAR; PG8_SCHED;
            PG8_LDA(At, 1, 1); PG8_STAGE(PG8_SB(1, 0), b3, voffB); PG8_STAGE(PG8_SB(1, 1), b3 + hstepB, voffB); PG8_STAGE_A(PG8_SA(1, 0), ka3, v2, 0);
            PG8_WAIT_V(8); PG8_WAIT_L(0); PG8_BAR; PG8_MMA(1, 0, At, B0); PG8_MMA(1, 1, At, B1); PG8_BAR; PG8_SCHED;
        }
        if constexpr (ALIGN_EPI) { if (wr == 0) PG8_BAR; }
        E(acc, cur, wr, wc, fr, fq);
        if (!has_next) break;
#pragma unroll
        for (int a = 0; a < 2; ++a)
#pragma unroll
            for (int b = 0; b < 2; ++b)
#pragma unroll
                for (int m = 0; m < 4; ++m)
#pragma unroll
                    for (int n = 0; n < 2; ++n) acc[a][b][m][n] = (f32x4){0.f, 0.f, 0.f, 0.f};
        cur = nxt; cB = nB; ++ui;
#pragma unroll
        for (int q = 0; q < 4; ++q) vc[q] = vn[q];
        if constexpr (ALIGN_EPI) { if (wr == 1) PG8_BAR; }
    }
    PG8_WAIT_V(0);
    if constexpr (!ALIGN_EPI) { if (wr == 0) PG8_BAR; }
    PG8_BAR;
#undef PG8_SA
#undef PG8_SB
#undef PG8_STAGE
#undef PG8_STAGE_A
#undef PG8_LDA
#undef PG8_LDB
#undef PG8_MMA
#undef PG8_WAIT_V
#undef PG8_WAIT_L
#undef PG8_BAR
#undef PG8_SCHED
}
}
constexpr int BATCH = 8, SEQ = 4096, D = 1024, T = BATCH * SEQ;
constexpr int IN_COLS = 8208;
constexpr int NEXP = 32, FF = 512;
constexpr float LN_EPS = 1e-5f, RMS_EPS = 1e-6f, ALPHA = 1.189207115002721f, LAM_INIT = 0.2f;
constexpr float ATT_C2 = 0.125f * 1.4426950408889634f;
constexpr int ACT_LD = 4352, AC_GQ = 0, AC_GK = 512, AC_GV = 1024, AC_GO = 2048, AC_DV = 3072, AC_GR = 4096;
constexpr int AC_O1 = 0, AC_O2 = 2048, AC_OGLA = 1024, AC_ODIFF = 0, AC_MERGED = 3072, AC_Y = 2048;
constexpr int DQK_LD = 2048;
constexpr int N1 = 32 * 256;

namespace pg8 {
struct EpiProj {
    bf16_t* act1; bf16_t* dqk; const int* pos; unsigned char* gates;
    __device__ __forceinline__ static unsigned q8(const f32x4 v) {
        const unsigned b0 = (unsigned)__builtin_rintf(sigmoidf_(v[0]) * 255.f), b1 = (unsigned)__builtin_rintf(sigmoidf_(v[1]) * 255.f), b2 = (unsigned)__builtin_rintf(sigmoidf_(v[2]) * 255.f), b3 = (unsigned)__builtin_rintf(sigmoidf_(v[3]) * 255.f);
        return b0 | (b1 << 8) | (b2 << 16) | (b3 << 24); }
    __device__ __forceinline__ void operator()(const f32x4 (&acc)[2][2][4][2], const Unit& u, int wr, int wc, int fr, int fq) const {
        const int pn = u.pn, row0 = u.row0 + wr * 64 + fr, colin = wc * 32 + 8 * fq;
        if (pn >= 24) {
            const int j0 = (pn - 24) * 128 + colin;
#pragma unroll
            for (int ai = 0; ai < 2; ++ai)
#pragma unroll
                for (int m = 0; m < 4; ++m) { unsigned char* gp = gates + (size_t)(row0 + ai * HALF + m * 16) * 2048 + j0;
                    *(u32x2*)gp = (u32x2){q8(acc[ai][0][m][0]), q8(acc[ai][0][m][1])}; *(u32x2*)(gp + 1024) = (u32x2){q8(acc[ai][1][m][0]), q8(acc[ai][1][m][1])}; }
        } else if (pn < 12 || pn >= 20) {
            const int coltile = pn < 12 ? pn * 256 : AC_DV + (pn - 20) * 256;
#pragma unroll
            for (int ai = 0; ai < 2; ++ai)
#pragma unroll
                for (int m = 0; m < 4; ++m) { bf16_t* rowp = act1 + (size_t)(row0 + ai * HALF + m * 16) * ACT_LD + coltile + colin;
#pragma unroll
                    for (int bj = 0; bj < 2; ++bj) { const f32x4 v0 = acc[ai][bj][m][0], v1 = acc[ai][bj][m][1];
                        u32x4 w; w.x = cvt_pk_bf16(v0[0], v0[1]); w.y = cvt_pk_bf16(v0[2], v0[3]); w.z = cvt_pk_bf16(v1[0], v1[1]); w.w = cvt_pk_bf16(v1[2], v1[3]);
                        *(u32x4*)(rowp + bj * HALF) = w; } }
        } else {
            const bool isq = pn < 16; const int coltile = isq ? (pn - 12) * 256 : 1024 + (pn - 16) * 256; const float sc = isq ? ATT_C2 : 1.f;
            const int g = 4 * (wc & 1) + fq; float inv[4];
#pragma unroll
            for (int i = 0; i < 4; ++i) inv[i] = exp2f(-(float)(4 * g + i) * (13.287712379549449f / 32.f));
            int pp[2][4];
#pragma unroll
            for (int ai = 0; ai < 2; ++ai)
#pragma unroll
                for (int m = 0; m < 4; ++m) pp[ai][m] = pos[row0 + ai * HALF + m * 16];
#pragma unroll
            for (int ai = 0; ai < 2; ++ai)
#pragma unroll
                for (int m = 0; m < 4; ++m) { const int r = row0 + ai * HALF + m * 16; const float p = (float)pp[ai][m]; float cs[4], sn[4];
#pragma unroll
                    for (int i = 0; i < 4; ++i) { const float ang = p * inv[i]; float rev = ang * 0.15915494309189535f; rev = rev - floorf(rev); sn[i] = __builtin_amdgcn_sinf(rev); cs[i] = __builtin_amdgcn_cosf(rev); }
                    bf16_t* rowp = dqk + (size_t)r * DQK_LD + coltile + colin;
#pragma unroll
                    for (int bj = 0; bj < 2; ++bj) { const f32x4 v0 = acc[ai][bj][m][0], v1 = acc[ai][bj][m][1]; float o1[4], o2[4];
#pragma unroll
                        for (int i = 0; i < 4; ++i) { o1[i] = (v0[i] * cs[i] - v1[i] * sn[i]) * sc; o2[i] = (v1[i] * cs[i] + v0[i] * sn[i]) * sc; }
                        u32x4 w; w.x = cvt_pk_bf16(o1[0], o1[1]); w.y = cvt_pk_bf16(o1[2], o1[3]); w.z = cvt_pk_bf16(o2[0], o2[1]); w.w = cvt_pk_bf16(o2[2], o2[3]);
                        *(u32x4*)(rowp + bj * HALF) = w; } }
        }
    }
};
struct EpiMerge {
    bf16_t* act1;
    __device__ __forceinline__ void operator()(const f32x4 (&acc)[2][2][4][2], const Unit& u, int wr, int wc, int fr, int fq) const {
        const int row0 = u.row0 + wr * 64 + fr, j0 = u.pn * 128 + wc * 32 + 8 * fq;
#pragma unroll
        for (int ai = 0; ai < 2; ++ai) { u32x4 ogs[4], ods[4];
#pragma unroll
            for (int m = 0; m < 4; ++m) { const bf16_t* rowp = act1 + (size_t)(row0 + ai * HALF + m * 16) * ACT_LD; ogs[m] = *(const u32x4*)(rowp + AC_OGLA + j0); ods[m] = *(const u32x4*)(rowp + AC_ODIFF + j0); }
#pragma unroll
            for (int m = 0; m < 4; ++m) { bf16_t* rowp = act1 + (size_t)(row0 + ai * HALF + m * 16) * ACT_LD; u32x4 w;
#pragma unroll
                for (int n = 0; n < 2; ++n) { const f32x4 va = acc[ai][0][m][n], vb = acc[ai][1][m][n]; const unsigned g0 = ogs[m][2 * n], g1 = ogs[m][2 * n + 1], d0 = ods[m][2 * n], d1 = ods[m][2 * n + 1];
                    w[2 * n] = cvt_pk_bf16(sigmoidf_(va[0]) * bf_lo(g0) + sigmoidf_(vb[0]) * bf_lo(d0), sigmoidf_(va[1]) * bf_hi(g0) + sigmoidf_(vb[1]) * bf_hi(d0));
                    w[2 * n + 1] = cvt_pk_bf16(sigmoidf_(va[2]) * bf_lo(g1) + sigmoidf_(vb[2]) * bf_lo(d1), sigmoidf_(va[3]) * bf_hi(g1) + sigmoidf_(vb[3]) * bf_hi(d1)); }
                *(u32x4*)(rowp + AC_MERGED + j0) = w; } }
    }
};
struct EpiY {
    bf16_t* act1;
    __device__ __forceinline__ void operator()(const f32x4 (&acc)[2][2][4][2], const Unit& u, int wr, int wc, int fr, int fq) const {
        const int row0 = u.row0 + wr * 64 + fr, col0 = u.pn * BM + wc * 32 + 8 * fq;
#pragma unroll
        for (int ai = 0; ai < 2; ++ai)
#pragma unroll
            for (int m = 0; m < 4; ++m) { bf16_t* rowp = act1 + (size_t)(row0 + ai * HALF + m * 16) * ACT_LD + AC_Y + col0;
#pragma unroll
                for (int bj = 0; bj < 2; ++bj) { const f32x4 v0 = acc[ai][bj][m][0], v1 = acc[ai][bj][m][1];
                    u32x4 w; w.x = cvt_pk_bf16(v0[0], v0[1]); w.y = cvt_pk_bf16(v0[2], v0[3]); w.z = cvt_pk_bf16(v1[0], v1[1]); w.w = cvt_pk_bf16(v1[2], v1[3]);
                    *(u32x4*)(rowp + bj * HALF) = w; } }
    }
};
struct EpiUp {
    bf16_t* hbuf;
    __device__ __forceinline__ void operator()(const f32x4 (&acc)[2][2][4][2], const Unit& u, int wr, int wc, int fr, int fq) const {
        const int row0 = u.row0 + wr * 64 + fr, j0 = u.pn * 128 + wc * 32 + 8 * fq;
#pragma unroll
        for (int ai = 0; ai < 2; ++ai)
#pragma unroll
            for (int m = 0; m < 4; ++m) { bf16_t* rowp = hbuf + (size_t)(row0 + ai * HALF + m * 16) * FF; u32x4 w;
#pragma unroll
                for (int n = 0; n < 2; ++n) { const f32x4 g = acc[ai][0][m][n], v = acc[ai][1][m][n];
                    w[2 * n] = cvt_pk_bf16(g[0] * sigmoidf_(g[0]) * v[0], g[1] * sigmoidf_(g[1]) * v[1]); w[2 * n + 1] = cvt_pk_bf16(g[2] * sigmoidf_(g[2]) * v[2], g[3] * sigmoidf_(g[3]) * v[3]); }
                *(u32x4*)(rowp + j0) = w; }
    }
};
struct EpiDown {
    bf16_t* mout; const int* rowtok; const float* roww;
    __device__ __forceinline__ void operator()(const f32x4 (&acc)[2][2][4][2], const Unit& u, int wr, int wc, int fr, int fq) const {
        const int row0 = u.row0 + wr * 64 + fr, col0 = u.pn * BM + wc * 32 + 8 * fq;
        int rts[2][4]; float ws[2][4];
#pragma unroll
        for (int ai = 0; ai < 2; ++ai)
#pragma unroll
            for (int m = 0; m < 4; ++m) { const int pr = row0 + ai * HALF + m * 16; rts[ai][m] = rowtok[pr]; ws[ai][m] = roww[pr]; }
#pragma unroll
        for (int ai = 0; ai < 2; ++ai)
#pragma unroll
            for (int m = 0; m < 4; ++m) { const int rt = rts[ai][m]; const float w = ws[ai][m];
                if (rt >= 0) { bf16_t* rowp = mout + (size_t)rt * D + col0;
#pragma unroll
                    for (int bj = 0; bj < 2; ++bj) { const f32x4 v0 = acc[ai][bj][m][0] * w, v1 = acc[ai][bj][m][1] * w;
                        u32x4 o; o.x = cvt_pk_bf16(v0[0], v0[1]); o.y = cvt_pk_bf16(v0[2], v0[3]); o.z = cvt_pk_bf16(v1[0], v1[1]); o.w = cvt_pk_bf16(v1[2], v1[3]);
                        *(u32x4*)(rowp + bj * HALF) = o; } } }
    }
};
constexpr int TILE_MAX = 512;
template <bool GATHER> struct MoeProb {
    const char* A; const char* Bt; int lda, K; int G, c; PG8_LAS const int* tab; PG8_LAS const int* rows; size_t bstride;
    __device__ __forceinline__ bool next(int i, Unit& u) const {
        const int idx = i * G + c, ntile = tab[0]; if (idx >= ntile * 4) return false;
        const int t = idx >> 2; u.pn = idx & 3; u.e = tab[1 + t]; u.row0 = tab[1 + TILE_MAX + t]; u.pm = i; return true;
    }
    __device__ __forceinline__ void a_voff(const Unit& u, const int (&R)[2], const int (&C)[2], unsigned (&v)[4]) const {
#pragma unroll
        for (int h = 0; h < 2; ++h)
#pragma unroll
            for (int i = 0; i < 2; ++i) { const int row = GATHER ? rows[u.pm * 256 + h * HALF + R[i]] : (u.row0 + h * HALF + R[i]); v[h * 2 + i] = (unsigned)(row * lda + C[i]) * 2u; }
    }
    __device__ __forceinline__ size_t b_off(const Unit& u) const { return (size_t)u.e * bstride + (size_t)u.pn * BM * K * 2; }
};
}
#include <hip/hip_bf16.h>
#include <cmath>
namespace attn_body {
using bf16=__hip_bfloat16;
using bf16x8=__attribute__((ext_vector_type(8)))short;
using s16x4=__attribute__((ext_vector_type(4)))short;
using f32x16=__attribute__((ext_vector_type(16)))float;
using u32x4=__attribute__((ext_vector_type(4)))unsigned;
constexpr int SEQ=4096,D=64,PQ=2048,PK=2048,PV=4352,PO=4352;
constexpr int NW=8,QBLK=32,QB=QBLK*NW,KVBLK=64,NQB=SEQ/QB;
constexpr int ATTN_UNIT_ROWS=QB;
__device__ __forceinline__ int crow(int r,int hi){return (r&3)+8*(r>>2)+4*hi;}
#define SBAR() __builtin_amdgcn_sched_barrier(0)
__device__ __forceinline__ void cmask(f32x16&p0,f32x16&p1,int jb,int qrel,int hi){
  const float NEG=-INFINITY; int kb=64*jb+4*hi;
  #pragma unroll
  for(int r=0;r<16;++r){int kv=kb+(r&3)+8*(r>>2); if(kv>qrel)p0[r]=NEG; if(kv+32>qrel)p1[r]=NEG;}
}

constexpr int NSLOT=3, SLOTB=8192;
constexpr int LDS_K=0, LDS_V=NSLOT*SLOTB, LDS_WS=3*NSLOT*SLOTB, LDS_OST=LDS_WS+NW*64*4, LDS_BYTES=LDS_OST+NW*4096;
constexpr float C2=0.125f*1.4426950408889634f;
__device__ __forceinline__ void glds16(const void*gsrc,unsigned lds_dst){unsigned keep;
  asm volatile("s_mov_b32 %0, m0\n\ts_mov_b32 m0, %2\n\ts_nop 0\n\tglobal_load_lds_dwordx4 %1, off\n\ts_mov_b32 m0, %0":"=&s"(keep):"v"(gsrc),"s"(lds_dst):"memory");}
__device__ __forceinline__ float max3f(float a,float b,float c){float r;asm("v_max3_f32 %0, %1, %2, %3":"=v"(r):"v"(a),"v"(b),"v"(c));return r;}
__device__ __forceinline__ float max2f(float a,float b){float r;asm("v_max_f32_e32 %0, %1, %2":"=v"(r):"v"(a),"v"(b));return r;}
__device__ __forceinline__ float fadd_s(float a,float b){float r;asm("v_add_f32_e32 %0, %1, %2":"=v"(r):"v"(a),"v"(b));return r;}
__device__ __forceinline__ float fsub_s(float a,float b){float r;asm("v_sub_f32_e32 %0, %1, %2":"=v"(r):"v"(a),"v"(b));return r;}
typedef float f32x2_t __attribute__((ext_vector_type(2))); typedef __bf16 bf16x2_t __attribute__((ext_vector_type(2)));
__device__ __forceinline__ unsigned cvtpk_s(float lo,float hi){f32x2_t v={lo,hi};bf16x2_t b=__builtin_convertvector(v,bf16x2_t);return __builtin_bit_cast(unsigned,b);}
#define WAIT_BAR(N) asm volatile("s_waitcnt vmcnt(" #N ") lgkmcnt(0)\n\ts_barrier":::"memory")

__device__ __forceinline__ void qkt(f32x16&p0,f32x16&p1,const char*Kslot,const bf16x8*qr,int r32,int hi){ const f32x16 negm=f32x16{};
  const char*kb=Kslot+hi*1024+r32*16;
  #pragma unroll
  for(int d0=0;d0<4;++d0){
    const bf16x8 b0=*reinterpret_cast<const bf16x8*>(kb+d0*2048);
    const bf16x8 b1=*reinterpret_cast<const bf16x8*>(kb+d0*2048+512);
    if(d0==0){p0=__builtin_amdgcn_mfma_f32_32x32x16_bf16(b0,qr[0],negm,0,0,0);p1=__builtin_amdgcn_mfma_f32_32x32x16_bf16(b1,qr[0],negm,0,0,0);}
    else{p0=__builtin_amdgcn_mfma_f32_32x32x16_bf16(b0,qr[d0],p0,0,0,0);p1=__builtin_amdgcn_mfma_f32_32x32x16_bf16(b1,qr[d0],p1,0,0,0);}}
}
typedef __attribute__((address_space(3))) const char* lds_cptr;
typedef short v4i16_t __attribute__((ext_vector_type(4)));
__device__ __forceinline__ void kload8(bf16x8*kf,lds_cptr kp){
  kf[0]=*(const __attribute__((address_space(3))) bf16x8*)(kp);      kf[1]=*(const __attribute__((address_space(3))) bf16x8*)(kp+512);
  kf[2]=*(const __attribute__((address_space(3))) bf16x8*)(kp+2048); kf[3]=*(const __attribute__((address_space(3))) bf16x8*)(kp+2560);
  kf[4]=*(const __attribute__((address_space(3))) bf16x8*)(kp+4096); kf[5]=*(const __attribute__((address_space(3))) bf16x8*)(kp+4608);
  kf[6]=*(const __attribute__((address_space(3))) bf16x8*)(kp+6144); kf[7]=*(const __attribute__((address_space(3))) bf16x8*)(kp+6656);
}
__device__ __forceinline__ void kload2(bf16x8*kf,lds_cptr kp,int j){ kf[2*j]=*(const __attribute__((address_space(3))) bf16x8*)(kp+j*2048); kf[2*j+1]=*(const __attribute__((address_space(3))) bf16x8*)(kp+j*2048+512); }
__device__ __forceinline__ s16x4 vtr(lds_cptr p){ return __builtin_bit_cast(s16x4,__builtin_amdgcn_ds_read_tr16_b64_v4i16((__attribute__((address_space(3))) v4i16_t*)p)); }
__device__ __forceinline__ float rowmax(const f32x16&p0,const f32x16&p1){
  float a=max3f(p0[0],p0[1],p1[0]),b=max3f(p0[2],p0[3],p1[1]);a=max3f(a,p1[2],p1[3]);
  #pragma unroll
  for(int r=4;r<16;r+=4){a=max3f(a,p0[r],p0[r+1]);b=max3f(b,p0[r+2],p0[r+3]);a=max3f(a,p1[r],p1[r+1]);b=max3f(b,p1[r+2],p1[r+3]);}
  const float m=max2f(a,b);
  auto rr=__builtin_amdgcn_permlane32_swap(__float_as_uint(m),__float_as_uint(m),false,false);
  return max2f(__uint_as_float(rr[0]),__uint_as_float(rr[1]));
}
__device__ __forceinline__ void pv(f32x16*o,int vb,bf16x8 pa0,bf16x8 pa1,bf16x8 pa2,bf16x8 pa3){
  #pragma unroll
  for(int d0=0;d0<4;++d0){s16x4 lo[4],hi[4];
    #pragma unroll
    for(int ks=0;ks<4;++ks){
      asm volatile("ds_read_b64_tr_b16 %0,%1 offset:%c2":"=&v"(lo[ks]):"v"(vb),"i"(d0*4096+ks*1024):"memory");
      asm volatile("ds_read_b64_tr_b16 %0,%1 offset:%c2":"=&v"(hi[ks]):"v"(vb),"i"(d0*4096+ks*1024+512):"memory");}
    asm volatile("s_waitcnt lgkmcnt(0)":::"memory");SBAR();
    #define PK(k) (bf16x8){lo[k][0],lo[k][1],lo[k][2],lo[k][3],hi[k][0],hi[k][1],hi[k][2],hi[k][3]}
    o[d0]=__builtin_amdgcn_mfma_f32_32x32x16_bf16(pa0,PK(0),o[d0],0,0,0);
    o[d0]=__builtin_amdgcn_mfma_f32_32x32x16_bf16(pa1,PK(1),o[d0],0,0,0);
    o[d0]=__builtin_amdgcn_mfma_f32_32x32x16_bf16(pa2,PK(2),o[d0],0,0,0);
    o[d0]=__builtin_amdgcn_mfma_f32_32x32x16_bf16(pa3,PK(3),o[d0],0,0,0);
    #undef PK
  }
}

#ifndef ATTN_STORE16
#define ATTN_STORE16(p,v) (*(u32x4*)(p)=(v))
#endif
template<int THRL,int CM> __device__ __forceinline__ void attn_unit(int b,int qb,int qcol,int vcol,int ocol,int mcol,int gcol,const bf16*QK,const bf16*__restrict__ V,bf16*O,const unsigned char*gates,char*shm,float lam,const float*nwp){
  int tid_=threadIdx.x; asm volatile("":"+v"(tid_));
  const int tid=tid_,lane=tid&63,r32=lane&31,hi=lane>>5; const int wid=__builtin_amdgcn_readfirstlane(tid>>6);
  const long rowbase=(long)b*SEQ; const int q0=qb*QB;
  const bf16*Qw=QK+(rowbase+q0+wid*QBLK)*PQ+qcol;
  const bf16*Kh=QK+rowbase*PK+1024+qcol,*Vh=V+rowbase*PV+vcol;
  const unsigned lds0=(unsigned)(uintptr_t)shm;
  float*wsf=(float*)(shm+LDS_WS)+wid*64;
  const bf16*ksrc=Kh+(long)lane*PK+wid*8;
  const bf16*vsrc=Vh+(long)(16*(wid&3)+(lane>>2))*PV+(wid>>2)*32+(lane&3)*8;
  const unsigned kdst=lds0+LDS_K+wid*1024, vdst=lds0+LDS_V+wid*1024;
  #define DMA_K(t,slot) glds16(ksrc+(long)(t)*KVBLK*PK,(unsigned)__builtin_amdgcn_readfirstlane(kdst+(slot)))
  #define DMA_V(t,slot) do{ glds16(vsrc+(long)(t)*KVBLK*PV,(unsigned)__builtin_amdgcn_readfirstlane(vdst+2*(slot))); glds16(vsrc+(long)(t)*KVBLK*PV+64,(unsigned)__builtin_amdgcn_readfirstlane(vdst+2*(slot)+8192)); }while(0)
  const int vb0=(int)(lds0+LDS_V)+((lane>>4)&1)*32+(lane&3)*8+(4*hi+((lane&15)>>2))*64;
  const char*Kbase=shm+LDS_K; bf16x8 kf[8];
  const lds_cptr shm3=(lds_cptr)shm; const lds_cptr kp0=shm3+LDS_K+hi*1024+r32*16; const lds_cptr vp0=shm3+LDS_V+((lane>>4)&1)*32+(lane&3)*8+(4*hi+((lane&15)>>2))*64;
  const int NT=(q0+QB)/KVBLK;
  DMA_K(0,0);DMA_V(0,0);DMA_K(1,SLOTB);
  bf16x8 qr[4];
  #pragma unroll
  for(int d0=0;d0<4;++d0)qr[d0]=*reinterpret_cast<const bf16x8*>(&Qw[(long)r32*PQ+d0*16+hi*8]);
  float mhat=0.f,l_reg=0.f;f32x16 o[4];o[0]=f32x16{};o[1]=f32x16{};o[2]=f32x16{};o[3]=f32x16{};
  const int qrel=wid*QBLK+r32;
  #define CMASK(P0,P1,t) do{int jb_=(t)-(NT-4); if(jb_>=0)cmask(P0,P1,jb_,qrel,hi);}while(0)
  bool resc=false;
  #define START(P0,P1) do{ const float rm=rowmax(P0,P1); resc=false; mhat=rm; \
    _Pragma("unroll") for(int r=0;r<16;++r)P0[r]=__builtin_amdgcn_exp2f(fsub_s(P0[r],mhat)); }while(0)
  #define RESC() do{ if(resc){ asm volatile("s_waitcnt lgkmcnt(0)":::"memory"); \
      _Pragma("unroll") for(int d_=0;d_<4;++d_) _Pragma("unroll") for(int r=0;r<16;++r)o[d_][r]*=wsf[crow(r,hi)]; } }while(0)
  f32x16 pA0,pA1,pB0,pB1;
  int sl_prev=0,sl_cur=0,sl_next=SLOTB;
  #define ROT() do{sl_prev=sl_cur;sl_cur=sl_next;sl_next=(sl_next==(NSLOT-1)*SLOTB)?0:sl_next+SLOTB;}while(0)
  DMA_K(2,2*SLOTB);
  WAIT_BAR(3);
  qkt(pA0,pA1,Kbase,qr,r32,hi);asm volatile("s_nop 15\n\ts_nop 7":"+v"(pA0),"+v"(pA1));CMASK(pA0,pA1,0);
  START(pA0,pA1);
  _Pragma("unroll") for(int r=0;r<16;++r)pA1[r]=__builtin_amdgcn_exp2f(fsub_s(pA1[r],mhat));
  WAIT_BAR(0);
  DMA_K(3,0);DMA_V(1,SLOTB);
  ROT();
  kload8(kf,kp0+sl_cur);
  WAIT_BAR(3);
  s16x4 vlo[8],vhi[8]; u32x4 pw0,pw1,pw2,pw3; const f32x16 zc=f32x16{};
  #define PKW(P,B) cvtpk_s(P[B],P[B+1])
  #define PAF(k) __builtin_bit_cast(bf16x8,pw##k)
  #define VFR(i) (bf16x8){vlo[i][0],vlo[i][1],vlo[i][2],vlo[i][3],vhi[i][0],vhi[i][1],vhi[i][2],vhi[i][3]}
  #define PIN(x) asm volatile("":"+v"(x))
  #define MX3(a,b,c) __builtin_fmaxf(__builtin_fmaxf((a),(b)),(c))
  #define GAPA(MF,A0,A1,A2,A3,W0,W1,PW) do{ MF; sacc+=A0; sacc+=A1; sacc+=A2; sacc+=A3; PIN(sacc); W0; W1; PIN(PW); SBAR(); }while(0)
  #define EX(v) __builtin_amdgcn_exp2f((v)-mhat)
  #define GAPB(MF,X,B) do{ MF; X[B]=EX(X[B]); X[B+1]=EX(X[B+1]); PIN(X); SBAR(); }while(0)
  #define VRD(i) do{ vlo[(i)&7]=vtr(vp_+(((i)>>2)*4096+((i)&3)*1024)); vhi[(i)&7]=vtr(vp_+(((i)>>2)*4096+((i)&3)*1024+512)); SBAR(); }while(0)
  #define KRD(G,j) do{ if(G){ kload2(kf,kp0+sl_next,j); SBAR(); } }while(0)
  #define STEP(C0,C1,P0,P1,t,GK,GV,GL) do{ SBAR(); \
    const lds_cptr vp_=vp0+2*sl_prev; \
    VRD(0); float sacc=(P0[0]+P0[1]); \
    GAPA(C0=__builtin_amdgcn_mfma_f32_32x32x16_bf16(kf[0],qr[0],zc,0,0,0), P0[2],P0[3],P0[4],P0[5],     pw0[0]=PKW(P0,0), pw0[1]=PKW(P0,2), pw0); \
    VRD(4); GAPA(C1=__builtin_amdgcn_mfma_f32_32x32x16_bf16(kf[1],qr[0],zc,0,0,0), P0[6],P0[7],P0[8],P0[9],     pw0[2]=PKW(P0,4), pw0[3]=PKW(P0,6), pw0); \
    VRD(1); GAPA(C0=__builtin_amdgcn_mfma_f32_32x32x16_bf16(kf[2],qr[1],C0,0,0,0),   P0[10],P0[11],P0[12],P0[13], pw1[0]=PKW(P0,8), pw1[1]=PKW(P0,10), pw1); \
    VRD(5); GAPA(C1=__builtin_amdgcn_mfma_f32_32x32x16_bf16(kf[3],qr[1],C1,0,0,0),   P0[14],P0[15],P1[0],P1[1],   pw1[2]=PKW(P0,12),pw1[3]=PKW(P0,14), pw1); \
    VRD(2); GAPA(C0=__builtin_amdgcn_mfma_f32_32x32x16_bf16(kf[4],qr[2],C0,0,0,0),   P1[2],P1[3],P1[4],P1[5],     pw2[0]=PKW(P1,0), pw2[1]=PKW(P1,2), pw2); \
    VRD(6); GAPA(C1=__builtin_amdgcn_mfma_f32_32x32x16_bf16(kf[5],qr[2],C1,0,0,0),   P1[6],P1[7],P1[8],P1[9],     pw2[2]=PKW(P1,4), pw2[3]=PKW(P1,6), pw2); \
    VRD(3); GAPA(C0=__builtin_amdgcn_mfma_f32_32x32x16_bf16(kf[6],qr[3],C0,0,0,0),   P1[10],P1[11],P1[12],P1[13], pw3[0]=PKW(P1,8), pw3[1]=PKW(P1,10), pw3); \
    VRD(7); GAPA(C1=__builtin_amdgcn_mfma_f32_32x32x16_bf16(kf[7],qr[3],C1,0,0,0),   P1[14],P1[15],0.f,0.f,       pw3[2]=PKW(P1,12),pw3[3]=PKW(P1,14), pw3); \
    l_reg+=sacc; \
    if(GK){DMA_K((t)+3,sl_cur);} if(GV){DMA_V((t)+1,sl_next);} \
    CMASK(C0,C1,t); \
    { float a=MX3(C0[0],C0[1],C1[0]),b=MX3(C0[2],C0[3],C1[1]); a=MX3(a,C1[2],C1[3]); \
      _Pragma("unroll") for(int r=4;r<16;r+=4){a=MX3(a,C0[r],C0[r+1]);b=MX3(b,C0[r+2],C0[r+3]);a=MX3(a,C1[r],C1[r+1]);b=MX3(b,C1[r+2],C1[r+3]);} \
      float rm=__builtin_fmaxf(a,b); { auto rr=__builtin_amdgcn_permlane32_swap(__float_as_uint(rm),__float_as_uint(rm),false,false); rm=__builtin_fmaxf(__uint_as_float(rr[0]),__uint_as_float(rr[1])); } \
      resc=false; rm-=mhat; \
      if(__builtin_expect(__any(rm>(float)THRL),0)){ const float dl=__builtin_fmaxf(rm,0.f); mhat+=dl; \
        const float f=__builtin_amdgcn_exp2f(-dl); l_reg*=f; if(hi==0)wsf[r32]=f; resc=true; } } \
    SBAR(); \
    GAPB(o[0]=__builtin_amdgcn_mfma_f32_32x32x16_bf16(PAF(0),VFR(0),o[0],0,0,0), C0,0);  VRD(8); \
    GAPB(o[1]=__builtin_amdgcn_mfma_f32_32x32x16_bf16(PAF(0),VFR(4),o[1],0,0,0), C0,2);  VRD(12); \
    GAPB(o[0]=__builtin_amdgcn_mfma_f32_32x32x16_bf16(PAF(1),VFR(1),o[0],0,0,0), C0,4);  VRD(9); \
    GAPB(o[1]=__builtin_amdgcn_mfma_f32_32x32x16_bf16(PAF(1),VFR(5),o[1],0,0,0), C0,6);  VRD(13); \
    GAPB(o[0]=__builtin_amdgcn_mfma_f32_32x32x16_bf16(PAF(2),VFR(2),o[0],0,0,0), C0,8);  VRD(10); \
    GAPB(o[1]=__builtin_amdgcn_mfma_f32_32x32x16_bf16(PAF(2),VFR(6),o[1],0,0,0), C0,10); VRD(14); \
    GAPB(o[0]=__builtin_amdgcn_mfma_f32_32x32x16_bf16(PAF(3),VFR(3),o[0],0,0,0), C0,12); VRD(11); \
    GAPB(o[1]=__builtin_amdgcn_mfma_f32_32x32x16_bf16(PAF(3),VFR(7),o[1],0,0,0), C0,14); VRD(15); \
    GAPB(o[2]=__builtin_amdgcn_mfma_f32_32x32x16_bf16(PAF(0),VFR(0),o[2],0,0,0), C1,0); \
    GAPB(o[3]=__builtin_amdgcn_mfma_f32_32x32x16_bf16(PAF(0),VFR(4),o[3],0,0,0), C1,2); \
    KRD(GL,0); GAPB(o[2]=__builtin_amdgcn_mfma_f32_32x32x16_bf16(PAF(1),VFR(1),o[2],0,0,0), C1,4); \
    KRD(GL,1); GAPB(o[3]=__builtin_amdgcn_mfma_f32_32x32x16_bf16(PAF(1),VFR(5),o[3],0,0,0), C1,6); \
    KRD(GL,2); GAPB(o[2]=__builtin_amdgcn_mfma_f32_32x32x16_bf16(PAF(2),VFR(2),o[2],0,0,0), C1,8); \
    KRD(GL,3); GAPB(o[3]=__builtin_amdgcn_mfma_f32_32x32x16_bf16(PAF(2),VFR(6),o[3],0,0,0), C1,10); \
    GAPB(o[2]=__builtin_amdgcn_mfma_f32_32x32x16_bf16(PAF(3),VFR(3),o[2],0,0,0), C1,12); \
    GAPB(o[3]=__builtin_amdgcn_mfma_f32_32x32x16_bf16(PAF(3),VFR(7),o[3],0,0,0), C1,14); \
    }while(0)
  int t=1;
  #undef CMASK
  #define CMASK(P0,P1,t) do{}while(0)
  for(;t+5<NT;t+=2){
    STEP(pB0,pB1,pA0,pA1,t,true,true,true);     WAIT_BAR(3); RESC(); ROT();
    STEP(pA0,pA1,pB0,pB1,t+1,true,true,true);   WAIT_BAR(3); RESC(); ROT();
  }
  #undef CMASK
  #define CMASK(P0,P1,t) do{int jb_=(t)-(NT-4); if(jb_>=0)cmask(P0,P1,jb_,qrel,hi);}while(0)
  #define ENDW(tt) do{ if((tt)+3<NT){WAIT_BAR(3);} else if((tt)+2<NT){WAIT_BAR(2);} else {WAIT_BAR(0);} }while(0)
  for(;t+1<NT;t+=2){
    STEP(pB0,pB1,pA0,pA1,t,(t+3<NT),(t+1<NT),(t+1<NT));       ENDW(t);   RESC(); ROT();
    STEP(pA0,pA1,pB0,pB1,t+1,(t+4<NT),(t+2<NT),(t+2<NT));     ENDW(t+1); RESC(); ROT();
  }
  STEP(pB0,pB1,pA0,pA1,NT-1,false,false,false); RESC();
  { float sacc=pB0[0]+pB0[1]; _Pragma("unroll") for(int r=2;r<16;++r)sacc+=pB0[r]; _Pragma("unroll") for(int r=0;r<16;++r)sacc+=pB1[r]; l_reg+=sacc;
    pw0=(u32x4){PKW(pB0,0),PKW(pB0,2),PKW(pB0,4),PKW(pB0,6)};pw1=(u32x4){PKW(pB0,8),PKW(pB0,10),PKW(pB0,12),PKW(pB0,14)};pw2=(u32x4){PKW(pB1,0),PKW(pB1,2),PKW(pB1,4),PKW(pB1,6)};pw3=(u32x4){PKW(pB1,8),PKW(pB1,10),PKW(pB1,12),PKW(pB1,14)};
    SBAR(); pv(o,vb0+2*sl_cur,PAF(0),PAF(1),PAF(2),PAF(3)); }
  #undef PKW
  #undef PAF
  #undef VFR
  #undef PIN
  #undef MX3
  #undef GAPA
  #undef GAPB
  #undef EX
  #undef VRD
  #undef KRD
  #undef STEP
  #undef ENDW
  {auto rr=__builtin_amdgcn_permlane32_swap(__float_as_uint(l_reg),__float_as_uint(l_reg),false,false);l_reg=__uint_as_float(rr[0])+__uint_as_float(rr[1]);}
  if(hi==0)wsf[32+r32]=l_reg;asm volatile("s_waitcnt lgkmcnt(0)":::"memory");
  float rli[16];
  #pragma unroll
  for(int r=0;r<16;++r)rli[r]=__builtin_amdgcn_rcpf(wsf[32+crow(r,hi)]);
  bf16*Ow=O+(rowbase+q0+wid*QBLK)*PO+ocol;
  { bf16*stg=(bf16*)(shm+LDS_OST)+wid*2048;
    float vv[2][4][8];
    u32x4 w1s[2][4];
    if constexpr(CM==1){ const bf16*p0=Ow+(long)(lane>>3)*PO+(lane&7)*8;
      asm volatile("global_load_dwordx4 %0, %8, off sc0 sc1\n\tglobal_load_dwordx4 %1, %9, off sc0 sc1\n\tglobal_load_dwordx4 %2, %10, off sc0 sc1\n\tglobal_load_dwordx4 %3, %11, off sc0 sc1\n\t"
                   "global_load_dwordx4 %4, %12, off sc0 sc1\n\tglobal_load_dwordx4 %5, %13, off sc0 sc1\n\tglobal_load_dwordx4 %6, %14, off sc0 sc1\n\tglobal_load_dwordx4 %7, %15, off sc0 sc1\n\ts_waitcnt vmcnt(0)"
                   :"=&v"(w1s[0][0]),"=&v"(w1s[0][1]),"=&v"(w1s[0][2]),"=&v"(w1s[0][3]),"=&v"(w1s[1][0]),"=&v"(w1s[1][1]),"=&v"(w1s[1][2]),"=&v"(w1s[1][3])
                   :"v"(p0),"v"(p0+8L*PO),"v"(p0+16L*PO),"v"(p0+24L*PO),"v"(p0+64),"v"(p0+8L*PO+64),"v"(p0+16L*PO+64),"v"(p0+24L*PO+64):"memory"); }
    #pragma unroll
    for(int hf=0;hf<2;++hf){
      #pragma unroll
      for(int r=0;r<16;++r){const int orow=crow(r,hi);
        #pragma unroll
        for(int d0=0;d0<2;++d0)stg[orow*64+d0*32+r32]=__float2bfloat16(o[2*hf+d0][r]*rli[r]);}
      asm volatile("s_waitcnt lgkmcnt(0)":::"memory");
      #pragma unroll
      for(int i=0;i<4;++i){const int row=i*8+(lane>>3),ch=lane&7; const u32x4 v=*(const u32x4*)(stg+row*64+ch*8);
        if constexpr(CM==0){ ATTN_STORE16(Ow+(long)row*PO+hf*64+ch*8,v); }
        else { const u32x4 w1=w1s[hf][i];
          #pragma unroll
          for(int e=0;e<4;++e){ vv[hf][i][2*e]=__uint_as_float(w1[e]<<16)-lam*__uint_as_float(v[e]<<16); vv[hf][i][2*e+1]=__uint_as_float(w1[e]&0xffff0000u)-lam*__uint_as_float(v[e]&0xffff0000u); } } }
      asm volatile("s_waitcnt lgkmcnt(0)":::"memory"); }
    if constexpr(CM==1){
      bf16*Mw=O+(rowbase+q0+wid*QBLK)*PO+mcol; const unsigned char*Gw=gates+(rowbase+q0+wid*QBLK)*2048+gcol;
      u32x4 mg[2][4]; unsigned gbw[2][4][2];
      #pragma unroll
      for(int hf=0;hf<2;++hf)
        #pragma unroll
        for(int i=0;i<4;++i){ const int row=i*8+(lane>>3),ch=lane&7; mg[hf][i]=*(const u32x4*)(Mw+(long)row*PO+hf*64+ch*8);
          const unsigned long long g8=*(const unsigned long long*)(Gw+(long)row*2048+hf*64+ch*8); gbw[hf][i][0]=(unsigned)g8; gbw[hf][i][1]=(unsigned)(g8>>32); }
      float nw[2][8];
      #pragma unroll
      for(int hf=0;hf<2;++hf)
        #pragma unroll
        for(int e=0;e<8;++e)nw[hf][e]=nwp[hf*64+(lane&7)*8+e];
      #pragma unroll
      for(int i=0;i<4;++i){ float ss=0.f;
        #pragma unroll
        for(int hf=0;hf<2;++hf)
          #pragma unroll
          for(int e=0;e<8;++e)ss+=vv[hf][i][e]*vv[hf][i][e];
        ss+=__shfl_xor(ss,1); ss+=__shfl_xor(ss,2); ss+=__shfl_xor(ss,4);
        const float rstd=1.f/sqrtf(ss*(1.f/128.f)+1e-6f); const int row=i*8+(lane>>3),ch=lane&7;
        #pragma unroll
        for(int hf=0;hf<2;++hf){ u32x4 w;
          #pragma unroll
          for(int e=0;e<4;++e){ const unsigned gw_=gbw[hf][i][e>>1]; const float g0=(float)((gw_>>(16*(e&1)))&0xffu)*(1.f/255.f),g1=(float)((gw_>>(16*(e&1)+8))&0xffu)*(1.f/255.f);
            const unsigned m_=mg[hf][i][e];
            w[e]=cvtpk_s(__uint_as_float(m_<<16)+g0*(vv[hf][i][2*e]*rstd*nw[hf][2*e]),__uint_as_float(m_&0xffff0000u)+g1*(vv[hf][i][2*e+1]*rstd*nw[hf][2*e+1])); }
          ATTN_STORE16(Mw+(long)row*PO+hf*64+ch*8,w); } } } }
  asm volatile("s_waitcnt lgkmcnt(0)\n\ts_barrier":::"memory");
  #undef DMA_K
  #undef DMA_V
  #undef CMASK
  #undef START
  #undef RESC
  #undef ROT
}
constexpr int ATTN_LDS_BYTES=LDS_BYTES;
struct AttnTensors { const bf16* QK; const bf16* V; bf16* O; };
struct AttnUnit { int bh; int qb; };
struct StaticOrder {
  int vcu, G;
  __device__ __forceinline__ explicit StaticOrder(int grid,int vcu_):vcu(vcu_),G(grid){}
  __device__ __forceinline__ bool next(int i,AttnUnit&u)const{ const int L=i*G+vcu; if(L>=64*NQB)return false; const int v=L&255,j=L>>8,sx=v&3; u.bh=v>>2; u.qb=(j==0)?15-sx:(j==1)?8+sx:(j==2)?7-sx:sx; return true; }
};
template<class Sched,int THRL=8> __device__ __forceinline__ void attn_phase(char*lds,const AttnTensors&T,const Sched&S,int vcol,int ocol,int mcol,const unsigned char*gates,float lam,const float*nwp){
  AttnUnit u;
  for(int i=0;S.next(i,u);++i){
    const int b=u.bh>>3,h=u.bh&7;
    attn_unit<THRL,0>(b,u.qb,h*128,vcol+h*128,ocol+h*128,mcol+h*128,1024+h*128,T.QK,T.V,T.O,gates,lds,lam,nwp);
    attn_unit<THRL,1>(b,u.qb,h*128+64,vcol+h*128,ocol+h*128,mcol+h*128,1024+h*128,T.QK,T.V,T.O,gates,lds,lam,nwp);
  }
}
#undef SBAR
#undef WAIT_BAR
}
constexpr size_t MiB = 1u << 20;
constexpr size_t WS_CTL = 0, CTL_ZERO_BYTES = 64 * 1024;
constexpr size_t WS_ADA = 1 * MiB;
constexpr size_t WS_WRT = 1 * MiB + 256 * 1024;
constexpr size_t WS_CNT = 1 * MiB + 512 * 1024;
constexpr size_t WS_TAB = 1 * MiB + 640 * 1024;
constexpr size_t WS_TOKE = 2 * MiB;
constexpr size_t WS_TOKW = 2 * MiB + 256 * 1024;
constexpr size_t WS_ROWTOK = 2 * MiB + 512 * 1024;
constexpr size_t WS_ROWW = 3 * MiB;
constexpr size_t WS_DT = 3 * MiB + 512 * 1024;
constexpr size_t WS_WIN = 8 * MiB;
constexpr size_t WS_WMG = 20 * MiB;
constexpr size_t WS_WOUT = 25 * MiB;
constexpr size_t WS_WGU = 27 * MiB;
constexpr size_t WS_WD = 91 * MiB;
constexpr size_t WS_U = 123 * MiB;
constexpr size_t WS_ACT = 187 * MiB;
constexpr size_t WS_HST = 459 * MiB;
constexpr size_t WS_END = 491 * MiB;
constexpr size_t WS_GATES = WS_WGU;
constexpr size_t WS_HBUF = WS_ACT;
constexpr int PROWS = 73728;
constexpr size_t WS_MOUT = WS_ACT + 72 * MiB;
static_assert(WS_HBUF + (size_t)PROWS * FF * 2 <= WS_MOUT && WS_MOUT + (size_t)T * 2 * D * 2 <= WS_HST && WS_ACT + (size_t)T * ACT_LD * 2 <= WS_HST, "d_ws map");
constexpr int CW_TMO = 0, CW_CODE = 1, CW_BAR = 4096;
static_assert((CW_BAR + 3456) * 4 <= (int)CTL_ZERO_BYTES, "barrier words inside the memset region");

constexpr int NWAVES = 8;
constexpr int RING_OFF = 0, RING_BYTES = 131072;
constexpr int LDSCTL_OFF = RING_BYTES, MISC_OFF = LDSCTL_OFF + 320;
constexpr int ROWS_OFF = RING_BYTES + 1024;
constexpr int TAB_OFF = ROWS_OFF + 8 * 256 * 4;
constexpr int LDS_BYTES = 147456;
static_assert(TAB_OFF + (1 + 2 * 512) * 4 <= LDS_BYTES, "LDS map");

#define GAS __attribute__((address_space(1)))
#define LAS __attribute__((address_space(3)))
typedef unsigned short bf16;
typedef unsigned v4u __attribute__((ext_vector_type(4)));
typedef float f32x4 __attribute__((ext_vector_type(4)));
typedef short bf16x8 __attribute__((ext_vector_type(8)));
typedef GAS unsigned gu32;
typedef GAS unsigned long long gu64;
#define RLX_AGENT __ATOMIC_RELAXED, __HIP_MEMORY_SCOPE_AGENT
#define LDS_WAIT() asm volatile("s_waitcnt lgkmcnt(0)" ::: "memory")
#define VM_WAIT() asm volatile("s_waitcnt vmcnt(0)" ::: "memory")
__device__ __forceinline__ unsigned long long rt() { return __builtin_amdgcn_s_memrealtime(); }
__device__ __forceinline__ unsigned f2bf(float f) { unsigned u = __builtin_bit_cast(unsigned, f); return (u + 0x7fffu + ((u >> 16) & 1u)) >> 16; }
__device__ __forceinline__ unsigned pk2(float lo, float hi) { return f2bf(lo) | (f2bf(hi) << 16); }

#define XB_TMO      128
#define XB_XCNT(j)  (256  + 64 * (j))
#define XB_XSUB(j)  (1280 + 64 * (j))
#define XB_XGEN(j)  (2304 + 64 * (j))
#define XB_TOP      3328
#define XB_TOPGEN   3392
#define XCD_BAR_WORDS 3456
#define XB_SPIN_CAP (1u << 18)

__device__ __forceinline__ unsigned xb_ld(unsigned* p)              { return __hip_atomic_load(p, __ATOMIC_RELAXED, __HIP_MEMORY_SCOPE_AGENT); }
__device__ __forceinline__ unsigned xb_add(unsigned* p, unsigned v) { return __hip_atomic_fetch_add(p, v, __ATOMIC_RELAXED, __HIP_MEMORY_SCOPE_AGENT); }
__device__ __forceinline__ unsigned xb_xcc_id() { return (unsigned)__builtin_amdgcn_s_getreg((3 << 11) | 20) & 0xFu; }
#define XB_SPIN(cond, bar) do { unsigned _sp = 0; while (cond) { __builtin_amdgcn_s_sleep(1); \
    if ((++_sp & 255u) == 0u) { if (xb_ld(&(bar)[XB_TMO])) break; if (_sp > XB_SPIN_CAP) { atomicAdd(&(bar)[XB_TMO], 1u); break; } } } } while (0)

struct XcdBarrier {
    unsigned* bar; unsigned x;
    volatile LAS unsigned* st;
};

__device__ __forceinline__ XcdBarrier xcd_barrier_post(unsigned* bar, volatile LAS unsigned* st) {
    XcdBarrier b; b.bar = bar; b.x = xb_xcc_id(); b.st = st;
    if (threadIdx.x == 0) (void)xb_add(&bar[XB_XCNT(b.x)], 1u);
    return b;
}
__device__ __forceinline__ void xcd_barrier_complete(unsigned* bar, unsigned x, unsigned& nloc, unsigned& nx) {
    const unsigned G = gridDim.x * gridDim.y * gridDim.z;
    unsigned sum, cnt, mine, sp = 0u;
    for (;;) {
        sum = 0u; cnt = 0u; mine = 0u;
#pragma unroll
        for (unsigned j = 0; j < 16; ++j) { const unsigned c = xb_ld(&bar[XB_XCNT(j)]); sum += c; cnt += (c > 0u) ? 1u : 0u; mine = (j == x) ? c : mine; }
        if (sum == G) break;
        __builtin_amdgcn_s_sleep(1);
        if ((++sp & 255u) == 0u) { if (xb_ld(&bar[XB_TMO])) break; if (sp > XB_SPIN_CAP) { atomicAdd(&bar[XB_TMO], 1u); break; } }
    }
    nloc = mine > 0u ? mine : 1u; nx = cnt > 0u ? cnt : 1u;
}

__device__ __forceinline__ void xcd_barrier(const XcdBarrier& b) {
    asm volatile("s_waitcnt vmcnt(0)" ::: "memory");
    __syncthreads();
    if (threadIdx.x == 0) {
        unsigned* bar = b.bar;
        __builtin_amdgcn_s_waitcnt(0);
        unsigned nloc = b.st[0], nx = b.st[1];
        if (nloc == 0u) { xcd_barrier_complete(bar, b.x, nloc, nx); b.st[0] = nloc; b.st[1] = nx; }
        const unsigned old = xb_add(&bar[XB_XSUB(b.x)], 1u);
        const unsigned gen = old / nloc;
        if (old + 1u == (gen + 1u) * nloc) {
            __builtin_amdgcn_fence(__ATOMIC_RELEASE, "agent");
            asm volatile("s_waitcnt vmcnt(0)" ::: "memory");
            const unsigned og = xb_add(&bar[XB_TOP], 1u);
            const unsigned tg = og / nx;
            if (og + 1u == (tg + 1u) * nx) xb_add(&bar[XB_TOPGEN], 1u);
            else XB_SPIN(xb_ld(&bar[XB_TOPGEN]) == tg, bar);
            __builtin_amdgcn_fence(__ATOMIC_ACQUIRE, "agent");
            xb_add(&bar[XB_XGEN(b.x)], 1u);
            asm volatile("s_waitcnt vmcnt(0)" ::: "memory");
        } else {
            XB_SPIN(xb_ld(&bar[XB_XGEN(b.x)]) == gen, bar);
            __builtin_amdgcn_fence(__ATOMIC_ACQUIRE, "agent");
            asm volatile("s_waitcnt vmcnt(0)" ::: "memory");
        }
    }
    __syncthreads();
}

typedef float f32x16 __attribute__((ext_vector_type(16)));
typedef short s16x4 __attribute__((ext_vector_type(4)));
typedef unsigned v2u __attribute__((ext_vector_type(2)));
using pg8::cvt_pk_bf16; using pg8::bf_lo; using pg8::bf_hi; using pg8::sigmoidf_; using pg8::f32x2;
#define WS_DPP(v_, ctrl_) (v_ + __builtin_bit_cast(float, __builtin_amdgcn_update_dpp(0, __builtin_bit_cast(int, v_), (ctrl_), 0xf, 0xf, false)))
__device__ __forceinline__ float wave_sum(float v) {
    v = WS_DPP(v, 0xB1);
    v = WS_DPP(v, 0x4E);
    v = WS_DPP(v, 0x141);
    v = WS_DPP(v, 0x140);
    { auto rr = __builtin_amdgcn_permlane16_swap(__float_as_uint(v), __float_as_uint(v), false, false); v = __uint_as_float(rr[0]) + __uint_as_float(rr[1]); }
    { auto rr = __builtin_amdgcn_permlane32_swap(__float_as_uint(v), __float_as_uint(v), false, false); v = __uint_as_float(rr[0]) + __uint_as_float(rr[1]); }
    return v;
}
#define LBAR() do { asm volatile("s_waitcnt lgkmcnt(0)" ::: "memory"); __builtin_amdgcn_s_barrier(); asm volatile("" ::: "memory"); } while (0)
__device__ __forceinline__ float dot4(f32x4 a, f32x4 b) { return (a.x * b.x + a.y * b.y) + (a.z * b.z + a.w * b.w); }

struct MapIn { bf16* win; bf16* wmg;
    __device__ __forceinline__ bf16* operator()(int n) const {
        if (n < 3072) return win + (size_t)n * D;
        if (n < 3088) return nullptr;
        if (n < 5136) { const int c = n - 3088, blk = c >> 6, d = c & 63, g = (d & 31) >> 2, e = (d & 3) + ((d >> 5) << 2); return win + (size_t)(3072 + blk * 64 + 8 * g + e) * D; }
        if (n < 6160) return win + (size_t)(5120 + n - 5136) * D;
        const int c = n - 6160, j = c & 1023, half = c >> 10; return wmg + (size_t)(256 * (j >> 7) + 128 * half + (j & 127)) * D; } };
struct MapPlain { bf16* w; int K;
    __device__ __forceinline__ bf16* operator()(int n) const { return w + (size_t)n * K; } };
struct MapIl { bf16* w; int half;
    __device__ __forceinline__ bf16* operator()(int n) const { return w + (size_t)(256 * (n >> 7) + 128 * half + (n & 127)) * D; } };
struct TItem { const float* W; int K, N, it, kind, e; };
__device__ __forceinline__ void titem_load(const TItem& t, int lane, float (&r)[32]) {
    const int nblk = (t.N + 31) / 32, kb = t.it / nblk, nb = t.it % nblk, k0 = 64 * kb; int nn = 32 * nb + (lane & 31); nn = nn < t.N ? nn : t.N - 1;
    const float* p = t.W + (size_t)(k0 + (lane >> 5)) * t.N + nn;
#pragma unroll
    for (int i = 0; i < 32; ++i) r[i] = p[(size_t)(2 * i) * t.N];
}
template <class MapFn>
__device__ __forceinline__ void titem_store_map(const TItem& t, const float (&r)[32], LAS float* scr, int lane, const MapFn& map) {
    const int nblk = (t.N + 31) / 32, kb = t.it / nblk, nb = t.it % nblk, k0 = 64 * kb, n0 = 32 * nb;
#pragma unroll
    for (int i = 0; i < 32; ++i) scr[(2 * i + (lane >> 5)) * 33 + (lane & 31)] = r[i];
    LDS_WAIT(); asm volatile("" ::: "memory");
    const int c = lane & 7;
#pragma unroll
    for (int j = 0; j < 4; ++j) { const int nl = (lane >> 3) + 8 * j; const LAS float* s = scr + (8 * c) * 33 + nl;
        v4u o; o.x = cvt_pk_bf16(s[0 * 33], s[1 * 33]); o.y = cvt_pk_bf16(s[2 * 33], s[3 * 33]); o.z = cvt_pk_bf16(s[4 * 33], s[5 * 33]); o.w = cvt_pk_bf16(s[6 * 33], s[7 * 33]);
        if (n0 + nl < t.N) { bf16* dst = map(n0 + nl); if (dst) *(GAS v4u*)(dst + k0 + 8 * c) = o; } }
    LDS_WAIT(); asm volatile("" ::: "memory");
}

struct Ptrs {
    const float *x, *c, *w_ada, *b_ada, *w_in, *wg2, *bg2, *gnw, *lq1, *lk1, *lq2, *lk2, *dnw, *w_out, *ln1w, *ln1b, *wrg, *brg, *wre, *bre, *weg, *weu, *wed, *ln2w, *ln2b;
    const int* pos;
    float* out;
    float *ada, *wrt, *tokw, *roww, *dt, *hst;
    int *cnt, *tab, *toke, *rowtok;
    bf16 *win, *wmg, *wout, *wgu, *wd, *u, *act, *hbuf, *mout, *dqk;
    unsigned* dbg;
    unsigned char* gates;
};

constexpr int TI_IN = 16 * 257, TI_OUT = 16 * 32, TI_E = 16 * 16, TI_D = 8 * 32;
constexpr int TI_DENSE = TI_IN + TI_OUT, TI_ALL = TI_DENSE + NEXP * (2 * TI_E + TI_D);
__device__ __forceinline__ void transpose_items(const Ptrs& P, LAS unsigned char* lds, int gw, int NGW, int lane, int wave, int lo, int hi) {
    LAS float* scr = (LAS float*)(lds + RING_OFF + wave * 16384);
#define P0_DECODE(t_, idx_) do { int r_ = (idx_); \
        if (r_ < TI_IN) { t_ = TItem{P.w_in, D, IN_COLS, r_, 0, 0}; } else { r_ -= TI_IN; \
        if (r_ < TI_OUT) { t_ = TItem{P.w_out, D, D, r_, 1, 0}; } else { r_ -= TI_OUT; \
        if (r_ < NEXP * TI_E) { t_ = TItem{P.weg + (size_t)(r_ / TI_E) * D * FF, D, FF, r_ % TI_E, 2, r_ / TI_E}; } else { r_ -= NEXP * TI_E; \
        if (r_ < NEXP * TI_E) { t_ = TItem{P.weu + (size_t)(r_ / TI_E) * D * FF, D, FF, r_ % TI_E, 3, r_ / TI_E}; } else { r_ -= NEXP * TI_E; \
        t_ = TItem{P.wed + (size_t)(r_ / TI_D) * FF * D, FF, D, r_ % TI_D, 4, r_ / TI_D}; } } } } } while (0)
#define P0_STORE(t_, r_) do { \
        if (t_.kind == 0) titem_store_map(t_, r_, scr, lane, MapIn{P.win, P.wmg}); \
        else if (t_.kind == 1) titem_store_map(t_, r_, scr, lane, MapPlain{P.wout, D}); \
        else if (t_.kind == 2) titem_store_map(t_, r_, scr, lane, MapIl{P.wgu + (size_t)t_.e * 1024 * D, 0}); \
        else if (t_.kind == 3) titem_store_map(t_, r_, scr, lane, MapIl{P.wgu + (size_t)t_.e * 1024 * D, 1}); \
        else titem_store_map(t_, r_, scr, lane, MapPlain{P.wd + (size_t)t_.e * D * FF, FF}); } while (0)
    int it = lo + gw; TItem ta{}, tb{}; float ra[32], rb[32];
    if (it < hi) { P0_DECODE(ta, it); titem_load(ta, lane, ra); }
    while (it < hi) {
        const int it2 = it + NGW; if (it2 < hi) { P0_DECODE(tb, it2); titem_load(tb, lane, rb); }
        P0_STORE(ta, ra);
        it = it2; if (it >= hi) break;
        const int it3 = it + NGW; if (it3 < hi) { P0_DECODE(ta, it3); titem_load(ta, lane, ra); }
        P0_STORE(tb, rb);
        it = it3;
    }
#undef P0_DECODE
#undef P0_STORE
}

__device__ __forceinline__ void p0_prologue(const Ptrs& P, LAS unsigned char* lds, int vcu, int G, int tid, int lane, int wave) {
#ifndef P0PROBE
#define P0PROBE 0
#endif
    unsigned long long p0t = 0ull; if (P0PROBE && blockIdx.x == 0 && tid == 0) p0t = __builtin_amdgcn_s_memrealtime();
    if (vcu < 192) {
        LAS float* sc = (LAS float*)(lds + RING_OFF);
        LAS float* red = (LAS float*)(lds + RING_OFF + 32768);
        for (int i = tid; i < 8 * D; i += NWAVES * 64) { const float v = P.c[i]; sc[i] = v / (1.f + __expf(-v)); }
        __syncthreads();
        for (int item = vcu; item < 192; item += G) {
            const int col = item * 32 + (tid & 31), kg = tid >> 5;
            float a[8];
#pragma unroll
            for (int b = 0; b < 8; ++b) a[b] = 0.f;
#pragma unroll 16
            for (int i = 0; i < 64; ++i) { const int k = kg + 16 * i; const float w = P.w_ada[(size_t)k * (6 * D) + col];
#pragma unroll
                for (int b = 0; b < 8; ++b) a[b] += sc[b * D + k] * w; }
#pragma unroll
            for (int b = 0; b < 8; ++b) red[(kg * 8 + b) * 32 + (tid & 31)] = a[b];
            __syncthreads();
            if (tid < 256) { const int b = tid >> 5, cc = tid & 31; float s = 0.f;
#pragma unroll
                for (int q = 0; q < 16; ++q) s += red[(q * 8 + b) * 32 + cc];
                P.ada[(size_t)b * (6 * D) + item * 32 + cc] = s + P.b_ada[item * 32 + cc]; }
            __syncthreads();
        }
    }
    if (P0PROBE && blockIdx.x == 0 && tid == 0) __hip_atomic_store(P.dbg, (unsigned)(__builtin_amdgcn_s_memrealtime() - p0t), RLX_AGENT);
    const int gt = vcu * (NWAVES * 64) + tid, NT = G * NWAVES * 64;
    for (int i = gt; i < 36 * D; i += NT) { const int cc = i >> 10, k = i & 1023; P.wrt[i] = cc < 4 ? P.wrg[k * 4 + cc] : P.wre[k * 32 + (cc - 4)]; }
    transpose_items(P, lds, vcu * NWAVES + wave, G * NWAVES, lane, wave, 0, TI_DENSE);
}

namespace p1n { constexpr int U_LD = 1032, WAVE_BYTES = 4 * U_LD * 2, L_BF = 8 * WAVE_BYTES; static_assert(L_BF + 32 * 64 * 16 <= RING_BYTES, "P1 LDS map"); }
__device__ __forceinline__ void p1_ln_mod(const Ptrs& P, LAS unsigned char* lds, int gw, int NGW, int lane, int wave) {
    LAS bf16* UW = (LAS bf16*)(lds + RING_OFF + wave * p1n::WAVE_BYTES);
    const int fr = lane & 15, fq = lane >> 4;
    LAS v4u* BF = (LAS v4u*)(lds + RING_OFF + p1n::L_BF);
#pragma unroll
    for (int ss = 0; ss < 4; ++ss) { const int s = wave * 4 + ss, k0 = 32 * s + 8 * fq; unsigned hw[4];
#pragma unroll
        for (int j = 0; j < 8; j += 2) hw[j >> 1] = cvt_pk_bf16(P.w_in[(size_t)(k0 + j) * IN_COLS + 3072 + fr], P.w_in[(size_t)(k0 + j + 1) * IN_COLS + 3072 + fr]);
        BF[s * 64 + lane] = (v4u){hw[0], hw[1], hw[2], hw[3]}; }
    __syncthreads();
    for (int blk = gw; blk < T / 16; blk += NGW) {
        const int m0 = blk * 16, b = m0 / SEQ;
        f32x4 sh[4], sl[4];
#pragma unroll
        for (int j = 0; j < 4; ++j) { sh[j] = *((const f32x4*)(P.ada + (size_t)b * 6 * D) + lane + 64 * j); sl[j] = *((const f32x4*)(P.ada + (size_t)b * 6 * D + D) + lane + 64 * j) + 1.f; }
        f32x4 pre[4][4];
#pragma unroll
        for (int rr = 0; rr < 4; ++rr)
#pragma unroll
            for (int j = 0; j < 4; ++j) pre[rr][j] = *((const GAS f32x4*)(P.x + (size_t)(m0 + rr) * D) + lane + 64 * j);
#pragma unroll 1
        for (int g4 = 0; g4 < 4; ++g4) {
#pragma unroll
            for (int rr = 0; rr < 4; ++rr) {
                const int m = m0 + 4 * g4 + rr;
                f32x4 v[4]; float s = 0.f;
#pragma unroll
                for (int j = 0; j < 4; ++j) { v[j] = pre[rr][j]; s += (v[j].x + v[j].y) + (v[j].z + v[j].w); }
                if (g4 < 3) {
#pragma unroll
                    for (int j = 0; j < 4; ++j) pre[rr][j] = *((const GAS f32x4*)(P.x + (size_t)(m + 4) * D) + lane + 64 * j); }
                const float mean = wave_sum(s) * (1.f / D); float s2 = 0.f;
#pragma unroll
                for (int j = 0; j < 4; ++j) { v[j] = v[j] - mean; s2 += dot4(v[j], v[j]); }
                const float rstd = 1.f / sqrtf(wave_sum(s2) * (1.f / D) + LN_EPS);
                GAS v2u* o8 = (GAS v2u*)(P.u + (size_t)m * D) + lane;
#pragma unroll
                for (int j = 0; j < 4; ++j) { const f32x4 uu = v[j] * rstd * sl[j] + sh[j];
                    v2u w; w.x = cvt_pk_bf16(uu.x, uu.y); w.y = cvt_pk_bf16(uu.z, uu.w); o8[64 * j] = w; *(LAS v2u*)(UW + rr * p1n::U_LD + 4 * lane + 256 * j) = w; }
            }
            asm volatile("s_waitcnt lgkmcnt(0)" ::: "memory");
            f32x4 acc = (f32x4){0.f, 0.f, 0.f, 0.f};
#pragma unroll
            for (int s = 0; s < 32; ++s) { const bf16x8 a = *(const LAS bf16x8*)(UW + (fr & 3) * p1n::U_LD + 32 * s + 8 * fq); const bf16x8 bb = __builtin_bit_cast(bf16x8, BF[s * 64 + lane]); acc = __builtin_amdgcn_mfma_f32_16x16x32_bf16(a, bb, acc, 0, 0, 0); }
            if (fq == 0) {
#pragma unroll
                for (int g = 0; g < 4; ++g) P.act[(size_t)(m0 + 4 * g4 + g) * ACT_LD + AC_GR + fr] = (bf16)f2bf(acc[g]); }
            asm volatile("s_waitcnt lgkmcnt(0)" ::: "memory");
        }
    }
}

namespace gla {
constexpr int QT_LD = 136, KD_LD = 72, AT_LD = 72, OS_LD = 264;
constexpr int L_QT = 0, L_KT = L_QT + 64 * QT_LD * 2, L_KDT = L_KT + 64 * QT_LD * 2, L_VB = L_KDT + 128 * KD_LD * 2, L_AT = L_VB + 32768, L_KRAW = L_AT + 64 * AT_LD * 2, L_QRAW = L_KRAW + 16384, L_ENDC = L_QRAW + 16384, L_OS = 0;
constexpr int A_KDT = 0, A_VB = A_KDT + 128 * KD_LD * 2, A_KRAW = A_VB + 2 * 32768, A_END = A_KRAW + 2 * 16384;
constexpr int X_GL = ROWS_OFF, X_NW = X_GL + 2 * 2048, X_DEC = X_NW + 1024, X_END = X_DEC + 512;
static_assert(L_ENDC <= RING_BYTES && A_END <= RING_BYTES && 64 * OS_LD * 2 <= L_KDT && X_END <= LDS_BYTES, "GLA LDS map");
__device__ __forceinline__ int crow(int reg, int h) { return (reg & 3) + 8 * (reg >> 2) + 4 * h; }
__device__ __forceinline__ float fexp(float x) { return __builtin_amdgcn_exp2f(x * 1.4426950408889634f); }
__device__ __forceinline__ float flog(float x) { return __builtin_amdgcn_logf(x) * 0.6931471805599453f; }
__device__ __forceinline__ unsigned bf1(float x) { return cvt_pk_bf16(x, x) & 0xffffu; }
__device__ __forceinline__ unsigned vswz(unsigned row) { return ((row & 3) << 2) | ((row >> 2) & 3); }
__device__ __forceinline__ unsigned voff_b(unsigned row, unsigned ch) { return 256u * row + 16u * (ch ^ vswz(row)); }
__device__ __forceinline__ unsigned vtr_addr(unsigned lane, unsigned c, unsigned ks, unsigned t) {
    const unsigned h = lane >> 5, blk = (lane >> 4) & 1, q = (lane & 15) >> 2, p = lane & 3;
    return voff_b(16 * ks + 8 * h + 4 * t + q, 4 * c + 2 * blk + (p >> 1)) + 8 * (p & 1);
}
typedef short v4i16_t __attribute__((ext_vector_type(4)));
__device__ __forceinline__ void glds16(const void* gsrc, unsigned lds_dst) { unsigned keep;
    asm volatile("s_mov_b32 %0, m0\n\ts_mov_b32 m0, %2\n\ts_nop 0\n\tglobal_load_lds_dwordx4 %1, off\n\ts_mov_b32 m0, %0" : "=&s"(keep) : "v"(gsrc), "s"(lds_dst) : "memory"); }
#define GLA_LDSA(p_) ((unsigned)__builtin_amdgcn_readfirstlane((int)(unsigned)(size_t)(p_)))
#define MFMA32(a, b, c) __builtin_amdgcn_mfma_f32_32x32x16_bf16((a), (b), (c), 0, 0, 0)
#define MFMA16(a, b, c) __builtin_amdgcn_mfma_f32_16x16x32_bf16((a), (b), (c), 0, 0, 0)
template <bool OUT>
__device__ __forceinline__ void gla_unit(LAS unsigned char* lds, const Ptrs& P, int b, int h, int sc) {
    const int tid = threadIdx.x, lane0 = tid & 63, wid = __builtin_amdgcn_readfirstlane(tid >> 6);
#define GLA_LANE_VARS int lanev_ = lane0; asm volatile("" : "+v"(lanev_)); const int lane = lanev_, r = lane & 31, hh = lane >> 5, fr = lane & 15, fq = lane >> 4, col = 16 * wid + fr; (void)r; (void)hh; (void)fr; (void)fq; (void)col
    LAS bf16* QT = (LAS bf16*)(lds + L_QT); LAS bf16* KT = (LAS bf16*)(lds + L_KT); LAS bf16* KDT = (LAS bf16*)(lds + (OUT ? L_KDT : A_KDT)); LAS bf16* AT = (LAS bf16*)(lds + L_AT); LAS bf16* OS = (LAS bf16*)(lds + L_OS);
    LAS unsigned char* VB0 = lds + (OUT ? L_VB : A_VB); LAS unsigned char* KRAW0 = lds + (OUT ? L_KRAW : A_KRAW); LAS unsigned char* QRAW = lds + L_QRAW;
    LAS unsigned char* GLRAW0 = lds - RING_OFF + X_GL; LAS float* NW = (LAS float*)(lds - RING_OFF + X_NW); LAS float* DEC = (LAS float*)(lds - RING_OFF + X_DEC);
    bf16* act = P.act;
    float bias; bf16x8 bh, bl;
    { GLA_LANE_VARS;
        bias = P.bg2[h * 128 + col];
        unsigned hw[4], lw[4];
#pragma unroll
        for (int j = 0; j < 8; j += 2) { const float m_ = fq < 2 ? 1.f : 0.f; const float w0 = P.wg2[(8 * (fq & 1) + j) * 512 + h * 128 + col] * m_, w1 = P.wg2[(8 * (fq & 1) + j + 1) * 512 + h * 128 + col] * m_;
            const unsigned hp = cvt_pk_bf16(w0, w1); hw[j >> 1] = hp; lw[j >> 1] = cvt_pk_bf16(w0 - bf_lo(hp), w1 - bf_hi(hp)); }
        bh = __builtin_bit_cast(bf16x8, (v4u){hw[0], hw[1], hw[2], hw[3]}); bl = __builtin_bit_cast(bf16x8, (v4u){lw[0], lw[1], lw[2], lw[3]}); }
    if (OUT && tid < 256) NW[tid] = P.gnw[tid];
    const int bhs = (b * 4 + h) * 8 + sc;
    float* Hp = P.hst + (size_t)bhs * (128 * 256);
    float dsum = 0.f;
    v4u pgo[4]; v2u pga[4];
    const size_t rowu = (size_t)b * SEQ + sc * 512;
    unsigned okq[2], ov_[4], og_ = 0u, ogo_ = 0u, oga_ = 0u;
    { GLA_LANE_VARS;
#pragma unroll
        for (int pp_ = 0; pp_ < 2; ++pp_) okq[pp_] = (unsigned)((4 * (wid + 8 * pp_) + (lane >> 4)) * ACT_LD + h * 128 + (lane & 15) * 8) * 2u;
#pragma unroll
        for (int pp_ = 0; pp_ < 4; ++pp_) { const int q_ = wid + 8 * pp_, t_ = q_ >> 3; const unsigned rin_ = 4 * (q_ & 7) + (lane >> 4), chin_ = (lane & 15) ^ vswz(rin_);
            ov_[pp_] = (unsigned)((32 * (t_ >> 1) + rin_) * ACT_LD + AC_GV + h * 256 + (16 * (t_ & 1) + chin_) * 8) * 2u; }
        og_ = (unsigned)((32 * wid + (lane >> 1)) * ACT_LD + AC_GR + (lane & 1) * 8) * 2u;
        ogo_ = (unsigned)((8 * wid + (lane >> 3)) * ACT_LD + AC_GO + h * 256 + (lane & 7) * 8) * 2u;
        oga_ = (unsigned)((8 * wid + (lane >> 3)) * 2048 + h * 256 + (lane & 7) * 8); }
#define GLA_CBASE(n_) ((const char*)act + (rowu + (size_t)(n_) * 64) * (ACT_LD * 2))
#define GLA_DMA_KQ(n_, dst_, ac_) do { const char* cb_ = GLA_CBASE(n_) + (ac_) * 2; \
        _Pragma("unroll") for (int pp_ = 0; pp_ < 2; ++pp_) glds16(cb_ + okq[pp_], GLA_LDSA((dst_) + (wid + 8 * pp_) * 1024)); } while (0)
#define GLA_DMA_V(n_, dst_) do { const char* cb_ = GLA_CBASE(n_); \
        _Pragma("unroll") for (int pp_ = 0; pp_ < 4; ++pp_) glds16(cb_ + ov_[pp_], GLA_LDSA((dst_) + (wid + 8 * pp_) * 1024)); } while (0)
#define GLA_DMA_G(n_, dst_) do { if (wid < 2) glds16(GLA_CBASE(n_) + og_, GLA_LDSA((dst_) + wid * 1024)); } while (0)
    f32x16 S[4];
    { GLA_LANE_VARS;
        GLA_DMA_KQ(0, KRAW0, AC_GK); if (OUT) GLA_DMA_KQ(0, QRAW, AC_GQ); GLA_DMA_G(0, GLRAW0); GLA_DMA_V(0, VB0);
#pragma unroll
        for (int i = 0; i < 4; ++i) { const float* hp = Hp + (size_t)(32 * i + 4 * hh) * 256 + 32 * wid + r;
#pragma unroll
            for (int g = 0; g < 16; ++g) S[i][g] = OUT ? hp[((g & 3) + 8 * (g >> 2)) * 256] : 0.f;
            asm volatile("" ::: "memory"); } }
    asm volatile("s_waitcnt vmcnt(0)" ::: "memory");
    LBAR();
#ifndef GPROBE_K
#define GPROBE_K -1
#endif
    unsigned long long gacc = 0ull, gt0 = 0ull; const bool gstamp = OUT && GPROBE_K >= 0 && blockIdx.x == 0 && tid == 0;
#define GST(k_) do { if (gstamp) { const unsigned long long t_ = __builtin_amdgcn_s_memrealtime(); if ((k_) == GPROBE_K) gt0 = t_; if ((k_) == GPROBE_K + 1) gacc += t_ - gt0; } } while (0)
    for (int n = 0; n < 8; ++n) {
        GLA_LANE_VARS;
        GST(0);
        size_t row0 = rowu + n * 64; asm volatile("" : "+s"(row0));
        const int bsel = OUT ? 0 : (n & 1);
        LAS unsigned char* KB = KRAW0 + bsel * 16384; LAS unsigned char* GB = GLRAW0 + bsel * 2048; LAS unsigned char* VB = VB0 + bsel * 32768;
        if (!OUT && n + 1 < 8) { GLA_DMA_KQ(n + 1, KRAW0 + (bsel ^ 1) * 16384, AC_GK); GLA_DMA_G(n + 1, GLRAW0 + (bsel ^ 1) * 2048); GLA_DMA_V(n + 1, VB0 + (bsel ^ 1) * 32768); }
        bf16x8 bv[4];
#pragma unroll
        for (int ks = 0; ks < 4; ++ks) { LAS unsigned char* tb = VB + ((ks >> 1) * 2 + (wid >> 2)) * 8192;
            const v4i16_t lo = __builtin_amdgcn_ds_read_tr16_b64_v4i16((LAS v4i16_t*)(tb + vtr_addr(lane, wid & 3, ks & 1, 0))), hi = __builtin_amdgcn_ds_read_tr16_b64_v4i16((LAS v4i16_t*)(tb + vtr_addr(lane, wid & 3, ks & 1, 1)));
            bv[ks] = __builtin_shufflevector(lo, hi, 0, 1, 2, 3, 4, 5, 6, 7); }
        f32x4 lg[4];
#pragma unroll
        for (int mi = 0; mi < 4; ++mi) { const bf16x8 a = *(const LAS bf16x8*)(GB + (16 * mi + fr) * 32 + (fq & 1) * 16);
            lg[mi] = MFMA16(a, bh, ((f32x4){bias, bias, bias, bias})); lg[mi] = MFMA16(a, bl, lg[mi]); }
        float bq[4][4]; float run = 0.f;
#pragma unroll
        for (int mi = 0; mi < 4; ++mi) { float c = 0.f;
#pragma unroll
            for (int g = 0; g < 4; ++g) { const float l = lg[mi][g]; c += (fminf(l, 0.f) - flog(1.f + fexp(-fabsf(l)))) * (1.f / 16.f); bq[mi][g] = c; }
            const float p1 = __shfl_xor(c, 16), pp = c + p1, p2 = __shfl_xor(pp, 32);
            const float base = run + ((fq & 1) ? p1 : 0.f) + ((fq & 2) ? p2 : 0.f);
#pragma unroll
            for (int g = 0; g < 4; ++g) bq[mi][g] += base;
            run += pp + p2; }
        const float tot = run, etot = fexp(tot);
#pragma unroll
        for (int mi = 0; mi < 4; ++mi) { float kd[4];
#pragma unroll
            for (int g = 0; g < 4; ++g) { const int row = 16 * mi + 4 * fq + g; const float bi = bq[mi][g];
                const float kraw = __uint_as_float((unsigned)(*(const LAS bf16*)(KB + (row * 128 + col) * 2)) << 16);
                const float kt = kraw * fexp(-bi);
                kd[g] = kt * etot;
                if (OUT) { const float qraw = __uint_as_float((unsigned)(*(const LAS bf16*)(QRAW + (row * 128 + col) * 2)) << 16);
                    QT[row * QT_LD + col] = (bf16)bf1(qraw * 0.08838834764831845f * fexp(bi)); KT[row * QT_LD + col] = (bf16)bf1(kt); } }
            *(LAS v2u*)(KDT + col * KD_LD + 16 * mi + 4 * fq) = (v2u){cvt_pk_bf16(kd[0], kd[1]), cvt_pk_bf16(kd[2], kd[3])}; }
        if (fq == 0) DEC[col] = etot;
        dsum += tot;
        LBAR();
        GST(1);
        f32x16 o[2];
        if (OUT) {
#pragma unroll
            for (int tt = 0; tt < 2; ++tt) { const int t = 2 * wid + tt, mi = t >> 2, nj = t & 3; f32x4 a4 = (f32x4){0.f, 0.f, 0.f, 0.f};
                if (nj <= mi) {
#pragma unroll
                    for (int s = 0; s < 4; ++s) { const bf16x8 a = *(const LAS bf16x8*)(QT + (16 * mi + fr) * QT_LD + 32 * s + 8 * fq); const bf16x8 bb = *(const LAS bf16x8*)(KT + (16 * nj + fr) * QT_LD + 32 * s + 8 * fq); a4 = MFMA16(a, bb, a4); } }
#pragma unroll
                for (int g = 0; g < 4; ++g) { const int row = 16 * mi + 4 * fq + g, cc = 16 * nj + fr; AT[row * AT_LD + cc] = (bf16)bf1(cc <= row ? a4[g] : 0.f); } }
            LBAR();
            GST(2);
            const bool more = n + 1 < 8;
            if (more) GLA_DMA_KQ(n + 1, KRAW0, AC_GK);
#pragma unroll
            for (int mt = 0; mt < 2; ++mt) {
#pragma unroll
                for (int g = 0; g < 16; ++g) o[mt][g] = 0.f;
#pragma unroll
                for (int ks = 0; ks < 4; ++ks) if (mt == 1 || ks < 2) { const bf16x8 a = *(const LAS bf16x8*)(AT + (32 * mt + r) * AT_LD + 16 * ks + 8 * hh); o[mt] = MFMA32(a, bv[ks], o[mt]); }
            }
            if (more) { GLA_DMA_KQ(n + 1, QRAW, AC_GQ); GLA_DMA_G(n + 1, GLRAW0); }
#pragma unroll
            for (int i = 0; i < 4; ++i) {
                bf16x8 sp[2];
#pragma unroll
                for (int s = 0; s < 2; ++s) { v4u w; w.x = cvt_pk_bf16(S[i][8 * s + 0], S[i][8 * s + 1]); w.y = cvt_pk_bf16(S[i][8 * s + 2], S[i][8 * s + 3]); w.z = cvt_pk_bf16(S[i][8 * s + 4], S[i][8 * s + 5]); w.w = cvt_pk_bf16(S[i][8 * s + 6], S[i][8 * s + 7]); sp[s] = __builtin_bit_cast(bf16x8, w); }
#pragma unroll
                for (int mt = 0; mt < 2; ++mt)
#pragma unroll
                    for (int s = 0; s < 2; ++s) { const s16x4 lo = *(const LAS s16x4*)(QT + (32 * mt + r) * QT_LD + 32 * i + 16 * s + 4 * hh); const s16x4 hi = *(const LAS s16x4*)(QT + (32 * mt + r) * QT_LD + 32 * i + 16 * s + 8 + 4 * hh);
                        const bf16x8 a = __builtin_shufflevector(lo, hi, 0, 1, 2, 3, 4, 5, 6, 7); o[mt] = MFMA32(a, sp[s], o[mt]); }
                if (i == 1 && more) GLA_DMA_V(n + 1, VB0);
            }
            { const char* gop = GLA_CBASE(n) + ogo_;
#pragma unroll
                for (int q4 = 0; q4 < 4; ++q4) pgo[q4] = *(const GAS v4u*)(gop + q4 * 128);
                const unsigned char* gap = P.gates + (rowu + (size_t)n * 64) * 2048 + oga_;
#pragma unroll
                for (int q4 = 0; q4 < 4; ++q4) pga[q4] = *(const GAS v2u*)(gap + q4 * 64); }
        }
#pragma unroll
        for (int i = 0; i < 4; ++i) {
#pragma unroll
            for (int g = 0; g < 16; ++g) S[i][g] *= DEC[32 * i + crow(g, hh)];
#pragma unroll
            for (int ks = 0; ks < 4; ++ks) { const bf16x8 a = *(const LAS bf16x8*)(KDT + (32 * i + r) * KD_LD + 16 * ks + 8 * hh); S[i] = MFMA32(a, bv[ks], S[i]); }
        }
        if (!OUT) { asm volatile("s_waitcnt vmcnt(0)" ::: "memory"); LBAR(); }
        if (OUT) {
            LBAR();
            GST(3);
#pragma unroll
            for (int mt = 0; mt < 2; ++mt)
#pragma unroll
                for (int g = 0; g < 16; ++g) OS[(32 * mt + crow(g, hh)) * OS_LD + 32 * wid + r] = (bf16)bf1(o[mt][g]);
            LBAR();
            GST(4);
            asm volatile("s_waitcnt vmcnt(0)" ::: "memory");
            const int rowl = 8 * wid + (lane >> 3), part = lane & 7; const LAS bf16* orow = OS + rowl * OS_LD + part * 8;
            f32x4 ov[8]; float ss = 0.f;
#pragma unroll
            for (int q4 = 0; q4 < 4; ++q4) { const v4u w = *(const LAS v4u*)(orow + 64 * q4); ov[2 * q4] = (f32x4){bf_lo(w.x), bf_hi(w.x), bf_lo(w.y), bf_hi(w.y)}; ov[2 * q4 + 1] = (f32x4){bf_lo(w.z), bf_hi(w.z), bf_lo(w.w), bf_hi(w.w)};
                ss += dot4(ov[2 * q4], ov[2 * q4]) + dot4(ov[2 * q4 + 1], ov[2 * q4 + 1]); }
            ss += __shfl_xor(ss, 1); ss += __shfl_xor(ss, 2); ss += __shfl_xor(ss, 4);
            const float rstd = 1.f / sqrtf(ss * (1.f / 256.f) + RMS_EPS);
            bf16* orp = act + (row0 + rowl) * ACT_LD + AC_OGLA + h * 256 + part * 8; const LAS float* nw = NW + part * 8;
#pragma unroll
            for (int q4 = 0; q4 < 4; ++q4) { const v4u gg = pgo[q4]; const f32x4 w0 = *(const LAS f32x4*)(nw + q4 * 64), w1 = *(const LAS f32x4*)(nw + q4 * 64 + 4); const v2u gb_ = pga[q4];
                const f32x4 ga0 = (f32x4){(float)(gb_.x & 0xffu), (float)((gb_.x >> 8) & 0xffu), (float)((gb_.x >> 16) & 0xffu), (float)(gb_.x >> 24)} * (1.f / 255.f), ga1 = (f32x4){(float)(gb_.y & 0xffu), (float)((gb_.y >> 8) & 0xffu), (float)((gb_.y >> 16) & 0xffu), (float)(gb_.y >> 24)} * (1.f / 255.f);
                const f32x4 a0 = ov[2 * q4] * rstd * w0 * ga0, a1 = ov[2 * q4 + 1] * rstd * w1 * ga1;
                const float g0 = bf_lo(gg.x), g1 = bf_hi(gg.x), g2 = bf_lo(gg.y), g3 = bf_hi(gg.y), g4 = bf_lo(gg.z), g5 = bf_hi(gg.z), g6 = bf_lo(gg.w), g7 = bf_hi(gg.w);
                v4u w; w.x = cvt_pk_bf16(a0.x * g0 * sigmoidf_(g0), a0.y * g1 * sigmoidf_(g1)); w.y = cvt_pk_bf16(a0.z * g2 * sigmoidf_(g2), a0.w * g3 * sigmoidf_(g3));
                w.z = cvt_pk_bf16(a1.x * g4 * sigmoidf_(g4), a1.y * g5 * sigmoidf_(g5)); w.w = cvt_pk_bf16(a1.z * g6 * sigmoidf_(g6), a1.w * g7 * sigmoidf_(g7));
                *(GAS v4u*)(orp + q4 * 64) = w; }
            LBAR();
            GST(5);
        }
    }
    if (gstamp) __hip_atomic_store(P.dbg, (unsigned)gacc, RLX_AGENT);
#undef GST
#undef GLA_DMA_KQ
#undef GLA_DMA_V
#undef GLA_DMA_G
#undef GLA_CBASE
    if (!OUT) { GLA_LANE_VARS;
#pragma unroll
        for (int i = 0; i < 4; ++i)
#pragma unroll
            for (int g = 0; g < 16; ++g) Hp[(32 * i + crow(g, hh)) * 256 + 32 * wid + r] = S[i][g];
        if (fq == 0) P.dt[bhs * 128 + col] = fexp(dsum);
    }
#undef GLA_LANE_VARS
}
__device__ __forceinline__ void gla_scan(const Ptrs& P, int gt, int NT) {
    for (int v = gt; v < 32 * 128 * 64; v += NT) {
        const int bh = v >> 13, rem = v & 8191, dk = rem >> 6, dv4 = rem & 63;
        f32x4 s = (f32x4){0.f, 0.f, 0.f, 0.f};
#pragma unroll
        for (int sc = 0; sc < 8; ++sc) { GAS f32x4* p = (GAS f32x4*)(P.hst + ((size_t)(bh * 8 + sc) * 128 + dk) * 256) + dv4;
            f32x4 hv = (f32x4){0.f, 0.f, 0.f, 0.f}; float dd = 0.f; if (sc < 7) { hv = *p; dd = P.dt[(bh * 8 + sc) * 128 + dk]; }
            *p = s; s = s * dd + hv; }
    }
}
#undef MFMA32
#undef MFMA16
}

__device__ __forceinline__ void p7_combine(const Ptrs& P, int gw, int NGW, int lane) {
    const float s1 = wave_sum(P.lq1[lane] * P.lk1[lane]), s2 = wave_sum(P.lq2[lane] * P.lk2[lane]);
    const float lam = expf(s1) - expf(s2) + LAM_INIT;
    f32x4 nw[4];
#pragma unroll
    for (int q = 0; q < 4; ++q) nw[q] = *(const f32x4*)(P.dnw + ((16 * lane) & 127) + 4 * q) * (1.f - LAM_INIT);
    for (int m = gw; m < T; m += NGW) {
        bf16* rp = P.act + (size_t)m * ACT_LD + 16 * lane;
        const v4u a0 = *(const GAS v4u*)(rp + AC_O1), a1 = *(const GAS v4u*)(rp + AC_O1 + 8), b0 = *(const GAS v4u*)(rp + AC_O2), b1 = *(const GAS v4u*)(rp + AC_O2 + 8);
        float v[16];
        v[0] = bf_lo(a0.x) - lam * bf_lo(b0.x); v[1] = bf_hi(a0.x) - lam * bf_hi(b0.x); v[2] = bf_lo(a0.y) - lam * bf_lo(b0.y); v[3] = bf_hi(a0.y) - lam * bf_hi(b0.y);
        v[4] = bf_lo(a0.z) - lam * bf_lo(b0.z); v[5] = bf_hi(a0.z) - lam * bf_hi(b0.z); v[6] = bf_lo(a0.w) - lam * bf_lo(b0.w); v[7] = bf_hi(a0.w) - lam * bf_hi(b0.w);
        v[8] = bf_lo(a1.x) - lam * bf_lo(b1.x); v[9] = bf_hi(a1.x) - lam * bf_hi(b1.x); v[10] = bf_lo(a1.y) - lam * bf_lo(b1.y); v[11] = bf_hi(a1.y) - lam * bf_hi(b1.y);
        v[12] = bf_lo(a1.z) - lam * bf_lo(b1.z); v[13] = bf_hi(a1.z) - lam * bf_hi(b1.z); v[14] = bf_lo(a1.w) - lam * bf_lo(b1.w); v[15] = bf_hi(a1.w) - lam * bf_hi(b1.w);
        float ss = 0.f;
#pragma unroll
        for (int e = 0; e < 16; ++e) ss += v[e] * v[e];
        ss += __shfl_xor(ss, 1); ss += __shfl_xor(ss, 2); ss += __shfl_xor(ss, 4);
        const float rstd = 1.f / sqrtf(ss * (1.f / 128.f) + RMS_EPS);
        v4u w0, w1;
        w0.x = cvt_pk_bf16(v[0] * rstd * nw[0].x, v[1] * rstd * nw[0].y); w0.y = cvt_pk_bf16(v[2] * rstd * nw[0].z, v[3] * rstd * nw[0].w); w0.z = cvt_pk_bf16(v[4] * rstd * nw[1].x, v[5] * rstd * nw[1].y); w0.w = cvt_pk_bf16(v[6] * rstd * nw[1].z, v[7] * rstd * nw[1].w);
        w1.x = cvt_pk_bf16(v[8] * rstd * nw[2].x, v[9] * rstd * nw[2].y); w1.y = cvt_pk_bf16(v[10] * rstd * nw[2].z, v[11] * rstd * nw[2].w); w1.z = cvt_pk_bf16(v[12] * rstd * nw[3].x, v[13] * rstd * nw[3].y); w1.w = cvt_pk_bf16(v[14] * rstd * nw[3].z, v[15] * rstd * nw[3].w);
        *(GAS v4u*)(rp + AC_ODIFF) = w0; *(GAS v4u*)(rp + AC_ODIFF + 8) = w1;
    }
}

namespace rtr {
constexpr int U_LD = 1032;
constexpr int L_UH = 0, L_UL = 16 * U_LD * 2, L_PART = 2 * 16 * U_LD * 2, L_LOG = L_PART + 8 * 3 * 256 * 4, L_HIST = L_LOG + 16 * 48 * 4, L_LN = L_HIST + 128, L_ADA = L_LN + 2 * D * 4, L_END = L_ADA + 2 * 3 * D * 4;
static_assert(L_END <= RING_BYTES, "router LDS map");
}
__device__ __forceinline__ void p10_ln_router(const Ptrs& P, LAS unsigned char* lds, int vcu, int G, int tid, int lane, int wave) {
    LAS bf16* UH = (LAS bf16*)(lds + RING_OFF + rtr::L_UH); LAS bf16* UL = (LAS bf16*)(lds + RING_OFF + rtr::L_UL);
    LAS float* PART = (LAS float*)(lds + RING_OFF + rtr::L_PART); LAS float* LOG = (LAS float*)(lds + RING_OFF + rtr::L_LOG); LAS int* hist = (LAS int*)(lds + RING_OFF + rtr::L_HIST);
    const int fr = lane & 15, fq = lane >> 4;
    bf16x8 bh[3][4], bl[3][4];
#pragma unroll
    for (int nt = 0; nt < 3; ++nt)
#pragma unroll
        for (int s = 0; s < 4; ++s) { const int n = nt * 16 + fr, k0 = 128 * wave + 32 * s + 8 * fq; unsigned hw[4], lw[4];
#pragma unroll
            for (int j = 0; j < 8; j += 2) { const int ng = n < 4 ? n : 3, ne = n < 4 ? 0 : (n < 36 ? n - 4 : 31);
                const float g0 = P.wrg[(k0 + j) * 4 + ng], g1 = P.wrg[(k0 + j + 1) * 4 + ng], e0 = P.wre[(k0 + j) * 32 + ne], e1 = P.wre[(k0 + j + 1) * 32 + ne];
                const float w0 = n < 4 ? g0 : (n < 36 ? e0 : 0.f), w1 = n < 4 ? g1 : (n < 36 ? e1 : 0.f);
                const unsigned h = cvt_pk_bf16(w0, w1); hw[j >> 1] = h; lw[j >> 1] = cvt_pk_bf16(w0 - bf_lo(h), w1 - bf_hi(h)); }
            bh[nt][s] = __builtin_bit_cast(bf16x8, (v4u){hw[0], hw[1], hw[2], hw[3]}); bl[nt][s] = __builtin_bit_cast(bf16x8, (v4u){lw[0], lw[1], lw[2], lw[3]}); }
    if (tid < 32) hist[tid] = 0;
    LAS f32x4* LNV = (LAS f32x4*)(lds + RING_OFF + rtr::L_LN); LAS f32x4* ADV = (LAS f32x4*)(lds + RING_OFF + rtr::L_ADA);
    LNV[tid] = tid < 256 ? *((const f32x4*)P.ln1w + tid) : *((const f32x4*)P.ln1b + (tid - 256));
    if (vcu < T / 16) { const f32x4* ap = (const f32x4*)(P.ada + (size_t)((vcu * 16) / SEQ) * 6 * D + 2 * D); ADV[tid] = ap[tid]; if (tid < 256) ADV[512 + tid] = ap[512 + tid]; }
    LBAR();
    int abuf = 0;
    f32x4 pre[2][4]; v2u prey[2][4];
    if (vcu < T / 16) {
#pragma unroll
        for (int rr = 0; rr < 2; ++rr) { const size_t m_ = (size_t)(vcu * 16 + wave * 2 + rr); const GAS f32x4* xr = (const GAS f32x4*)(P.x + m_ * D) + lane; const GAS v2u* yr = (const GAS v2u*)(P.act + m_ * ACT_LD + AC_Y) + lane;
#pragma unroll
            for (int j = 0; j < 4; ++j) { pre[rr][j] = xr[64 * j]; prey[rr][j] = yr[64 * j]; } } }
#ifndef RPROBE_K
#define RPROBE_K -1
#endif
    unsigned long long racc = 0ull, rt0 = 0ull; const bool rstamp = RPROBE_K >= 0 && blockIdx.x == 0 && tid == 0;
#define RST(k_) do { if (rstamp) { const unsigned long long t_ = __builtin_amdgcn_s_memrealtime(); if ((k_) == RPROBE_K) rt0 = t_; if ((k_) == RPROBE_K + 1) racc += t_ - rt0; } } while (0)
    for (int batch = vcu; batch < T / 16; batch += G) {
        RST(0);
        f32x4 adn0 = (f32x4){0.f, 0.f, 0.f, 0.f}, adn1 = adn0;
        if (batch + G < T / 16) { const f32x4* ap = (const f32x4*)(P.ada + (size_t)(((batch + G) * 16) / SEQ) * 6 * D + 2 * D); adn0 = ap[tid]; if (tid < 256) adn1 = ap[512 + tid]; }
#pragma unroll
        for (int rr = 0; rr < 2; ++rr) {
            const int rl = wave * 2 + rr, m = batch * 16 + rl, b = m / SEQ;
            GAS v2u* xr = (GAS v2u*)((bf16*)P.out + (size_t)m * 2 * D + D) + lane;
            f32x4 v[4]; float s = 0.f;
#pragma unroll
            for (int j = 0; j < 4; ++j) { const f32x4 g1 = ADV[abuf * 768 + lane + 64 * j]; const v2u yv = prey[rr][j];
                v[j] = pre[rr][j] * ALPHA + g1 * (f32x4){bf_lo(yv.x), bf_hi(yv.x), bf_lo(yv.y), bf_hi(yv.y)}; s += (v[j].x + v[j].y) + (v[j].z + v[j].w); }
            float mean = wave_sum(s) * (1.f / D), s2 = 0.f;
#pragma unroll
            for (int j = 0; j < 4; ++j) { v[j] = v[j] - mean; s2 += dot4(v[j], v[j]); }
            float rstd = 1.f / sqrtf(wave_sum(s2) * (1.f / D) + LN_EPS);
            s = 0.f;
#pragma unroll
            for (int j = 0; j < 4; ++j) { const f32x4 w = LNV[lane + 64 * j], bb = LNV[256 + lane + 64 * j]; v[j] = v[j] * rstd * w + bb; { v2u xw; xw.x = cvt_pk_bf16(v[j].x, v[j].y); xw.y = cvt_pk_bf16(v[j].z, v[j].w); xr[64 * j] = xw; } s += (v[j].x + v[j].y) + (v[j].z + v[j].w); }
            mean = wave_sum(s) * (1.f / D); s2 = 0.f;
#pragma unroll
            for (int j = 0; j < 4; ++j) { v[j] = v[j] - mean; s2 += dot4(v[j], v[j]); }
            rstd = 1.f / sqrtf(wave_sum(s2) * (1.f / D) + LN_EPS);
            const LAS f32x4* sh = ADV + abuf * 768 + 256 + lane; const LAS f32x4* sl = ADV + abuf * 768 + 512 + lane;
            GAS v2u* o8 = (GAS v2u*)(P.u + (size_t)m * D) + lane;
#pragma unroll
            for (int j = 0; j < 4; ++j) { const f32x4 a = sh[64 * j], c = sl[64 * j]; const f32x4 uu = v[j] * rstd * (c + 1.f) + a;
                v2u hw; hw.x = cvt_pk_bf16(uu.x, uu.y); hw.y = cvt_pk_bf16(uu.z, uu.w); o8[64 * j] = hw;
                v2u lw; lw.x = cvt_pk_bf16(uu.x - bf_lo(hw.x), uu.y - bf_hi(hw.x)); lw.y = cvt_pk_bf16(uu.z - bf_lo(hw.y), uu.w - bf_hi(hw.y));
                *(LAS v2u*)(UH + rl * rtr::U_LD + 4 * lane + 256 * j) = hw; *(LAS v2u*)(UL + rl * rtr::U_LD + 4 * lane + 256 * j) = lw; }
        }
        if (batch + G < T / 16) {
#pragma unroll
            for (int rr = 0; rr < 2; ++rr) { const size_t m_ = (size_t)((batch + G) * 16 + wave * 2 + rr); const GAS f32x4* xr = (const GAS f32x4*)(P.x + m_ * D) + lane; const GAS v2u* yr = (const GAS v2u*)(P.act + m_ * ACT_LD + AC_Y) + lane;
#pragma unroll
                for (int j = 0; j < 4; ++j) { pre[rr][j] = xr[64 * j]; prey[rr][j] = yr[64 * j]; } }
            ADV[(abuf ^ 1) * 768 + tid] = adn0; if (tid < 256) ADV[(abuf ^ 1) * 768 + 512 + tid] = adn1; }
        abuf ^= 1;
        LBAR();
        RST(1);
        f32x4 acc[3];
#pragma unroll
        for (int nt = 0; nt < 3; ++nt) acc[nt] = (f32x4){0.f, 0.f, 0.f, 0.f};
#pragma unroll
        for (int s = 0; s < 4; ++s) { const int kk = 128 * wave + 32 * s + 8 * fq;
            const bf16x8 ah = *(const LAS bf16x8*)(UH + fr * rtr::U_LD + kk), al = *(const LAS bf16x8*)(UL + fr * rtr::U_LD + kk);
#pragma unroll
            for (int nt = 0; nt < 3; ++nt) { acc[nt] = __builtin_amdgcn_mfma_f32_16x16x32_bf16(ah, bh[nt][s], acc[nt], 0, 0, 0); acc[nt] = __builtin_amdgcn_mfma_f32_16x16x32_bf16(ah, bl[nt][s], acc[nt], 0, 0, 0);
                acc[nt] = __builtin_amdgcn_mfma_f32_16x16x32_bf16(al, bh[nt][s], acc[nt], 0, 0, 0); } }
#pragma unroll
        for (int nt = 0; nt < 3; ++nt)
#pragma unroll
            for (int g = 0; g < 4; ++g) PART[(wave * 3 + nt) * 256 + (4 * fq + g) * 16 + fr] = acc[nt][g];
        LBAR();
        RST(2);
        { const int row = tid >> 5, c = tid & 31;
#pragma unroll
            for (int hf = 0; hf < 2; ++hf) { const int cc = c + 32 * hf; if (cc < 48) { const int nt = cc >> 4, ci = cc & 15; float sm = 0.f;
#pragma unroll
                for (int w = 0; w < 8; ++w) sm += PART[(w * 3 + nt) * 256 + row * 16 + ci];
                LOG[row * 48 + cc] = sm; } } }
        LBAR();
        RST(3);
        if (tid < 16) { const int m = batch * 16 + tid; const LAS float* lgs = LOG + tid * 48;
            float lg[4], le[32];
#pragma unroll
            for (int c = 0; c < 4; ++c) lg[c] = lgs[c] + P.brg[c];
#pragma unroll
            for (int c = 0; c < 32; ++c) le[c] = lgs[4 + c] + P.bre[c];
            int g = 0; float gm = lg[0];
#pragma unroll
            for (int c = 1; c < 4; ++c) if (lg[c] > gm) { gm = lg[c]; g = c; }
            float gs = 0.f;
#pragma unroll
            for (int c = 0; c < 4; ++c) gs += expf(lg[c] - gm);
            const float wgrp = 1.f / gs;
            float es[8];
#pragma unroll
            for (int i = 0; i < 8; ++i) es[i] = g == 0 ? le[i] : (g == 1 ? le[8 + i] : (g == 2 ? le[16 + i] : le[24 + i]));
            int i0 = 0; float v0 = es[0];
#pragma unroll
            for (int i = 1; i < 8; ++i) if (es[i] > v0) { v0 = es[i]; i0 = i; }
            int i1 = -1; float v1 = -INFINITY;
#pragma unroll
            for (int i = 0; i < 8; ++i) if (i != i0 && es[i] > v1) { v1 = es[i]; i1 = i; }
            const float p1 = 1.f / (1.f + expf(v0 - v1)), p0 = 1.f - p1;
            const int e0 = g * 8 + i0, e1 = g * 8 + i1;
            P.toke[2 * m] = e0; P.toke[2 * m + 1] = e1; P.tokw[2 * m] = wgrp * p0; P.tokw[2 * m + 1] = wgrp * p1;
            __hip_atomic_fetch_add(hist + e0, 1, __ATOMIC_RELAXED, __HIP_MEMORY_SCOPE_WORKGROUP); __hip_atomic_fetch_add(hist + e1, 1, __ATOMIC_RELAXED, __HIP_MEMORY_SCOPE_WORKGROUP); }
        RST(4);
    }
    if (rstamp) __hip_atomic_store(P.dbg, (unsigned)racc, RLX_AGENT);
#undef RST
    LBAR();
    if (tid < 32) P.cnt[vcu * 32 + tid] = hist[tid];
}

__device__ __forceinline__ void p11_dispatch(const Ptrs& P, LAS unsigned char* lds, int vcu, int G, int tid, int lane) {
    LAS int* tot = (LAS int*)(lds + RING_OFF); LAS int* base = tot + 32; LAS int* cur = tot + 64; LAS int* pst = tot + 96;
    LAS int* CL = (LAS int*)(lds + RING_OFF + 1024);
    LAS int* PS = (LAS int*)(lds + RING_OFF + 1024 + 512 * 32 * 4);
    for (int i = tid; i < G * 32; i += NWAVES * 64) CL[i] = P.cnt[i];
    __syncthreads();
    { const int e = tid & 31, g = tid >> 5, per = (G + 15) / 16; int sm = 0;
        for (int w = g * per; w < (g + 1) * per && w < G; ++w) sm += CL[w * 32 + e];
        PS[g * 32 + e] = sm; }
    __syncthreads();
    if (tid < 32) { const int per = (G + 15) / 16, gm = vcu / per; int total = 0, mine = 0;
#pragma unroll
        for (int g = 0; g < 16; ++g) { const int c = PS[g * 32 + tid]; total += c; mine += (g < gm) ? c : 0; }
        for (int w = gm * per; w < vcu; ++w) mine += CL[w * 32 + tid];
        tot[tid] = total; base[tid] = mine; cur[tid] = 0; }
    __syncthreads();
    if (tid == 0) { int p = 0, nt = 0;
        for (int e = 0; e < 32; ++e) { pst[e] = p; const int nte = (tot[e] + 255) >> 8;
            for (int k = 0; k < nte; ++k) { if (vcu == 0) { P.tab[1 + nt] = e; P.tab[1 + pg8::TILE_MAX + nt] = p + 256 * k; } ++nt; }
            p += nte * 256; }
        pst[32] = p; if (vcu == 0) P.tab[0] = nt; }
    __syncthreads();
    const int nb = (T / 16 - vcu + G - 1) / G;
    for (int idx = tid; idx < nb * 32; idx += NWAVES * 64) { const int bi = idx >> 5, pr = idx & 31, ts = ((vcu + G * bi) * 16) * 2 + pr;
        const int e = P.toke[ts]; const int pos = pst[e] + base[e] + __hip_atomic_fetch_add(cur + e, 1, __ATOMIC_RELAXED, __HIP_MEMORY_SCOPE_WORKGROUP);
        P.rowtok[pos] = ts; P.roww[pos] = P.tokw[ts]; }
    if (vcu < 32) { const int e = vcu, lim = pst[e + 1] - pst[e];
        for (int r = tot[e] + tid; r < lim; r += NWAVES * 64) { P.rowtok[pst[e] + r] = -1; P.roww[pst[e] + r] = 0.f; } }
}

__device__ __forceinline__ void p14_final(const Ptrs& P, int gw, int NGW, int lane, float dscale) {
    f32x4 lw[4], lb[4];
#pragma unroll
    for (int j = 0; j < 4; ++j) { lw[j] = *((const f32x4*)P.ln2w + lane + 64 * j) * dscale; lb[j] = *((const f32x4*)P.ln2b + lane + 64 * j) * dscale; }
    for (int blk = gw; blk < T / 16; blk += NGW) {
        const int m0 = blk * 16, b = m0 / SEQ;
        f32x4 g2[4];
#pragma unroll
        for (int j = 0; j < 4; ++j) g2[j] = *((const f32x4*)(P.ada + (size_t)b * 6 * D + 5 * D) + lane + 64 * j);
        v2u px[2][4], pa[2][4], pc[2][4];
#define P14_LOAD(slot_, m_) do { const GAS v2u* xr_ = (const GAS v2u*)((const bf16*)P.out + (size_t)(m_) * 2 * D + D) + lane; \
            const GAS v2u* q0_ = (const GAS v2u*)(P.mout + (size_t)(2 * (m_)) * D) + lane; const GAS v2u* q1_ = (const GAS v2u*)(P.mout + (size_t)(2 * (m_) + 1) * D) + lane; \
            _Pragma("unroll") for (int j = 0; j < 4; ++j) { px[slot_][j] = xr_[64 * j]; pa[slot_][j] = q0_[64 * j]; pc[slot_][j] = q1_[64 * j]; } } while (0)
        P14_LOAD(0, m0); P14_LOAD(1, m0 + 1);
#define P14_ROW(sl_, m_, more_) do { const int m = (m_); f32x4 v[4]; float s = 0.f; \
            _Pragma("unroll") for (int j = 0; j < 4; ++j) { const v2u a = pa[sl_][j], c = pc[sl_][j]; const f32x4 mm = (f32x4){bf_lo(a.x) + bf_lo(c.x), bf_hi(a.x) + bf_hi(c.x), bf_lo(a.y) + bf_lo(c.y), bf_hi(a.y) + bf_hi(c.y)}; \
                const v2u xx = px[sl_][j]; v[j] = (f32x4){bf_lo(xx.x), bf_hi(xx.x), bf_lo(xx.y), bf_hi(xx.y)} * ALPHA + g2[j] * mm; s += (v[j].x + v[j].y) + (v[j].z + v[j].w); } \
            if (more_) P14_LOAD(sl_, m + 2); \
            const float mean = wave_sum(s) * (1.f / D); float s2 = 0.f; \
            _Pragma("unroll") for (int j = 0; j < 4; ++j) { v[j] = v[j] - mean; s2 += dot4(v[j], v[j]); } \
            const float rstd = 1.f / sqrtf(wave_sum(s2) * (1.f / D) + LN_EPS); \
            GAS f32x4* xr = (GAS f32x4*)(P.out + (size_t)m * D) + lane; \
            _Pragma("unroll") for (int j = 0; j < 4; ++j) xr[64 * j] = v[j] * rstd * lw[j] + lb[j]; } while (0)
#pragma unroll 1
        for (int rp = 0; rp < 8; ++rp) { P14_ROW(0, m0 + 2 * rp, rp < 7); P14_ROW(1, m0 + 2 * rp + 1, rp < 7); }
#undef P14_ROW
#undef P14_LOAD
    }
}

constexpr int NPH = 15;
constexpr int N_LAUNCHES = MK_N_LAUNCHES;
static_assert(N_LAUNCHES == 1 || N_LAUNCHES == NPH, "MK_N_LAUNCHES is 1 or 15");
struct Args { const void* in[26]; float* out; unsigned char* ws; int ph_lo, ph_hi; };
__global__ void __launch_bounds__(NWAVES * 64, 2) fwd_kernel(Args args) {
    extern __shared__ __attribute__((aligned(16))) unsigned char lds_raw[];
    LAS unsigned char* lds = (LAS unsigned char*)lds_raw;
    volatile LAS unsigned* MISC = (volatile LAS unsigned*)(lds + MISC_OFF);
    const int tid = threadIdx.x, lane = tid & 63, wave = __builtin_amdgcn_readfirstlane(tid >> 6);
    const int G = gridDim.x; const int bx = blockIdx.x; const int vcu = (G % 8 == 0) ? (bx % 8) * (G / 8) + bx / 8 : bx;
    const int gw = vcu * NWAVES + wave, NGW = G * NWAVES;
    unsigned char* ws = args.ws;
    gu32* ctl = (gu32*)(ws + WS_CTL);
    Ptrs P;
    P.x = (const float*)args.in[0]; P.c = (const float*)args.in[1]; P.pos = (const int*)args.in[2]; P.w_ada = (const float*)args.in[3]; P.b_ada = (const float*)args.in[4]; P.w_in = (const float*)args.in[5];
    P.wg2 = (const float*)args.in[6]; P.bg2 = (const float*)args.in[7]; P.gnw = (const float*)args.in[8]; P.lq1 = (const float*)args.in[9]; P.lk1 = (const float*)args.in[10]; P.lq2 = (const float*)args.in[11]; P.lk2 = (const float*)args.in[12];
    P.dnw = (const float*)args.in[13]; P.w_out = (const float*)args.in[14]; P.ln1w = (const float*)args.in[15]; P.ln1b = (const float*)args.in[16]; P.wrg = (const float*)args.in[17]; P.brg = (const float*)args.in[18];
    P.wre = (const float*)args.in[19]; P.bre = (const float*)args.in[20]; P.weg = (const float*)args.in[21]; P.weu = (const float*)args.in[22]; P.wed = (const float*)args.in[23]; P.ln2w = (const float*)args.in[24]; P.ln2b = (const float*)args.in[25];
    P.out = args.out;
    P.ada = (float*)(ws + WS_ADA); P.wrt = (float*)(ws + WS_WRT); P.tokw = (float*)(ws + WS_TOKW); P.roww = (float*)(ws + WS_ROWW); P.dt = (float*)(ws + WS_DT); P.hst = (float*)(ws + WS_HST);
    P.cnt = (int*)(ws + WS_CNT); P.tab = (int*)(ws + WS_TAB); P.toke = (int*)(ws + WS_TOKE); P.rowtok = (int*)(ws + WS_ROWTOK);
    P.win = (bf16*)(ws + WS_WIN); P.wmg = (bf16*)(ws + WS_WMG); P.wout = (bf16*)(ws + WS_WOUT); P.wgu = (bf16*)(ws + WS_WGU); P.wd = (bf16*)(ws + WS_WD); P.u = (bf16*)(ws + WS_U); P.act = (bf16*)(ws + WS_ACT);
    P.hbuf = (bf16*)(ws + WS_HBUF); P.mout = (bf16*)(ws + WS_MOUT); P.dqk = (bf16*)args.out;
    P.dbg = (unsigned*)(ctl + 2); P.gates = ws + WS_GATES;
    for (int u = tid; u < (LDS_BYTES - LDSCTL_OFF) / 4; u += NWAVES * 64) ((LAS unsigned*)(lds + LDSCTL_OFF))[u] = 0u;
    __syncthreads();
    XcdBarrier bar; bar.bar = (unsigned*)(ctl + CW_BAR); bar.x = 0; bar.st = nullptr;
    if (N_LAUNCHES == 1) bar = xcd_barrier_post((unsigned*)(ctl + CW_BAR), MISC + 8);
#define GRID_BAR() do { if (N_LAUNCHES == 1) xcd_barrier(bar); } while (0)
    const int lo = args.ph_lo, hi = args.ph_hi;
#ifndef PHASE_MASK
#define PHASE_MASK 0x7fff
#endif
#define IN(k) ((((PHASE_MASK) >> (k)) & 1) && lo <= (k) && (k) < hi)
#ifndef TPROBE_K
#define TPROBE_K -1
#endif
    unsigned long long tp0 = 0ull;
#define TP_BEGIN(k) do { if ((k) == TPROBE_K && bx == 0 && tid == 0) tp0 = __builtin_amdgcn_s_memrealtime(); } while (0)
#define SEAM(k) do { if (IN(k) && IN((k) + 1)) GRID_BAR(); if ((k) == TPROBE_K && bx == 0 && tid == 0) __hip_atomic_store(ctl + 2, (unsigned)(__builtin_amdgcn_s_memrealtime() - tp0), RLX_AGENT); } while (0)
#ifndef REP_MASK
#define REP_MASK 0
#endif
#define PHASE(k, ...) do { if (IN(k)) { __VA_ARGS__ if (((REP_MASK) >> (k)) & 1) { GRID_BAR(); __VA_ARGS__ } } } while (0)

    TP_BEGIN(0);
    PHASE(0, p0_prologue(P, lds, vcu, G, tid, lane, wave); __syncthreads(); );
    SEAM(0);
    TP_BEGIN(1);
    PHASE(1, p1_ln_mod(P, lds, gw, NGW, lane, wave); __syncthreads(); );
    SEAM(1);
    TP_BEGIN(2);
    PHASE(2,
        pg8::DenseProb Q; Q.init(P.u, D, P.win, T, N1, D, G, bx);
        pg8::EpiProj E{P.act, P.dqk, P.pos, P.gates};
        pg8::gemm_phase<pg8::EpiProj, pg8::DenseProb, true>(lds + RING_OFF, Q, E);
    );
    SEAM(2);
    TP_BEGIN(3);
    PHASE(3, for (int u = vcu; u < 256; u += G) { const int b = u >> 5, h = (u >> 3) & 3, sc = u & 7; if (sc < 7) gla::gla_unit<false>(lds + RING_OFF, P, b, h, sc); } );
    SEAM(3);
    TP_BEGIN(4);
    PHASE(4, gla::gla_scan(P, vcu * (NWAVES * 64) + tid, G * NWAVES * 64); );
    SEAM(4);
    TP_BEGIN(5);
    PHASE(5, for (int u = vcu; u < 256; u += G) { const int b = u >> 5, h = (u >> 3) & 3, sc = u & 7; gla::gla_unit<true>(lds + RING_OFF, P, b, h, sc); } );
    SEAM(5);
    TP_BEGIN(6);
    PHASE(6,
        const attn_body::AttnTensors AT{(const attn_body::bf16*)P.dqk, (const attn_body::bf16*)P.act, (attn_body::bf16*)P.act};
        const attn_body::StaticOrder S(G, vcu);
        const float lam = expf(wave_sum(P.lq1[lane] * P.lk1[lane])) - expf(wave_sum(P.lq2[lane] * P.lk2[lane])) + LAM_INIT;
        LAS float* nws = (LAS float*)(lds + LDSCTL_OFF + 512);
        if (tid < 128) nws[tid] = P.dnw[tid] * (1.f - LAM_INIT);
        __syncthreads();
        attn_body::attn_phase<attn_body::StaticOrder>((char*)lds_raw + RING_OFF, AT, S, AC_DV, AC_ODIFF, AC_OGLA, P.gates, lam, (const float*)((char*)lds_raw + LDSCTL_OFF + 512));
    );
    SEAM(6);
    TP_BEGIN(9);
    PHASE(9,
        pg8::DenseProb Q; Q.init(P.act + AC_OGLA, ACT_LD, P.wout, T, D, D, G, bx);
        pg8::EpiY E{P.act};
        pg8::gemm_phase<pg8::EpiY, pg8::DenseProb, true>(lds + RING_OFF, Q, E);
    );
    SEAM(9);
    TP_BEGIN(10);
    PHASE(10, p10_ln_router(P, lds, vcu, G, tid, lane, wave); __syncthreads(); );
    SEAM(10);
    TP_BEGIN(11);
    PHASE(11, transpose_items(P, lds, gw, NGW, lane, wave, TI_DENSE, TI_ALL); __syncthreads();
              p11_dispatch(P, lds, vcu, G, tid, lane); __syncthreads(); );
    SEAM(11);
    TP_BEGIN(12);
    PHASE(12,
        LAS int* rows = (LAS int*)(lds + ROWS_OFF); LAS int* ltab = (LAS int*)(lds + TAB_OFF);
        for (int i = tid; i < 1 + 2 * pg8::TILE_MAX; i += NWAVES * 64) ltab[i] = P.tab[i];
        __syncthreads();
        pg8::MoeProb<true> Q; Q.A = (const char*)P.u; Q.Bt = (const char*)P.wgu; Q.lda = D; Q.K = D; Q.G = G; Q.c = vcu; Q.tab = ltab; Q.rows = rows; Q.bstride = (size_t)1024 * D * 2;
        {
            int nun = 0; { pg8::Unit un; while (nun < 8 && Q.next(nun, un)) ++nun; }
            for (int idx = tid; idx < nun * 256; idx += NWAVES * 64) { const int i = idx >> 8; const int t = (i * G + vcu) >> 2; const int rt = P.rowtok[ltab[1 + pg8::TILE_MAX + t] + (idx & 255)]; rows[idx] = rt < 0 ? 0 : (rt >> 1); } }
        __syncthreads();
        pg8::EpiUp E{P.hbuf};
        pg8::gemm_phase<pg8::EpiUp, pg8::MoeProb<true>, true>(lds + RING_OFF, Q, E);
    );
    SEAM(12);
    TP_BEGIN(13);
    PHASE(13,
        LAS int* ltab = (LAS int*)(lds + TAB_OFF);
        for (int i = tid; i < 1 + 2 * pg8::TILE_MAX; i += NWAVES * 64) ltab[i] = P.tab[i];
        __syncthreads();
        pg8::MoeProb<false> Q; Q.A = (const char*)P.hbuf; Q.Bt = (const char*)P.wd; Q.lda = FF; Q.K = FF; Q.G = G; Q.c = vcu; Q.tab = ltab; Q.rows = nullptr; Q.bstride = (size_t)D * FF * 2;
        pg8::EpiDown E{P.mout, P.rowtok, P.roww};
        pg8::gemm_phase<pg8::EpiDown, pg8::MoeProb<false>, true>(lds + RING_OFF, Q, E);
    );
    SEAM(13);
    TP_BEGIN(14);
    PHASE(14, p14_final(P, gw, NGW, lane, (TPROBE_K >= 0 || GPROBE_K >= 0 || P0PROBE || RPROBE_K >= 0) ? 1.f + (float)__hip_atomic_load(ctl + 2, RLX_AGENT) * 1e-6f : 1.f); );
#undef IN
#undef SEAM
#undef GRID_BAR
}

extern "C" void kernel_launch(void* const* d_in, const int* in_sizes, int n_in, void* d_out, int out_size, void* d_ws, size_t ws_size, hipStream_t stream) {
    static int grid = 0;
    if (grid == 0) {
        if (n_in != 26 || in_sizes[0] != T * D || out_size != T * D || ws_size < WS_END) { fprintf(stderr, "kernel_launch: unexpected shapes (n_in %d, in0 %d, out %d, ws %zu < %zu); nothing launched\n", n_in, n_in > 0 ? in_sizes[0] : -1, out_size, ws_size, (size_t)WS_END); grid = -1; return; }
        int dev = 0, cus = 0, per_cu = 0;
        if (hipGetDevice(&dev) != hipSuccess || hipDeviceGetAttribute(&cus, hipDeviceAttributeMultiprocessorCount, dev) != hipSuccess) { fprintf(stderr, "kernel_launch: device query failed\n"); grid = -1; return; }
        if (hipFuncSetAttribute((const void*)fwd_kernel, hipFuncAttributeMaxDynamicSharedMemorySize, LDS_BYTES) != hipSuccess) { fprintf(stderr, "kernel_launch: hipFuncSetAttribute failed\n"); grid = -1; return; }
        if (hipOccupancyMaxActiveBlocksPerMultiprocessor(&per_cu, (const void*)fwd_kernel, NWAVES * 64, LDS_BYTES) != hipSuccess || per_cu < 1)
            fprintf(stderr, "kernel_launch: note: occupancy query reports %d workgroups per CU\n", per_cu);
        (void)hipGetLastError();
        grid = cus;
    }
    if (grid < 0) return;
    if (hipMemsetAsync((char*)d_ws + WS_CTL, 0, CTL_ZERO_BYTES, stream) != hipSuccess) { fprintf(stderr, "kernel_launch: hipMemsetAsync failed\n"); return; }
    Args a{};
    for (int i = 0; i < 26; ++i) a.in[i] = d_in[i];
    a.out = (float*)d_out; a.ws = (unsigned char*)d_ws;
    for (int li = 0; li < N_LAUNCHES; ++li) {
        a.ph_lo = (N_LAUNCHES == 1) ? 0 : li; a.ph_hi = (N_LAUNCHES == 1) ? NPH : li + 1;
        hipLaunchKernelGGL(fwd_kernel, dim3(grid), dim3(NWAVES * 64), LDS_BYTES, stream, a);
        const hipError_t le = hipPeekAtLastError();
        if (le != hipSuccess) { fprintf(stderr, "kernel_launch: launch %d failed: %s\n", li, hipGetErrorName(le)); break; }
    }
}
```
